# Optimizing an MI355X kernel written in HIP

```python
import math
import jax
import jax.numpy as jnp
from jax import lax
import numpy as np

D_MODEL = 1024
BATCH = 8
SEQ = 4096
DEPTH = 4

GRID_W = 64
CTX_LEN = 256
N_EVEN = (DEPTH + 1) // 2
N_ODD = DEPTH // 2
HEAD_DIM = 64
A_WIDTH = D_MODEL // 2
A_HEADS = A_WIDTH // HEAD_DIM
DECAY_LORA = 64
ICLR_LORA = 64
GATE_LORA = 128
A_IN = 3 * A_WIDTH + 2 * DECAY_LORA + 2 * ICLR_LORA + GATE_LORA
RWKV_GN_EPS = 64e-5
B_WIDTH = D_MODEL - A_WIDTH
B_Q_HEADS = B_WIDTH // HEAD_DIM
B_KV_HEADS = 2
B_GROUP = B_Q_HEADS // B_KV_HEADS
B_IN = (B_Q_HEADS + 2 * B_KV_HEADS) * HEAD_DIM
EVEN_IN = A_IN + B_IN
WINDOW = 128
BLOCK = 128
ROPE_THETA = 10000.0
MASK_VALUE = -1e30
HY_ORDER = 2
HY_EMB = 33
HY_BANDS = (HY_EMB - 1) // 2
HY_FFN = 64
HY_TARGET = 1e-2
HY_FAST_PCT = 0.3
HY_SLOW_PCT = 1.5
HY_MOD_SHIFT = 0.05
FFN_HIDDEN = 2816
NORM_EPS = 1e-6

kernel_name = 'hybrid_rwkv7_swa_hyena_dit_block'


def rms_norm(x, g):
    xf = x.astype(jnp.float32)
    xf = xf * lax.rsqrt(jnp.mean(jnp.square(xf), axis=-1, keepdims=True) + NORM_EPS)
    return (xf * g).astype(x.dtype)


def modulate(h, shift, scale):
    return h * (1.0 + scale) + shift


def neighbours(z):
    zp = jnp.pad(z, ((0, 0), (1, 1), (0, 0)))
    return zp[:, :-2], zp[:, 2:]


def dwconv3(z, w, b):
    prev, nxt = neighbours(z)
    return prev * w[0] + z * w[1] + nxt * w[2] + b


def token_shift(z, mu_prev, mu_next):
    prev, nxt = neighbours(z)
    return z + mu_prev * (prev - z) + mu_next * (nxt - z)


def axial_rope(n_tokens):
    rows = n_tokens // GRID_W
    row = jnp.repeat(jnp.arange(rows), GRID_W).astype(jnp.float32)
    col = jnp.tile(jnp.arange(GRID_W), rows).astype(jnp.float32)
    n_freq = HEAD_DIM // 4
    inv = ROPE_THETA ** (-jnp.arange(n_freq, dtype=jnp.float32) / n_freq)
    ang = jnp.concatenate([row[:, None] * inv, col[:, None] * inv], axis=-1)
    return jnp.cos(ang), jnp.sin(ang)


def apply_rope(x, cos, sin):
    half = HEAD_DIM // 2
    x1, x2 = x[..., :half], x[..., half:]
    cos = cos[None, :, None, :].astype(x.dtype)
    sin = sin[None, :, None, :].astype(x.dtype)
    return jnp.concatenate([x1 * cos - x2 * sin, x1 * sin + x2 * cos], axis=-1)


def softmax_with_sink(s, sink):
    m = jnp.maximum(jnp.max(s, axis=-1, keepdims=True), sink)
    e = jnp.exp(s - m)
    return e / (jnp.sum(e, axis=-1, keepdims=True) + jnp.exp(sink - m))


def attn_heads(pb):
    bsz, n = pb.shape[:2]
    nq = B_Q_HEADS * HEAD_DIM
    nk = B_KV_HEADS * HEAD_DIM
    q = pb[..., :nq].reshape(bsz, n, B_Q_HEADS, HEAD_DIM)
    k = pb[..., nq:nq + nk].reshape(bsz, n, B_KV_HEADS, HEAD_DIM)
    v = pb[..., nq + nk:].reshape(bsz, n, B_KV_HEADS, HEAD_DIM)
    return q, k, v


def window_attention(q, k, v, kc, vc, sink):
    bsz, n = q.shape[:2]
    nb = n // BLOCK
    scale = HEAD_DIM ** -0.5
    qb = q.reshape(bsz, nb, BLOCK, B_KV_HEADS, B_GROUP, HEAD_DIM).transpose(1, 0, 2, 3, 4, 5)

    def band(t):
        tp = jnp.pad(t, ((0, 0), (BLOCK, BLOCK), (0, 0), (0, 0)))
        tp = tp.reshape(bsz, nb + 2, BLOCK, B_KV_HEADS, HEAD_DIM)
        tb = jnp.concatenate([tp[:, :-2], tp[:, 1:-1], tp[:, 2:]], axis=2)
        return tb.transpose(1, 0, 2, 3, 4)

    kb, vb = band(k), band(v)
    qi = jnp.arange(BLOCK)[:, None]
    kj = jnp.arange(3 * BLOCK)[None, :]
    in_window = jnp.abs(kj - BLOCK - qi) <= WINDOW
    sink_g = sink.reshape(B_KV_HEADS, B_GROUP)[None, :, :, None, None].astype(jnp.float32)

    def one_block(args):
        blk, q_blk, k_blk, v_blk = args
        kpos = blk * BLOCK - BLOCK + kj
        valid = in_window & (kpos >= 0) & (kpos < n)
        s_loc = jnp.einsum('bqhgd,bkhd->bhgqk', q_blk, k_blk).astype(jnp.float32) * scale
        s_loc = jnp.where(valid, s_loc, MASK_VALUE)
        s_ctx = jnp.einsum('bqhgd,bkhd->bhgqk', q_blk, kc).astype(jnp.float32) * scale
        p = softmax_with_sink(jnp.concatenate([s_loc, s_ctx], axis=-1), sink_g).astype(v.dtype)
        o = jnp.einsum('bhgqk,bkhd->bqhgd', p[..., :3 * BLOCK], v_blk)
        return o + jnp.einsum('bhgqk,bkhd->bqhgd', p[..., 3 * BLOCK:], vc)

    out = lax.map(one_block, (jnp.arange(nb), qb, kb, vb))
    return out.transpose(1, 0, 2, 3, 4, 5).reshape(bsz, n, B_Q_HEADS * HEAD_DIM)


def context_attention(qc, kc, vc, sink):
    bsz, n = qc.shape[:2]
    qg = qc.reshape(bsz, n, B_KV_HEADS, B_GROUP, HEAD_DIM)
    s = jnp.einsum('bqhgd,bkhd->bhgqk', qg, kc).astype(jnp.float32) * (HEAD_DIM ** -0.5)
    sink_g = sink.reshape(B_KV_HEADS, B_GROUP)[None, :, :, None, None].astype(jnp.float32)
    p = softmax_with_sink(s, sink_g).astype(vc.dtype)
    return jnp.einsum('bhgqk,bkhd->bqhgd', p, vc).reshape(bsz, n, B_Q_HEADS * HEAD_DIM)


def rwkv7_inputs(za, ep):
    bsz, n = za.shape[:2]
    C = A_WIDTH
    r = za[..., :C]
    k = za[..., C:2 * C]
    v = za[..., 2 * C:3 * C]
    o = 3 * C
    wd = za[..., o:o + 2 * DECAY_LORA].reshape(bsz, n, 2, DECAY_LORA)
    o += 2 * DECAY_LORA
    ad = za[..., o:o + 2 * ICLR_LORA].reshape(bsz, n, 2, ICLR_LORA)
    o += 2 * ICLR_LORA
    gd = za[..., o:o + GATE_LORA]
    w_log = -jax.nn.softplus(-(ep['w0'] + jnp.einsum('btdr,drc->btdc', jnp.tanh(wd), ep['w2']))) - 0.5
    decay = jnp.exp(-jnp.exp(w_log.astype(jnp.float32)))
    a = jax.nn.sigmoid(ep['a0'] + jnp.einsum('btdr,drc->btdc', ad, ep['a2']))
    g = jax.nn.sigmoid(gd) @ ep['g2']
    kk = (k * ep['k_k']).astype(jnp.float32).reshape(bsz, n, A_HEADS, HEAD_DIM)
    kk = kk / jnp.maximum(jnp.sqrt(jnp.sum(kk * kk, axis=-1, keepdims=True)), 1e-12)
    kk = kk.reshape(bsz, n, C)
    k_dir = k[:, :, None, :] * (1.0 + (a - 1.0) * ep['k_a'])
    return {'r': r, 'decay': decay, 'k': k_dir, 'v': v, 'kk': kk, 'a': a, 'g': g}


def dir_layout(t):
    t = jnp.stack([t[:, :, 0], jnp.flip(t[:, :, 1], axis=1)], axis=0)
    _, bsz, n, _ = t.shape
    return t.reshape(2, bsz, n, A_HEADS, HEAD_DIM).transpose(2, 0, 1, 3, 4).astype(jnp.float32)


def shared_layout(t):
    return dir_layout(jnp.stack([t, t], axis=2))


def rwkv7_run(state0, inp):
    def step(S, xs):
        r_t, w_t, k_t, v_t, kk_t, a_t = xs
        sa = -jnp.einsum('dbhij,dbhj->dbhi', S, kk_t)
        S = S * w_t[..., None, :] + sa[..., None] * (kk_t * a_t)[..., None, :] + v_t[..., None] * k_t[..., None, :]
        return S, jnp.einsum('dbhij,dbhj->dbhi', S, r_t)

    xs = (shared_layout(inp['r']), dir_layout(inp['decay']), dir_layout(inp['k']),
          shared_layout(inp['v']), shared_layout(inp['kk']), dir_layout(inp['a']))
    S, ys = lax.scan(step, state0, xs)
    ys = ys.transpose(1, 2, 0, 3, 4)
    return S, ys[0] + jnp.flip(ys[1], axis=1)


def rwkv7_output(y, inp, ep, dtype):
    bsz, n = y.shape[:2]
    mu = jnp.mean(y, axis=-1, keepdims=True)
    var = jnp.var(y, axis=-1, keepdims=True)
    yn = ((y - mu) * lax.rsqrt(var + RWKV_GN_EPS)).reshape(bsz, n, A_WIDTH) * ep['ln_w'] + ep['ln_b']
    r = inp['r'].reshape(bsz, n, A_HEADS, HEAD_DIM)
    kd = inp['k'].reshape(bsz, n, 2, A_HEADS, HEAD_DIM)
    v = inp['v'].reshape(bsz, n, A_HEADS, HEAD_DIM)
    bonus = jnp.einsum('bthn,btdhn,hn->bth', r, kd, ep['r_k'])[..., None] * v
    return ((yn + bonus.reshape(bsz, n, A_WIDTH)) * inp['g']).astype(dtype)


def even_mixer(h_lat, h_ctx, ep, rope_cos, rope_sin, need_ctx):
    p_lat = h_lat @ ep['w_in']
    p_ctx = h_ctx @ ep['w_in']
    in_ctx = rwkv7_inputs(token_shift(p_ctx[..., :A_IN], ep['mu_prev'], ep['mu_next']), ep)
    in_lat = rwkv7_inputs(token_shift(p_lat[..., :A_IN], ep['mu_prev'], ep['mu_next']), ep)
    state0 = jnp.zeros((2, h_lat.shape[0], A_HEADS, HEAD_DIM, HEAD_DIM), jnp.float32)
    s_ctx, y_ctx = rwkv7_run(state0, in_ctx)
    _, y_lat = rwkv7_run(s_ctx, in_lat)
    a_lat = rwkv7_output(y_lat, in_lat, ep, h_lat.dtype)
    q_l, k_l, v_l = attn_heads(p_lat[..., A_IN:])
    q_c, k_c, v_c = attn_heads(p_ctx[..., A_IN:])
    q_l = apply_rope(rms_norm(q_l, ep['q_norm']), rope_cos, rope_sin)
    k_l = apply_rope(rms_norm(k_l, ep['k_norm']), rope_cos, rope_sin)
    k_c = rms_norm(k_c, ep['k_norm'])
    b_lat = window_attention(q_l, k_l, v_l, k_c, v_c, ep['sink'])
    out_lat = jnp.concatenate([a_lat, b_lat], axis=-1) @ ep['w_out']
    if not need_ctx:
        return out_lat, None
    a_ctx = rwkv7_output(y_ctx, in_ctx, ep, h_ctx.dtype)
    b_ctx = context_attention(rms_norm(q_c, ep['q_norm']), k_c, v_c, ep['sink'])
    out_ctx = jnp.concatenate([a_ctx, b_ctx], axis=-1) @ ep['w_out']
    return out_lat, out_ctx


def hyena_filter_spectra(n, op):
    t = jnp.linspace(0.0, 1.0, n, dtype=jnp.float32)[:, None]
    ang = 2.0 * math.pi * jnp.arange(n, dtype=jnp.float32)[:, None] / n
    f = jnp.linspace(1e-4, HY_BANDS - 1, HY_BANDS, dtype=jnp.float32)[None, :]
    z = jnp.concatenate([t, jnp.cos(f * ang), -jnp.sin(f * ang)], axis=-1)
    hdn = jnp.sin(op['f_freq'] * (z @ op['f_w1'] + op['f_b1']))
    hdn = jnp.sin(op['f_freq'] * (hdn @ op['f_w2'] + op['f_b2']))
    hdn = jnp.sin(op['f_freq'] * (hdn @ op['f_w3'] + op['f_b3']))
    h = (hdn @ op['f_out']).astype(jnp.float32).reshape(n, HY_ORDER, 2, D_MODEL)
    deltas = jnp.abs(jnp.linspace(math.log(HY_TARGET) / HY_SLOW_PCT, math.log(HY_TARGET) / HY_FAST_PCT,
                                  D_MODEL, dtype=jnp.float32))
    h = h * (jnp.exp(-t * deltas) + HY_MOD_SHIFT)[:, None, None, :]
    h_fwd, h_bwd = h[:, :, 0], h[:, :, 1]
    kern = jnp.concatenate([h_fwd[:1] + h_bwd[:1], h_fwd[1:],
                            jnp.zeros((1, HY_ORDER, D_MODEL), jnp.float32), jnp.flip(h_bwd[1:], axis=0)], axis=0)
    return jnp.fft.rfft(kern, axis=0)


def long_conv(u, kern_f, skip):
    n = u.shape[1]
    uf = jnp.fft.rfft(u.astype(jnp.float32), n=2 * n, axis=1)
    y = jnp.fft.irfft(uf * kern_f[None], n=2 * n, axis=1)[:, :n]
    return (y + u * skip).astype(u.dtype)


def hyena_mixer(h, op):
    z = dwconv3(h @ op['w_in'] + op['b_in'], op['conv_w'], op['conv_b'])
    v, x1, x2 = jnp.split(z, 3, axis=-1)
    kf = hyena_filter_spectra(h.shape[1], op)
    y = x1 * long_conv(v, kf[:, 0], op['skip'][0])
    y = x2 * long_conv(y, kf[:, 1], op['skip'][1])
    return y @ op['w_out'] + op['b_out']


def conv_ffn(h, w_up, conv_w, conv_b, w_down):
    u = dwconv3(h @ w_up, conv_w, conv_b)
    gate, val = jnp.split(u, 2, axis=-1)
    return (jax.nn.silu(gate) * val) @ w_down


def setup_inputs(seed: int = 0) -> dict:
    key = jax.random.key(seed)
    keys = jax.random.split(key, 64)
    counter = [0]

    def nxt():
        counter[0] += 1
        return keys[counter[0] - 1]

    def nrm(shape, scale):
        return jax.random.normal(nxt(), shape, jnp.float32) * scale

    def unif(shape, lo, hi):
        return jax.random.uniform(nxt(), shape, jnp.float32, lo, hi)

    D = D_MODEL
    F = FFN_HIDDEN
    E = N_EVEN
    O = N_ODD
    return {
        'x': nrm((BATCH, SEQ, D), 1.0),
        'c': nrm((BATCH, D), 1.0),
        'ctx': nrm((BATCH, CTX_LEN, D), 1.0),
        'c_ctx': nrm((D,), 1.0),
        'ada_w': nrm((DEPTH, D, 6 * D), 0.5 * D ** -0.5),
        'ada_b': nrm((DEPTH, 6 * D), 0.02),
        'norm1_g': 1.0 + nrm((DEPTH, D), 0.02),
        'norm2_g': 1.0 + nrm((DEPTH, D), 0.02),
        'ffn_up': nrm((DEPTH, D, 2 * F), D ** -0.5),
        'ffn_conv_w': nrm((DEPTH, 3, 2 * F), 3 ** -0.5),
        'ffn_conv_b': nrm((DEPTH, 2 * F), 0.02),
        'ffn_down': nrm((DEPTH, F, D), F ** -0.5),
        'ev_w_in': nrm((E, D, EVEN_IN), D ** -0.5),
        'ev_mu_prev': unif((E, A_IN), 0.0, 0.5),
        'ev_mu_next': unif((E, A_IN), 0.0, 0.5),
        'ev_w0': unif((E, 2, A_WIDTH), -6.0, -1.0),
        'ev_w2': nrm((E, 2, DECAY_LORA, A_WIDTH), 0.1 * DECAY_LORA ** -0.5),
        'ev_a0': nrm((E, 2, A_WIDTH), 0.1),
        'ev_a2': nrm((E, 2, ICLR_LORA, A_WIDTH), 0.3 * ICLR_LORA ** -0.5),
        'ev_g2': nrm((E, GATE_LORA, A_WIDTH), GATE_LORA ** -0.5),
        'ev_k_k': 0.85 + nrm((E, A_WIDTH), 0.05),
        'ev_k_a': 1.0 + nrm((E, A_WIDTH), 0.05),
        'ev_r_k': nrm((E, A_HEADS, HEAD_DIM), 0.1),
        'ev_ln_w': 1.0 + nrm((E, A_WIDTH), 0.02),
        'ev_ln_b': nrm((E, A_WIDTH), 0.02),
        'ev_q_norm': 1.0 + nrm((E, HEAD_DIM), 0.02),
        'ev_k_norm': 1.0 + nrm((E, HEAD_DIM), 0.02),
        'ev_sink': nrm((E, B_Q_HEADS), 0.5),
        'ev_w_out': nrm((E, D, D), D ** -0.5),
        'od_w_in': nrm((O, D, 3 * D), D ** -0.5),
        'od_b_in': nrm((O, 3 * D), 0.02),
        'od_conv_w': nrm((O, 3, 3 * D), 3 ** -0.5),
        'od_conv_b': nrm((O, 3 * D), 0.02),
        'od_f_w1': nrm((O, HY_EMB, HY_FFN), HY_EMB ** -0.5),
        'od_f_b1': nrm((O, HY_FFN), 1.0),
        'od_f_w2': nrm((O, HY_FFN, HY_FFN), HY_FFN ** -0.5),
        'od_f_b2': nrm((O, HY_FFN), 0.1),
        'od_f_w3': nrm((O, HY_FFN, HY_FFN), HY_FFN ** -0.5),
        'od_f_b3': nrm((O, HY_FFN), 0.1),
        'od_f_freq': 1.0 + nrm((O, HY_FFN), 0.1),
        'od_f_out': nrm((O, HY_FFN, HY_ORDER * 2 * D), 0.05 * HY_FFN ** -0.5),
        'od_skip': nrm((O, HY_ORDER, D), 0.1),
        'od_w_out': nrm((O, D, D), D ** -0.5),
        'od_b_out': nrm((O, D), 0.02),
    }


def reference(x, c, ctx, c_ctx, ada_w, ada_b, norm1_g, norm2_g, ffn_up, ffn_conv_w, ffn_conv_b, ffn_down,
              ev_w_in, ev_mu_prev, ev_mu_next, ev_w0, ev_w2, ev_a0, ev_a2, ev_g2, ev_k_k, ev_k_a, ev_r_k,
              ev_ln_w, ev_ln_b, ev_q_norm, ev_k_norm, ev_sink, ev_w_out,
              od_w_in, od_b_in, od_conv_w, od_conv_b, od_f_w1, od_f_b1, od_f_w2, od_f_b2, od_f_w3, od_f_b3,
              od_f_freq, od_f_out, od_skip, od_w_out, od_b_out):
    rope_cos, rope_sin = axial_rope(x.shape[1])
    cond_lat = jax.nn.silu(c)
    cond_ctx = jax.nn.silu(c_ctx)
    for layer in range(DEPTH):
        need_ctx = layer < DEPTH - 1
        even = layer % 2 == 0
        j = layer // 2
        mod_l = jnp.split((cond_lat @ ada_w[layer] + ada_b[layer])[:, None, :], 6, axis=-1)
        h_lat = modulate(rms_norm(x, norm1_g[layer]), mod_l[0], mod_l[1])
        if even or need_ctx:
            mod_c = jnp.split((cond_ctx @ ada_w[layer] + ada_b[layer])[None, None, :], 6, axis=-1)
            h_ctx = modulate(rms_norm(ctx, norm1_g[layer]), mod_c[0], mod_c[1])
        if even:
            ep = {'w_in': ev_w_in[j], 'mu_prev': ev_mu_prev[j], 'mu_next': ev_mu_next[j],
                  'w0': ev_w0[j], 'w2': ev_w2[j], 'a0': ev_a0[j], 'a2': ev_a2[j], 'g2': ev_g2[j],
                  'k_k': ev_k_k[j], 'k_a': ev_k_a[j], 'r_k': ev_r_k[j], 'ln_w': ev_ln_w[j], 'ln_b': ev_ln_b[j],
                  'q_norm': ev_q_norm[j], 'k_norm': ev_k_norm[j], 'sink': ev_sink[j], 'w_out': ev_w_out[j]}
            o_lat, o_ctx = even_mixer(h_lat, h_ctx, ep, rope_cos, rope_sin, need_ctx)
        else:
            op = {'w_in': od_w_in[j], 'b_in': od_b_in[j], 'conv_w': od_conv_w[j], 'conv_b': od_conv_b[j],
                  'f_w1': od_f_w1[j], 'f_b1': od_f_b1[j], 'f_w2': od_f_w2[j], 'f_b2': od_f_b2[j],
                  'f_w3': od_f_w3[j], 'f_b3': od_f_b3[j], 'f_freq': od_f_freq[j], 'f_out': od_f_out[j],
                  'skip': od_skip[j], 'w_out': od_w_out[j], 'b_out': od_b_out[j]}
            o_lat = hyena_mixer(h_lat, op)
            o_ctx = hyena_mixer(h_ctx, op) if need_ctx else None
        x = x + mod_l[2] * o_lat
        x = x + mod_l[5] * conv_ffn(modulate(rms_norm(x, norm2_g[layer]), mod_l[3], mod_l[4]),
                                    ffn_up[layer], ffn_conv_w[layer], ffn_conv_b[layer], ffn_down[layer])
        if need_ctx:
            ctx = ctx + mod_c[2] * o_ctx
            ctx = ctx + mod_c[5] * conv_ffn(modulate(rms_norm(ctx, norm2_g[layer]), mod_c[3], mod_c[4]),
                                            ffn_up[layer], ffn_conv_w[layer], ffn_conv_b[layer], ffn_down[layer])
    return x
```

```cpp
#include <hip/hip_runtime.h>
#include <hip/hip_cooperative_groups.h>
#include <cstdio>
namespace cg = cooperative_groups;

typedef unsigned short bf16_t;
typedef short bf16x8 __attribute__((ext_vector_type(8)));
typedef float f32x4 __attribute__((ext_vector_type(4)));
typedef __bf16 bf16v2 __attribute__((ext_vector_type(2)));
#define DI __device__ __forceinline__
#ifndef PROBE_MASK
#define PROBE_MASK 0
#endif

constexpr int DM = 1024, NB = 8, SEQ = 4096, CTXL = 256, TPB = SEQ + CTXL, MROWS = NB * TPB;
constexpr int A_IN = 1920, EVEN_IN = 2688, PW = 2688, LW = 384, LOW = 2560, FF = 2816, FF2 = 5632, HY3 = 3072;
constexpr int NTHR = 512;
constexpr int TP = 264;
constexpr int LDS_BYTES = 256 * TP * 2;

enum { I_X = 0, I_C, I_CTX, I_CCTX, I_ADAW, I_ADAB, I_N1G, I_N2G, I_FUP, I_FCW, I_FCB, I_FDN,
       I_EWIN, I_EMUP, I_EMUN, I_EW0, I_EW2, I_EA0, I_EA2, I_EG2, I_EKK, I_EKA, I_ERK, I_ELNW, I_ELNB, I_EQN, I_EKN, I_ESINK, I_EWOUT,
       I_OWIN, I_OBIN, I_OCW, I_OCB, I_OFW1, I_OFB1, I_OFW2, I_OFB2, I_OFW3, I_OFB3, I_OFREQ, I_OFOUT, I_OSKIP, I_OWOUT, I_OBOUT, N_IN };

struct Params { const float* in[N_IN]; float* out; char* ws; };
struct DevP { const float* const* in; float* out; char* ws; bool dry; };

constexpr size_t OFF_XC = 0;
constexpr size_t OFF_MOD = OFF_XC + (size_t)NB * CTXL * DM * 4;
constexpr size_t OFF_HDNL = OFF_MOD + (size_t)4 * 9 * 6144 * 4;
constexpr size_t OFF_HDNC = OFF_HDNL + (size_t)2 * 4096 * 64 * 4;
constexpr size_t OFF_TW = OFF_HDNC + (size_t)2 * 256 * 64 * 4;
constexpr size_t OFF_ROPE = OFF_TW + (size_t)4096 * 8;
constexpr size_t OFF_KN = OFF_ROPE + (size_t)4096 * 32 * 8;
constexpr size_t OFF_WT = OFF_KN + (size_t)MROWS * 8 * 4;
constexpr size_t WT_WIN = 0, WT_LORA = 3145728, WT_WOUT = WT_LORA + 983040, WT_WUP = WT_WOUT + 1048576, WT_WDN = WT_WUP + 5767168, WT_END = WT_WDN + 2883584;
constexpr size_t OFF_H = OFF_WT + WT_END * 2;
constexpr size_t OFF_BIG = OFF_H + (size_t)MROWS * DM * 2;
constexpr size_t OFF_LO = OFF_BIG + (size_t)NB * HY3 * TPB * 2;
constexpr size_t WS_END = OFF_LO + (size_t)MROWS * LOW * 2;
constexpr size_t OFF_BAR = WS_END;
constexpr size_t OFF_WT2 = OFF_BAR + 16384;
constexpr size_t WS_END2 = OFF_WT2 + WT_END * 2;
constexpr size_t OFF_L = OFF_BIG + (size_t)MROWS * PW * 2;

DI float bf2f(bf16_t h) { return __uint_as_float(((unsigned)h) << 16); }
DI unsigned pack2(float a, float b) { bf16v2 v = {(__bf16)a, (__bf16)b}; return __builtin_bit_cast(unsigned, v); }
DI bf16_t f2bf(float a) { __bf16 v = (__bf16)a; return __builtin_bit_cast(bf16_t, v); }
DI float lo16(unsigned u) { return __uint_as_float(u << 16); }
DI float hi16(unsigned u) { return __uint_as_float(u & 0xffff0000u); }
DI float sigmoidf_(float x) { return 1.f / (1.f + __expf(-x)); }
DI float siluf_(float x) { return x / (1.f + __expf(-x)); }
DI float dpp_sum16(float x) {
  x += __builtin_bit_cast(float, __builtin_amdgcn_update_dpp(0, __builtin_bit_cast(int, x), 0x128, 0xf, 0xf, false));
  x += __builtin_bit_cast(float, __builtin_amdgcn_update_dpp(0, __builtin_bit_cast(int, x), 0x124, 0xf, 0xf, false));
  x += __builtin_bit_cast(float, __builtin_amdgcn_update_dpp(0, __builtin_bit_cast(int, x), 0x122, 0xf, 0xf, false));
  x += __builtin_bit_cast(float, __builtin_amdgcn_update_dpp(0, __builtin_bit_cast(int, x), 0x121, 0xf, 0xf, false));
  return x;
}
DI float bperm_xor(float v, int lane, int mask) {
  return __builtin_bit_cast(float, __builtin_amdgcn_ds_bpermute((lane ^ mask) << 2, __builtin_bit_cast(int, v)));
}
DI float sum16(float v) { return dpp_sum16(v); }
DI float wave_sum(float v, int lane) { v = dpp_sum16(v); v += bperm_xor(v, lane, 16); v += bperm_xor(v, lane, 32); return v; }
DI float* xrow(const DevP& p, int row, int& mi) {
  int b = row / TPB, s = row - b * TPB;
  if (s < CTXL) { mi = 8; return (float*)(p.ws + OFF_XC) + ((size_t)(b * CTXL + s)) * DM; }
  mi = b; return p.out + ((size_t)(b * SEQ + s - CTXL)) * DM;
}
DI bool prev_valid(int row) { int s = row % TPB; return s != 0 && s != CTXL; }
DI bool next_valid(int row) { int s = row % TPB; return s != CTXL - 1 && s != TPB - 1; }

constexpr int HT = 128 * 64;
DI const char* uni_ptr(const char* q) {
  unsigned lo = __builtin_amdgcn_readfirstlane((unsigned)(unsigned long long)q), hi = __builtin_amdgcn_readfirstlane((unsigned)((unsigned long long)q >> 32));
  return (const char*)(const __attribute__((address_space(1))) char*)(((unsigned long long)hi << 32) | lo);
}
DI const float* pin(const DevP& p, int i) { return (const float*)uni_ptr((const char*)p.in[i]); }
DI int lds_byte(int r, int c) { int st = (r >> 4) * 2 + (c >> 5), rr = r & 15, cc = c & 31, ob = rr * 64 + cc * 2; return st * 1024 + (ob ^ (((ob >> 9) & 1) << 5)); }
DI void stage_rc(int b, int& R, int& C) { int st = b / 1024, sb = b % 1024, swz = sb ^ (((sb >> 9) & 1) << 5); R = (st >> 1) * 16 + swz / 64; C = (st & 1) * 32 + (swz % 64) / 2; }

#define WAIT_V(n) asm volatile("s_waitcnt vmcnt(" #n ")" ::: "memory")
#define WAIT_L(n) asm volatile("s_waitcnt lgkmcnt(" #n ")" ::: "memory")
#define BAR __builtin_amdgcn_s_barrier()
#define SCHED __builtin_amdgcn_sched_barrier(0)

enum { M_RES = 0, M_LORA = 1, M_FFN = 2, M_EVEN = 3, M_ODD = 4 };

struct GemmCall {
  const bf16_t* A; int lda; int M; int ksk; int ksoff;
  const bf16_t* Bt; int K;
  const float* bias; const float* mod; int msel;
  const float* e0; const float* e1; const float* e2; const float* e3;
  bf16_t* o0; bf16_t* o1;
  int mode;
};

template <int MODE>
DI void gemm_tile(const DevP& p, bf16_t* shm, const GemmCall& g, int pm, int pn, const int tid_, const int bid_) {
  constexpr bool CONV = (MODE >= M_FFN);
  constexpr int S = (MODE == M_ODD) ? 248 : 254, HALO = (MODE == M_ODD) ? 4 : 1;
  const int tid = tid_;
  const int K = g.K;
  int arow0, brow0, brow1;
  if (CONV) arow0 = pm * S - HALO; else arow0 = pm * 256;
  if (MODE == M_FFN) { brow0 = pn * 128; brow1 = FF + pn * 128; } else { brow0 = pn * 256; brow1 = pn * 256 + 128; }
  unsigned aoffv, boffv;
  { int r, c; stage_rc(tid * 16, r, c); aoffv = (unsigned)(r * g.lda + c) * 2u; boffv = (unsigned)(r * K + c) * 2u; }
  const long abase0 = (long)arow0 * g.lda, bbase0 = (long)brow0 * K, bbase1 = (long)brow1 * K;
  const bf16_t* gA = g.A; const bf16_t* gB = g.Bt; const int ksk = g.ksk, ksoff = g.ksoff;
  const int wvu = __builtin_amdgcn_readfirstlane(tid >> 6);
#define SA(b, h) (shm + ((b) * 2 + (h)) * HT)
#define SB(b, h) (shm + (4 + (b) * 2 + (h)) * HT)
#define STAGE_A(P, h, kt) do { const int _k = (kt); \
    const char* _b0 = uni_ptr((const char*)(gA + abase0 + (long)(h) * 128 * g.lda + _k * 64 + (_k >= ksk ? ksoff : 0))); \
    const char* _b1 = uni_ptr(_b0 + (long)128 * g.lda); \
    unsigned _o0 = aoffv; asm volatile("" : "+v"(_o0)); \
    __builtin_amdgcn_global_load_lds((const unsigned*)(_b0 + (size_t)_o0), (unsigned*)((char*)(P) + wvu * 1024), 16, 0, 0); \
    __builtin_amdgcn_global_load_lds((const unsigned*)(_b1 + (size_t)_o0), (unsigned*)((char*)(P) + wvu * 1024 + 8192), 16, 0, 0); } while (0)
#define STAGE_B(P, h, kt) do { \
    const char* _b0 = uni_ptr((const char*)(gB + ((h) ? bbase1 : bbase0) + (kt) * 64)); \
    const char* _b1 = uni_ptr(_b0 + (long)128 * K); \
    unsigned _o0 = boffv; asm volatile("" : "+v"(_o0)); \
    __builtin_amdgcn_global_load_lds((const unsigned*)(_b0 + (size_t)_o0), (unsigned*)((char*)(P) + wvu * 1024), 16, 0, 0); \
    __builtin_amdgcn_global_load_lds((const unsigned*)(_b1 + (size_t)_o0), (unsigned*)((char*)(P) + wvu * 1024 + 8192), 16, 0, 0); } while (0)
#define LDA(dst, b, h) for (int m = 0; m < 4; ++m) for (int k = 0; k < 2; ++k) \
    dst[m][k] = *reinterpret_cast<const bf16x8*>((char*)SA(b, h) + lds_byte(wr * 64 + m * 16 + fr, k * 32 + fq * 8))
#define LDB(dst, b, h) for (int n = 0; n < 2; ++n) for (int k = 0; k < 2; ++k) \
    dst[n][k] = *reinterpret_cast<const bf16x8*>((char*)SB(b, h) + lds_byte(wc * 32 + n * 16 + fr, k * 32 + fq * 8))
#define MMA(ai, bj, At, Bx) do { __builtin_amdgcn_s_setprio(1); \
    for (int m = 0; m < 4; ++m) for (int n = 0; n < 2; ++n) for (int k = 0; k < 2; ++k) \
      acc[ai][bj][m][n] = __builtin_amdgcn_mfma_f32_16x16x32_bf16(Bx[n][k], At[m][k], acc[ai][bj][m][n], 0, 0, 0); \
    __builtin_amdgcn_s_setprio(0); } while (0)

  const int wid = tid >> 6, lane = tid & 63, wr = wid >> 2, wc = wid & 3, fr = lane & 15, fq = lane >> 4;
  f32x4 acc[2][2][4][2] = {};
  bf16x8 At[4][2], B0[2][2], B1[2][2];
  const int nt = K / 64;
  STAGE_B(SB(0, 0), 0, 0); STAGE_A(SA(0, 0), 0, 0);
  STAGE_B(SB(0, 1), 1, 0); STAGE_A(SA(0, 1), 1, 0);
  if (wr == 1) BAR;
  WAIT_V(4); BAR;
  STAGE_B(SB(1, 0), 0, 1); STAGE_A(SA(1, 0), 0, 1); STAGE_B(SB(1, 1), 1, 1);
  WAIT_V(6); BAR;
  for (int t = 0; t < nt; t += 2) {
    const int t1 = t + 1, t2 = (t + 2 < nt) ? t + 2 : nt - 1, t3 = (t + 3 < nt) ? t + 3 : nt - 1;
    LDB(B0, 0, 0); SCHED; LDA(At, 0, 0); STAGE_A(SA(1, 1), 1, t1);
    WAIT_L(8); BAR; WAIT_L(0); MMA(0, 0, At, B0); BAR; SCHED;
    LDB(B1, 0, 1); STAGE_B(SB(0, 0), 0, t2);
    BAR; WAIT_L(0); MMA(0, 1, At, B1); BAR;
    LDA(At, 0, 1); STAGE_A(SA(0, 0), 0, t2);
    BAR; WAIT_L(0); MMA(1, 0, At, B0); BAR; SCHED;
    STAGE_B(SB(0, 1), 1, t2);
    WAIT_V(6); BAR; MMA(1, 1, At, B1); BAR;
    LDB(B0, 1, 0); SCHED; LDA(At, 1, 0); STAGE_A(SA(0, 1), 1, t2);
    WAIT_L(8); BAR; WAIT_L(0); MMA(0, 0, At, B0); BAR; SCHED;
    LDB(B1, 1, 1); STAGE_B(SB(1, 0), 0, t3);
    BAR; WAIT_L(0); MMA(0, 1, At, B1); BAR;
    LDA(At, 1, 1); STAGE_A(SA(1, 0), 0, t3);
    BAR; WAIT_L(0); MMA(1, 0, At, B0); BAR; SCHED;
    STAGE_B(SB(1, 1), 1, t3);
    WAIT_V(6); BAR; MMA(1, 1, At, B1); BAR;
  }
  WAIT_V(0);
  if (wr == 0) BAR;
#undef SA
#undef SB
#undef STAGE_A
#undef STAGE_B
#undef LDA
#undef LDB
#undef MMA
  if (PROBE_MASK != 0 && p.dry && MODE != M_RES) { __syncthreads(); return; }
  int te = tid; asm volatile("" : "+v"(te));
  const int ewr = te >> 8, ewc = (te >> 6) & 3, efr = te & 15, efq = (te & 63) >> 4;
  if (MODE == M_RES) {
    int mi; (void)xrow(p, pm * 256, mi);
    const float* gate = g.mod + mi * 6144 + g.msel * 1024;
    f32x4 gv[4], bb[4];
#pragma unroll
    for (int k = 0; k < 4; ++k) {
      const int col = pn * 256 + (k >> 1) * 128 + ewc * 32 + (k & 1) * 16 + efq * 4;
      gv[k] = *(const f32x4*)(gate + col);
      bb[k] = g.bias ? *(const f32x4*)(g.bias + col) : (f32x4){0.f, 0.f, 0.f, 0.f};
    }
#pragma unroll
    for (int ai = 0; ai < 2; ++ai)
#pragma unroll
      for (int mh = 0; mh < 4; mh += 2) {
        f32x4 xv[2][4]; float* xps[2];
#pragma unroll
        for (int m = 0; m < 2; ++m) {
          int mi2; xps[m] = xrow(p, pm * 256 + ai * 128 + ewr * 64 + (mh + m) * 16 + efr, mi2);
#pragma unroll
          for (int k = 0; k < 4; ++k) xv[m][k] = *(const f32x4*)(xps[m] + pn * 256 + (k >> 1) * 128 + ewc * 32 + (k & 1) * 16 + efq * 4);
        }
#pragma unroll
        for (int m = 0; m < 2; ++m)
#pragma unroll
          for (int k = 0; k < 4; ++k) {
            const f32x4 x = xv[m][k] + gv[k] * (acc[ai][k >> 1][mh + m][k & 1] + bb[k]);
            if (!p.dry) *(f32x4*)(xps[m] + pn * 256 + (k >> 1) * 128 + ewc * 32 + (k & 1) * 16 + efq * 4) = x;
          }
      }
    __syncthreads();
  } else if (MODE == M_LORA) {
    f32x4 cvs[4];
#pragma unroll
    for (int k = 0; k < 4; ++k) { const int col = pn * 256 + (k >> 1) * 128 + ewc * 32 + (k & 1) * 16 + efq * 4;
      cvs[k] = (f32x4){0.f, 0.f, 0.f, 0.f};
      if (col < 1024) cvs[k] = *(const f32x4*)(g.e0 + col); else if (col < 2048) cvs[k] = *(const f32x4*)(g.e1 + col - 1024); }
#pragma unroll
    for (int bj = 0; bj < 2; ++bj)
#pragma unroll
      for (int n = 0; n < 2; ++n) {
        const int col = pn * 256 + bj * 128 + ewc * 32 + n * 16 + efq * 4;
        const f32x4 cv = cvs[bj * 2 + n];
#pragma unroll
        for (int ai = 0; ai < 2; ++ai)
#pragma unroll
          for (int m = 0; m < 4; ++m) {
            const int row = pm * 256 + ai * 128 + ewr * 64 + m * 16 + efr;
            f32x4 a = acc[ai][bj][m][n];
            float o[4];
#pragma unroll
            for (int j = 0; j < 4; ++j) {
              float v = a[j] + cv[j];
              if (col < 1024) o[j] = 0.6065306597126334f * __builtin_amdgcn_rcpf(1.f + __expf(-v));
              else if (col < 2048) o[j] = __builtin_amdgcn_rcpf(1.f + __expf(-v));
              else o[j] = v;
            }
            uint2 pk = {pack2(o[0], o[1]), pack2(o[2], o[3])};
            *(uint2*)(g.o0 + (size_t)row * LOW + col) = pk;
          }
      }
    __syncthreads();
  } else {
    __syncthreads();
    bf16_t* T = shm;
#pragma unroll
    for (int bj = 0; bj < 2; ++bj)
#pragma unroll
      for (int n = 0; n < 2; ++n) {
        const int col = bj * 128 + ewc * 32 + n * 16 + efq * 4;
        f32x4 bv = {0.f, 0.f, 0.f, 0.f};
        if (MODE == M_ODD) bv = *(const f32x4*)(g.bias + pn * 256 + col);
#pragma unroll
        for (int ai = 0; ai < 2; ++ai)
#pragma unroll
          for (int m = 0; m < 4; ++m) {
            const int row = ai * 128 + ewr * 64 + m * 16 + efr;
            f32x4 a = acc[ai][bj][m][n] + bv;
            uint2 pk = {pack2(a[0], a[1]), pack2(a[2], a[3])};
            *(uint2*)(T + row * TP + col) = pk;
          }
      }
    float wg[3][8], bg[8], wv[3][8], bvv[8];
    if (MODE == M_FFN) {
      const int gc_ = pn * 128 + (te & 15) * 8;
#pragma unroll
      for (int e = 0; e < 8; ++e) {
#pragma unroll
        for (int q = 0; q < 3; ++q) { wg[q][e] = g.e0[q * FF2 + gc_ + e]; wv[q][e] = g.e0[q * FF2 + FF + gc_ + e]; }
        bg[e] = g.e1[gc_ + e]; bvv[e] = g.e1[FF + gc_ + e];
      }
    }
    __syncthreads();
    if (MODE == M_FFN) {
      const int cg8 = (te & 15) * 8, rsub = te >> 4;
      const int gc = pn * 128 + cg8;
      for (int i = HALO + rsub; i < HALO + S; i += 32) {
        const int grow = pm * S + (i - HALO);
        if (grow >= g.M) break;
        uint4 gp = *(const uint4*)(T + (i - 1) * TP + cg8), gcn = *(const uint4*)(T + i * TP + cg8), gn = *(const uint4*)(T + (i + 1) * TP + cg8);
        uint4 vp = *(const uint4*)(T + (i - 1) * TP + 128 + cg8), vc = *(const uint4*)(T + i * TP + 128 + cg8), vn = *(const uint4*)(T + (i + 1) * TP + 128 + cg8);
        const uint4 zz = {0u, 0u, 0u, 0u};
        const int sq = grow - (grow / TPB) * TPB;
        if (sq == 0 || sq == CTXL) { gp = zz; vp = zz; }
        if (sq == CTXL - 1 || sq == TPB - 1) { gn = zz; vn = zz; }
        const unsigned* gpa = (const unsigned*)&gp; const unsigned* gca = (const unsigned*)&gcn; const unsigned* gna = (const unsigned*)&gn;
        const unsigned* vpa = (const unsigned*)&vp; const unsigned* vca = (const unsigned*)&vc; const unsigned* vna = (const unsigned*)&vn;
        float o[8];
#pragma unroll
        for (int e = 0; e < 8; ++e) {
          const int w = e >> 1;
          const float a0 = (e & 1) ? hi16(gpa[w]) : lo16(gpa[w]), a1 = (e & 1) ? hi16(gca[w]) : lo16(gca[w]), a2 = (e & 1) ? hi16(gna[w]) : lo16(gna[w]);
          const float b0 = (e & 1) ? hi16(vpa[w]) : lo16(vpa[w]), b1 = (e & 1) ? hi16(vca[w]) : lo16(vca[w]), b2 = (e & 1) ? hi16(vna[w]) : lo16(vna[w]);
          const float gg = wg[0][e] * a0 + (wg[1][e] * a1 + (wg[2][e] * a2 + bg[e]));
          const float vv = wv[0][e] * b0 + (wv[1][e] * b1 + (wv[2][e] * b2 + bvv[e]));
          o[e] = gg * __builtin_amdgcn_rcpf(1.f + __expf(-gg)) * vv;
        }
        uint4 pk = {pack2(o[0], o[1]), pack2(o[2], o[3]), pack2(o[4], o[5]), pack2(o[6], o[7])};
        *(uint4*)(g.o0 + (size_t)grow * FF + gc) = pk;
      }
    } else if (MODE == M_EVEN) {
      const int cg8 = (te & 31) * 8, rsub = te >> 5;
      const int col = pn * 256 + cg8;
      if (col < EVEN_IN) {
        float mp[8], mn[8];
#pragma unroll
        for (int e = 0; e < 8; ++e) { mp[e] = col < A_IN ? g.e0[col + e] : 0.f; mn[e] = col < A_IN ? g.e1[col + e] : 0.f; }
        for (int i = HALO + rsub; i < HALO + S; i += 16) {
          const int grow = pm * S + (i - HALO);
          if (grow >= g.M) break;
          const int sq = grow - (grow / TPB) * TPB;
          const float pv = (sq == 0 || sq == CTXL) ? 0.f : 1.f, nv = (sq == CTXL - 1 || sq == TPB - 1) ? 0.f : 1.f;
          uint4 tp = *(const uint4*)(T + (i - 1) * TP + cg8), tc = *(const uint4*)(T + i * TP + cg8), tn = *(const uint4*)(T + (i + 1) * TP + cg8);
          const unsigned* tpa = (const unsigned*)&tp; const unsigned* tca = (const unsigned*)&tc; const unsigned* tna = (const unsigned*)&tn;
          float o[8];
#pragma unroll
          for (int e = 0; e < 8; ++e) {
            const int w = e >> 1;
            float a0 = ((e & 1) ? hi16(tpa[w]) : lo16(tpa[w])) * pv, a1 = (e & 1) ? hi16(tca[w]) : lo16(tca[w]), a2 = ((e & 1) ? hi16(tna[w]) : lo16(tna[w])) * nv;
            float z = a1 + mp[e] * (a0 - a1) + mn[e] * (a2 - a1);
            if (col >= 1536 && col < 1664) z = 1.f - 2.f / (1.f + __expf(2.f * z));
            else if (col >= 1792 && col < 1920) z = sigmoidf_(z);
            o[e] = z;
          }
          uint4 pk = {pack2(o[0], o[1]), pack2(o[2], o[3]), pack2(o[4], o[5]), pack2(o[6], o[7])};
          if (col >= 1536 && col < 1920) *(uint4*)(g.o1 + (size_t)grow * LW + (col - 1536)) = pk;
          else *(uint4*)(g.o0 + (size_t)grow * PW + col) = pk;
        }
      }
    } else {
      const int rgs = te & 3, csub = te >> 2;
#pragma unroll 1
      for (int cp = 0; cp < 2; ++cp) {
        const int cl = cp * 128 + csub, col = pn * 256 + cl;
        const float w0 = g.e0[col], w1 = g.e0[HY3 + col], w2 = g.e0[2 * HY3 + col], cb = g.e1[col];
#pragma unroll 1
        for (int rg = rgs; rg < 31; rg += 4) {
          const int grow0 = pm * S + rg * 8;
          if (grow0 >= g.M) break;
          const int i0 = HALO + rg * 8;
          float tv[10];
#pragma unroll
          for (int q = 0; q < 10; ++q) tv[q] = bf2f(T[(i0 - 1 + q) * TP + cl]);
          const int b = grow0 / TPB, s0 = grow0 - b * TPB;
          if (s0 == 0 || s0 == CTXL) tv[0] = 0.f;
          if (s0 + 8 == CTXL || s0 + 8 == TPB) tv[9] = 0.f;
          float o[8];
#pragma unroll
          for (int q = 0; q < 8; ++q) o[q] = w0 * tv[q] + (w1 * tv[q + 1] + (w2 * tv[q + 2] + cb));
          uint4 pk = {pack2(o[0], o[1]), pack2(o[2], o[3]), pack2(o[4], o[5]), pack2(o[6], o[7])};
          *(uint4*)(g.o0 + ((size_t)(b * HY3 + col)) * TPB + s0) = pk;
        }
      }
    }
    __syncthreads();
  }
}

template <int MODE>
DI void gemm_phase(const DevP& p, bf16_t* shm, const GemmCall& g, int nM, int nN, const int tid_, const int bid_) {
  const int total = nM * nN, share = (total + 7) >> 3, xcd = bid_ & 7, lb = bid_ >> 3, nlb = (int)gridDim.x >> 3;
  const int lend = min((xcd + 1) * share, total), nig = 8 * nN;
  for (int L = xcd * share + lb; L < lend; L += nlb) {
    const int gid = L / nig, fm = gid * 8, gsz = min(nM - fm, 8), wi = L - gid * nig;
    gemm_tile<MODE>(p, shm, g, fm + wi % gsz, wi / gsz, tid_, bid_);
  }
}

DI void wconv(const float* src, int K, int N, bf16_t* dst, float* sh, const int tid_, const int bid_, const int nwk_) {
  const int tid = tid_, tk = K / 64, tn = N / 64, ntile = tk * tn;
  const int kk0 = tid >> 4, nn4 = (tid & 15) * 4;
  int it = bid_;
  f32x4 v0 = {0.f, 0.f, 0.f, 0.f}, v1 = v0;
  if (it < ntile) { const int k0 = (it / tn) * 64, n0 = (it % tn) * 64;
    v0 = *(const f32x4*)(src + (size_t)(k0 + kk0) * N + n0 + nn4); v1 = *(const f32x4*)(src + (size_t)(k0 + kk0 + 32) * N + n0 + nn4); }
  while (it < ntile) {
    const int k0 = (it / tn) * 64, n0 = (it % tn) * 64;
    sh[kk0 * 65 + nn4] = v0[0]; sh[kk0 * 65 + nn4 + 1] = v0[1]; sh[kk0 * 65 + nn4 + 2] = v0[2]; sh[kk0 * 65 + nn4 + 3] = v0[3];
    sh[(kk0 + 32) * 65 + nn4] = v1[0]; sh[(kk0 + 32) * 65 + nn4 + 1] = v1[1]; sh[(kk0 + 32) * 65 + nn4 + 2] = v1[2]; sh[(kk0 + 32) * 65 + nn4 + 3] = v1[3];
    __syncthreads();
    const int itn = it + nwk_;
    if (itn < ntile) { const int k1 = (itn / tn) * 64, n1 = (itn % tn) * 64;
      v0 = *(const f32x4*)(src + (size_t)(k1 + kk0) * N + n1 + nn4); v1 = *(const f32x4*)(src + (size_t)(k1 + kk0 + 32) * N + n1 + nn4); }
    { const int nn = tid >> 3, kp = (tid & 7) * 8;
      uint4 pk = {pack2(sh[kp * 65 + nn], sh[(kp + 1) * 65 + nn]), pack2(sh[(kp + 2) * 65 + nn], sh[(kp + 3) * 65 + nn]),
                  pack2(sh[(kp + 4) * 65 + nn], sh[(kp + 5) * 65 + nn]), pack2(sh[(kp + 6) * 65 + nn], sh[(kp + 7) * 65 + nn])};
      *(uint4*)(dst + (size_t)(n0 + nn) * K + k0 + kp) = pk; }
    __syncthreads();
    it = itn;
  }
}

DI void norm_phase(const DevP& p, int layer, int which, const int tid_, const int bid_) {
  const float* gw = pin(p, which ? I_N2G : I_N1G) + layer * DM;
  const float* mod = (const float*)(p.ws + OFF_MOD) + (size_t)layer * 9 * 6144;
  bf16_t* H = (bf16_t*)(p.ws + OFF_H);
  const int lane = tid_ & 63, gw_id = bid_ * 8 + (tid_ >> 6), nw = gridDim.x * 8;
  for (int row0 = gw_id; row0 < MROWS; row0 += 2 * nw) {
    const int row1 = row0 + nw; const bool has1 = row1 < MROWS;
    int mi0, mi1; const float* xp0 = xrow(p, row0, mi0); const float* xp1 = xrow(p, has1 ? row1 : row0, mi1);
    f32x4 v0[4], v1[4]; float ss0 = 0.f, ss1 = 0.f;
#pragma unroll
    for (int q = 0; q < 4; ++q) { v0[q] = *(const f32x4*)(xp0 + q * 256 + lane * 4); v1[q] = *(const f32x4*)(xp1 + q * 256 + lane * 4); }
#pragma unroll
    for (int q = 0; q < 4; ++q) { ss0 += v0[q][0] * v0[q][0] + v0[q][1] * v0[q][1] + v0[q][2] * v0[q][2] + v0[q][3] * v0[q][3];
                                  ss1 += v1[q][0] * v1[q][0] + v1[q][1] * v1[q][1] + v1[q][2] * v1[q][2] + v1[q][3] * v1[q][3]; }
    ss0 = wave_sum(ss0, lane); ss1 = wave_sum(ss1, lane);
    const float rstd0 = rsqrtf(ss0 * (1.f / DM) + 1e-6f), rstd1 = rsqrtf(ss1 * (1.f / DM) + 1e-6f);
    const float* sh0 = mod + mi0 * 6144 + (which ? 3 : 0) * 1024; const float* sh1 = mod + mi1 * 6144 + (which ? 3 : 0) * 1024;
#pragma unroll
    for (int q = 0; q < 4; ++q) {
      const int c = q * 256 + lane * 4;
      const f32x4 gg = *(const f32x4*)(gw + c);
      { const f32x4 s1 = *(const f32x4*)(sh0 + 1024 + c), s0 = *(const f32x4*)(sh0 + c); float o[4];
#pragma unroll
        for (int j = 0; j < 4; ++j) o[j] = v0[q][j] * rstd0 * gg[j] * (1.f + s1[j]) + s0[j];
        uint2 pk = {pack2(o[0], o[1]), pack2(o[2], o[3])};
        *(uint2*)(H + (size_t)row0 * DM + c) = pk; }
      if (has1) { const f32x4 s1 = *(const f32x4*)(sh1 + 1024 + c), s0 = *(const f32x4*)(sh1 + c); float o[4];
#pragma unroll
        for (int j = 0; j < 4; ++j) o[j] = v1[q][j] * rstd1 * gg[j] * (1.f + s1[j]) + s0[j];
        uint2 pk = {pack2(o[0], o[1]), pack2(o[2], o[3])};
        *(uint2*)(H + (size_t)row1 * DM + c) = pk; }
    }
  }
}

DI void phase_setup(const DevP& p, char* shmc, const int tid_, const int bid_) {
  const int tid = tid_;
  const size_t gtid = (size_t)bid_ * NTHR + tid, gn = (size_t)gridDim.x * NTHR;
  { const f32x4* s = (const f32x4*)pin(p, I_X); f32x4* d = (f32x4*)p.out; const size_t n = (size_t)NB * SEQ * DM / 4;
    { size_t i = gtid;
      for (; i + 3 * gn < n; i += 4 * gn) { const f32x4 a0 = s[i], a1 = s[i + gn], a2 = s[i + 2 * gn], a3 = s[i + 3 * gn]; d[i] = a0; d[i + gn] = a1; d[i + 2 * gn] = a2; d[i + 3 * gn] = a3; }
      for (; i < n; i += gn) d[i] = s[i]; }
    const f32x4* s2 = (const f32x4*)pin(p, I_CTX); f32x4* d2 = (f32x4*)(p.ws + OFF_XC); const size_t n2 = (size_t)NB * CTXL * DM / 4;
    for (size_t i = gtid; i < n2; i += gn) d2[i] = s2[i]; }
  { float2* tw = (float2*)(p.ws + OFF_TW);
    for (size_t i = gtid; i < 4096; i += gn) { float sn, cs; sincospif((float)i / 4096.f, &sn, &cs); tw[i] = make_float2(cs, -sn); }
    float2* rp = (float2*)(p.ws + OFF_ROPE);
    for (size_t i = gtid; i < 4096 * 32; i += gn) { int t = (int)(i >> 5), f = (int)(i & 31); float pos = (f < 16) ? (float)(t / 64) : (float)(t % 64);
      float inv = powf(10000.f, -(float)(f & 15) / 16.f); float a = pos * inv; rp[i] = make_float2(cosf(a), sinf(a)); } }
  { float* sc = (float*)shmc;
    float* red = sc + 9 * 1024;
    for (int i = tid; i < 9 * 1024; i += NTHR) { int mi = i >> 10, k = i & 1023; float v = (mi < 8) ? pin(p, I_C)[mi * 1024 + k] : pin(p, I_CCTX)[k]; sc[i] = siluf_(v); }
    __syncthreads();
    float* mod = (float*)(p.ws + OFF_MOD);
    float* red2 = sc + 9 * 1024;
    for (int it = bid_; it < 4 * 48; it += gridDim.x) {
      const int l = it / 48, c0 = (it % 48) * 128, n4 = (tid & 31) * 4, ks = tid >> 5;
      const float* w = pin(p, I_ADAW) + (size_t)l * 1024 * 6144 + c0 + n4;
      f32x4 a[9];
#pragma unroll
      for (int q = 0; q < 9; ++q) a[q] = (f32x4){0.f, 0.f, 0.f, 0.f};
#pragma unroll 8
      for (int k = ks * 64; k < ks * 64 + 64; ++k) { const f32x4 wv = *(const f32x4*)(w + (size_t)k * 6144);
#pragma unroll
        for (int q = 0; q < 9; ++q) a[q] += sc[q * 1024 + k] * wv; }
#pragma unroll
      for (int q = 0; q < 9; ++q) *(f32x4*)(red2 + (ks * 9 + q) * 128 + n4) = a[q];
      __syncthreads();
      for (int o = tid; o < 9 * 128; o += NTHR) { const int q = o >> 7, c = o & 127; float sum = 0.f;
#pragma unroll
        for (int k2 = 0; k2 < 16; ++k2) sum += red2[(k2 * 9 + q) * 128 + c];
        mod[((size_t)l * 9 + q) * 6144 + c0 + c] = sum + pin(p, I_ADAB)[l * 6144 + c0 + c]; }
      __syncthreads();
    }
  }
  { float* scr = (float*)shmc + (tid >> 6) * 128;
    const int lane = tid & 63, gw_id = bid_ * 8 + (tid >> 6), nw = gridDim.x * 8;
    for (int r = gw_id; r < 2 * (4096 + 256); r += nw) {
      const int j = r / 4352, rr = r % 4352, type = rr >= 4096, i = type ? rr - 4096 : rr, n = type ? 256 : 4096;
      const float tpos = (float)i / (float)(n - 1), ang = 6.283185307179586f * (float)i / (float)n;
      float z = 0.f;
      if (lane == 0) z = tpos;
      else if (lane <= 32) { int e = (lane - 1) & 15; float f = 1e-4f + (float)e * ((15.f - 1e-4f) / 15.f); z = (lane <= 16) ? cosf(f * ang) : -sinf(f * ang); }
      scr[lane] = z;
      __builtin_amdgcn_wave_barrier();
      const float fr = pin(p, I_OFREQ)[j * 64 + lane];
      float a = pin(p, I_OFB1)[j * 64 + lane];
      { const float* W = pin(p, I_OFW1) + (size_t)j * 33 * 64 + lane; float wr_[33];
#pragma unroll
        for (int e = 0; e < 33; ++e) wr_[e] = W[e * 64];
        __builtin_amdgcn_sched_barrier(0);
#pragma unroll
        for (int e = 0; e < 33; ++e) a += scr[e] * wr_[e]; }
      float h = sinf(fr * a);
      scr[64 + lane] = h;
      __builtin_amdgcn_wave_barrier();
      a = pin(p, I_OFB2)[j * 64 + lane];
      { const float* W = pin(p, I_OFW2) + (size_t)j * 64 * 64 + lane;
#pragma unroll
        for (int e0 = 0; e0 < 64; e0 += 32) { float wr_[32];
#pragma unroll
          for (int e = 0; e < 32; ++e) wr_[e] = W[(e0 + e) * 64];
          __builtin_amdgcn_sched_barrier(0);
#pragma unroll
          for (int e = 0; e < 32; ++e) a += scr[64 + e0 + e] * wr_[e]; } }
      h = sinf(fr * a);
      __builtin_amdgcn_wave_barrier();
      scr[lane] = h;
      __builtin_amdgcn_wave_barrier();
      a = pin(p, I_OFB3)[j * 64 + lane];
      { const float* W = pin(p, I_OFW3) + (size_t)j * 64 * 64 + lane;
#pragma unroll
        for (int e0 = 0; e0 < 64; e0 += 32) { float wr_[32];
#pragma unroll
          for (int e = 0; e < 32; ++e) wr_[e] = W[(e0 + e) * 64];
          __builtin_amdgcn_sched_barrier(0);
#pragma unroll
          for (int e = 0; e < 32; ++e) a += scr[e0 + e] * wr_[e]; } }
      h = sinf(fr * a);
      float* dst = type ? (float*)(p.ws + OFF_HDNC) + ((size_t)j * 256 + i) * 64 : (float*)(p.ws + OFF_HDNL) + ((size_t)j * 4096 + i) * 64;
      dst[lane] = h;
      __builtin_amdgcn_wave_barrier();
    }
  }
}

DI void phase_taps(const DevP& p, int j, char* shmc, const int tid_, const int bid_, const int nwk_);
DI void convert_layer(const DevP& p, int layer, bf16_t* wt, char* shmc, const int tid_, const int bid_, const int nwk_, const int parts) {
  float* sh = (float*)shmc;
  const int j = layer >> 1;
  if ((layer & 1) == 0) { if (parts & 1) {
    wconv(pin(p, I_EWIN) + (size_t)j * DM * EVEN_IN, DM, EVEN_IN, wt + WT_WIN, sh, tid_, bid_, nwk_);
    {
      unsigned* z = (unsigned*)(wt + WT_WIN + (size_t)EVEN_IN * DM);
      for (size_t i = (size_t)bid_ * NTHR + tid_; i < (size_t)128 * DM / 2; i += (size_t)nwk_ * NTHR) z[i] = 0u; }
    wconv(pin(p, I_EWOUT) + (size_t)j * DM * DM, DM, DM, wt + WT_WOUT, sh, tid_, bid_, nwk_);
    {
      bf16_t* lb = wt + WT_LORA;
      for (size_t i = (size_t)bid_ * NTHR + tid_; i < (size_t)LOW * LW; i += (size_t)nwk_ * NTHR) {
        const int n = (int)(i / LW), k = (int)(i % LW); float v = 0.f;
        if (n < 512) { if (k < 64) v = pin(p, I_EW2)[(((size_t)j * 2 + 0) * 64 + k) * 512 + n]; }
        else if (n < 1024) { if (k >= 64 && k < 128) v = pin(p, I_EW2)[(((size_t)j * 2 + 1) * 64 + (k - 64)) * 512 + (n - 512)]; }
        else if (n < 1536) { if (k >= 128 && k < 192) v = pin(p, I_EA2)[(((size_t)j * 2 + 0) * 64 + (k - 128)) * 512 + (n - 1024)]; }
        else if (n < 2048) { if (k >= 192 && k < 256) v = pin(p, I_EA2)[(((size_t)j * 2 + 1) * 64 + (k - 192)) * 512 + (n - 1536)]; }
        else { if (k >= 256) v = pin(p, I_EG2)[((size_t)j * 128 + (k - 256)) * 512 + (n - 2048)]; }
        lb[i] = f2bf(v);
      } }
  } } else {
    if (parts & 1) {
    wconv(pin(p, I_OWIN) + (size_t)j * DM * HY3, DM, HY3, wt + WT_WIN, sh, tid_, bid_, nwk_);
    wconv(pin(p, I_OWOUT) + (size_t)j * DM * DM, DM, DM, wt + WT_WOUT, sh, tid_, bid_, nwk_); }
    if (parts & 2) phase_taps(p, j, shmc, tid_, bid_, nwk_);
  }
  if (parts & 4) {
  wconv(pin(p, I_FUP) + (size_t)layer * DM * FF2, DM, FF2, wt + WT_WUP, sh, tid_, bid_, nwk_);
  wconv(pin(p, I_FDN) + (size_t)layer * FF * DM, FF, DM, wt + WT_WDN, sh, tid_, bid_, nwk_); }
}
DI void phase_start(const DevP& p, int layer, char* shmc, const int tid_, const int bid_) {
  norm_phase(p, layer, 0, tid_, bid_);
  if (layer == 0) convert_layer(p, 0, (bf16_t*)(p.ws + OFF_WT), shmc, tid_, bid_, (int)gridDim.x, 7);
}

DI void phase_qkprep(const DevP& p, int j, const int tid_, const int bid_) {
  bf16_t* P = (bf16_t*)(p.ws + OFF_BIG);
  float* KN = (float*)(p.ws + OFF_KN);
  const float2* rope = (const float2*)(p.ws + OFF_ROPE);
  const int l16 = tid_ & 15;
  const int g0 = (bid_ * NTHR + tid_) >> 4, gs = ((int)gridDim.x * NTHR) >> 4;
  const float* gq = pin(p, I_EQN) + j * 64; const float* gk = pin(p, I_EKN) + j * 64;
  const float gq0 = gq[2 * l16], gq1 = gq[2 * l16 + 1], gq2 = gq[32 + 2 * l16], gq3 = gq[33 + 2 * l16];
  const float gk0 = gk[2 * l16], gk1 = gk[2 * l16 + 1], gk2 = gk[32 + 2 * l16], gk3 = gk[33 + 2 * l16];
  for (int row = g0; row < MROWS; row += gs) {
    const int s = row % TPB, t = s >= CTXL ? s - CTXL : 0;
    bf16_t* base = P + (size_t)row * PW;
    unsigned u0[10], u1[10]; uint2 uk[8]; f32x4 kkw[8];
#pragma unroll
    for (int q = 0; q < 10; ++q) { u0[q] = *(const unsigned*)(base + A_IN + q * 64 + 2 * l16); u1[q] = *(const unsigned*)(base + A_IN + q * 64 + 32 + 2 * l16); }
#pragma unroll
    for (int h = 0; h < 8; ++h) { uk[h] = *(const uint2*)(base + 512 + h * 64 + 4 * l16); kkw[h] = *(const f32x4*)(pin(p, I_EKK) + j * 512 + h * 64 + 4 * l16); }
    const float2 c0 = rope[t * 32 + 2 * l16], c1 = rope[t * 32 + 2 * l16 + 1];
#pragma unroll
    for (int q = 0; q < 10; ++q) {
      float a0 = lo16(u0[q]), a1 = hi16(u0[q]), b0 = lo16(u1[q]), b1 = hi16(u1[q]);
      const float ss = sum16(a0 * a0 + a1 * a1 + b0 * b0 + b1 * b1);
      const float rstd = rsqrtf(ss * (1.f / 64.f) + 1e-6f);
      a0 = a0 * rstd * (q < 8 ? gq0 : gk0); a1 = a1 * rstd * (q < 8 ? gq1 : gk1); b0 = b0 * rstd * (q < 8 ? gq2 : gk2); b1 = b1 * rstd * (q < 8 ? gq3 : gk3);
      if (s >= CTXL) {
        const float na0 = a0 * c0.x - b0 * c0.y, nb0 = a0 * c0.y + b0 * c0.x, na1 = a1 * c1.x - b1 * c1.y, nb1 = a1 * c1.y + b1 * c1.x;
        a0 = na0; b0 = nb0; a1 = na1; b1 = nb1;
      }
      *(unsigned*)(base + A_IN + q * 64 + 2 * l16) = pack2(a0, a1); *(unsigned*)(base + A_IN + q * 64 + 32 + 2 * l16) = pack2(b0, b1);
    }
#pragma unroll
    for (int h = 0; h < 8; ++h) {
      const float a0 = lo16(uk[h].x) * kkw[h][0], a1 = hi16(uk[h].x) * kkw[h][1], a2 = lo16(uk[h].y) * kkw[h][2], a3 = hi16(uk[h].y) * kkw[h][3];
      const float ss = sum16(a0 * a0 + a1 * a1 + a2 * a2 + a3 * a3);
      if (l16 == 0) KN[(size_t)row * 8 + h] = 1.f / fmaxf(sqrtf(ss), 1e-12f);
    }
  }
}

template <int CTRL> DI float dppf(float x) { return __builtin_bit_cast(float, __builtin_amdgcn_update_dpp(0, __builtin_bit_cast(int, x), CTRL, 0xf, 0xf, false)); }
DI void phase_scan(const DevP& p, int j, char* shmc, const int tid_, const int bid_) {
  const bf16_t* P = (const bf16_t*)(p.ws + OFF_BIG);
  const bf16_t* LO = (const bf16_t*)(p.ws + OFF_LO);
  const float* KN = (const float*)(p.ws + OFF_KN);
  bf16_t* Y = (bf16_t*)(p.ws + OFF_H);
  const int tid = tid_, l16 = tid & 15, rloc = tid >> 4;
  constexpr int TT = 32, STEPF = 5 * 64 + 32 + 4;
  constexpr int NSTEP = CTXL + SEQ, NCH = NSTEP / TT;
  float* buf = (float*)shmc;
  float* ybuf = buf + 2 * TT * STEPF;
  for (int u = bid_; u < 256; u += gridDim.x) {
    const int chain = u >> 1, half = u & 1, d = chain >> 6, b = (chain >> 3) & 7, h = chain & 7;
    f32x4 kkw = *(const f32x4*)(pin(p, I_EKK) + j * 512 + h * 64 + 4 * l16), kaw = *(const f32x4*)(pin(p, I_EKA) + j * 512 + h * 64 + 4 * l16);
    f32x4 S = {0.f, 0.f, 0.f, 0.f};
    float sa = 0.f;
    uint2 gr, gk, ge, ga, gv, gk2; float gkn, gkn2;
    auto rowof = [&](int g) -> int {
      g = g > NSTEP - 1 ? NSTEP - 1 : g;
      const int seg = g >= CTXL, st = seg ? g - CTXL : g, n = seg ? SEQ : CTXL, t = d ? (n - 1 - st) : st;
      return b * TPB + (seg ? CTXL + t : t);
    };
    auto gload = [&](int c) {
      const int row = rowof(c * TT + rloc), row2 = rowof(c * TT + rloc + 1);
      const bf16_t* pr = P + (size_t)row * PW + h * 64 + 4 * l16;
      gr = *(const uint2*)pr; gk = *(const uint2*)(pr + 512);
      gk2 = *(const uint2*)(P + (size_t)row2 * PW + 512 + h * 64 + 4 * l16);
      const bf16_t* lo = LO + (size_t)row * LOW + d * 512 + h * 64 + 4 * l16;
      ge = *(const uint2*)lo; ga = *(const uint2*)(lo + 1024);
      gkn = KN[(size_t)row * 8 + h]; gkn2 = KN[(size_t)row2 * 8 + h];
      if (l16 < 8) gv = *(const uint2*)(P + (size_t)row * PW + 1024 + h * 64 + half * 32 + 4 * l16);
    };
    auto lstore = [&](int bi) {
      float* dst = buf + ((size_t)bi * TT + rloc) * STEPF;
      float k4[4] = {lo16(gk.x), hi16(gk.x), lo16(gk.y), hi16(gk.y)}, e4[4] = {lo16(ge.x), hi16(ge.x), lo16(ge.y), hi16(ge.y)};
      float a4[4] = {lo16(ga.x), hi16(ga.x), lo16(ga.y), hi16(ga.y)}, n4[4] = {lo16(gk2.x), hi16(gk2.x), lo16(gk2.y), hi16(gk2.y)};
      f32x4 w, q, kka, kd, r = {lo16(gr.x), hi16(gr.x), lo16(gr.y), hi16(gr.y)};
      float c1 = 0.f, c2 = 0.f;
#pragma unroll
      for (int e = 0; e < 4; ++e) {
        w[e] = __expf(-e4[e]); const float kk = k4[e] * kkw[e] * gkn, kkn = n4[e] * kkw[e] * gkn2;
        kka[e] = kk * a4[e]; kd[e] = k4[e] * (1.f + (a4[e] - 1.f) * kaw[e]); q[e] = w[e] * kkn;
        c1 += kka[e] * kkn; c2 += kd[e] * kkn;
      }
      c1 = dpp_sum16(c1); c2 = dpp_sum16(c2);
      *(f32x4*)(dst + 0 + 4 * l16) = q; *(f32x4*)(dst + 64 + 4 * l16) = kka; *(f32x4*)(dst + 128 + 4 * l16) = kd; *(f32x4*)(dst + 192 + 4 * l16) = w; *(f32x4*)(dst + 256 + 4 * l16) = r;
      if (l16 < 8) { f32x4 v = {lo16(gv.x), hi16(gv.x), lo16(gv.y), hi16(gv.y)}; *(f32x4*)(dst + 320 + 4 * l16) = v; }
      if (l16 == 0) { dst[352] = c1; dst[353] = c2; }
    };
    __syncthreads();
    gload(0); lstore(0);
    __syncthreads();
    for (int c = 0; c < NCH; ++c) {
      if (c + 1 < NCH) gload(c + 1);
      const float* sb = buf + (size_t)(c & 1) * TT * STEPF;
      float* yb = ybuf + (c & 1) * TT * 32;
      f32x4 Lq[3], Lka[3], Lkd[3], Lw[3], Lr[3]; float Lv[3]; float2 Lc[3];
#define SCAN_LD(slot, st) do { const float* q_ = sb + (st) * STEPF; \
        Lq[slot] = *(const f32x4*)(q_ + 4 * l16); Lka[slot] = *(const f32x4*)(q_ + 64 + 4 * l16); Lkd[slot] = *(const f32x4*)(q_ + 128 + 4 * l16); \
        Lw[slot] = *(const f32x4*)(q_ + 192 + 4 * l16); Lr[slot] = *(const f32x4*)(q_ + 256 + 4 * l16); Lv[slot] = q_[320 + rloc]; Lc[slot] = *(const float2*)(q_ + 352); } while (0)
      SCAN_LD(0, 0); SCAN_LD(1, 1);
      float yp[16];
#pragma unroll
      for (int st = 0; st < TT; ++st) {
        if (st + 2 < TT) SCAN_LD((st + 2) % 3, st + 2);
        __builtin_amdgcn_sched_barrier(0);
        { const int sl_ = st % 3;
          const f32x4 qq = Lq[sl_], kka = Lka[sl_], kd = Lkd[sl_], w = Lw[sl_], r = Lr[sl_]; const float v = Lv[sl_]; const float2 cc = Lc[sl_];
          float pd = S[0] * qq[0] + S[1] * qq[1] + S[2] * qq[2] + S[3] * qq[3];
          pd = dpp_sum16(pd);
#pragma unroll
          for (int e = 0; e < 4; ++e) S[e] = S[e] * w[e] + sa * kka[e] + v * kd[e];
          sa = -pd - sa * cc.x - v * cc.y;
          yp[st & 15] = S[0] * r[0] + S[1] * r[1] + S[2] * r[2] + S[3] * r[3];
        }
        if ((st & 15) == 15) {
          const bool h8 = l16 & 8, h4 = l16 & 4, h2 = l16 & 2, h1 = l16 & 1;
#pragma unroll
          for (int k = 0; k < 8; ++k) { const float a = yp[k], bq = yp[k + 8]; yp[k] = (h8 ? bq : a) + dppf<0x128>(h8 ? a : bq); }
#pragma unroll
          for (int k = 0; k < 4; ++k) { const float a = yp[k], bq = yp[k + 4]; yp[k] = (h4 ? bq : a) + dppf<0x141>(h4 ? a : bq); }
#pragma unroll
          for (int k = 0; k < 2; ++k) { const float a = yp[k], bq = yp[k + 2]; yp[k] = (h2 ? bq : a) + dppf<0x4E>(h2 ? a : bq); }
          { const float a = yp[0], bq = yp[1]; yp[0] = (h1 ? bq : a) + dppf<0xB1>(h1 ? a : bq); }
          yb[((st - 15) + l16) * 32 + rloc] = yp[0];
        }
      }
#undef SCAN_LD
      if (c + 1 < NCH) lstore((c + 1) & 1);
      __syncthreads();
      {
        const int sl = tid >> 4, i2 = (tid & 15) * 2;
        const int row = rowof(c * TT + sl);
        *(unsigned*)(Y + ((size_t)d * MROWS + row) * 512 + h * 64 + half * 32 + i2) = pack2(yb[sl * 32 + i2], yb[sl * 32 + i2 + 1]);
      }
    }
    __syncthreads();
  }
}

DI void phase_attn(const DevP& p, int j, char* shmc, const int tid_, const int bid_) {
  bf16_t* P = (bf16_t*)(p.ws + OFF_BIG);
  constexpr int KP = 72;
  bf16_t* Ks = (bf16_t*)shmc;
  bf16_t* Vs = Ks + 2 * 64 * KP;
  const int tid = tid_, wid = tid >> 6, lane = tid & 63, fr = lane & 15, fq = lane >> 4;
  const int gh = wid & 3, th = wid >> 2;
  const float C2 = 0.125f * 1.4426950408889634f;
  for (int it = bid_; it < 544; it += gridDim.x) {
    int b, kvh, qb0, isctx;
    if (it < 512) { b = it >> 6; kvh = (it >> 5) & 1; qb0 = it & 31; isctx = 0; }
    else { int i2 = it - 512; b = i2 >> 2; kvh = (i2 >> 1) & 1; qb0 = i2 & 1; isctx = 1; }
    const int head = kvh * 4 + gh;
    const int tq0 = qb0 * 128 + th * 64;
    const int rowbase = b * TPB + (isctx ? 0 : CTXL);
    bf16x8 bq[4][2];
#pragma unroll
    for (int qb = 0; qb < 4; ++qb)
#pragma unroll
      for (int ds = 0; ds < 2; ++ds)
        bq[qb][ds] = *(const bf16x8*)(P + (size_t)(rowbase + tq0 + qb * 16 + fr) * PW + A_IN + head * 64 + ds * 32 + fq * 8);
    f32x4 O[4][4];
#pragma unroll
    for (int a = 0; a < 4; ++a)
#pragma unroll
      for (int c = 0; c < 4; ++c) O[a][c] = (f32x4){0.f, 0.f, 0.f, 0.f};
    const float sinkl = pin(p, I_ESINK)[j * 8 + head] * 1.4426950408889634f;
    float mrun[4], lrun[4];
#pragma unroll
    for (int qb = 0; qb < 4; ++qb) { mrun[qb] = sinkl; lrun[qb] = (fq == 0) ? 1.f : 0.f; }
    const int ntile = isctx ? 4 : 10;
    auto tile_row0 = [&](int ti, bool& valid, bool& lat) -> int {
      if (!isctx && ti < 6) { int kb = qb0 * 128 + (ti - 2) * 64; lat = true; valid = (kb >= 0 && kb < SEQ); return b * TPB + CTXL + kb; }
      int ci = isctx ? ti : ti - 6; lat = false; valid = true; return b * TPB + ci * 64;
    };
    uint4 kreg, vreg;
    const int lkey = tid >> 3, ldg = tid & 7;
    auto gl = [&](int ti) { bool v, l; int r0 = tile_row0(ti, v, l); if (v) {
        const bf16_t* src = P + (size_t)(r0 + lkey) * PW + A_IN + 512 + kvh * 64 + ldg * 8;
        kreg = *(const uint4*)src; vreg = *(const uint4*)(src + 128); } };
    auto ls = [&](int ti, int bi) { bool v, l; tile_row0(ti, v, l); if (v) {
        *(uint4*)(Ks + bi * 64 * KP + lkey * KP + ldg * 8) = kreg;
        bf16_t* vt = Vs + bi * 64 * KP; const unsigned* vr = (const unsigned*)&vreg;
#pragma unroll
        for (int e = 0; e < 8; ++e) vt[(ldg * 8 + e) * KP + lkey] = (bf16_t)((e & 1) ? (vr[e >> 1] >> 16) : (vr[e >> 1] & 0xffffu)); } };
    __syncthreads();
    gl(0); ls(0, 0);
    __syncthreads();
    for (int ti = 0; ti < ntile; ++ti) {
      if (ti + 1 < ntile) gl(ti + 1);
      bool valid, lat; const int r0 = tile_row0(ti, valid, lat);
      bool work = valid;
      const int kt0 = lat ? (r0 - (b * TPB + CTXL)) : 0;
      if (lat && (kt0 + 63 < tq0 - 128 || kt0 > tq0 + 63 + 128)) work = false;
      if (work) {
        const bf16_t* kt = Ks + (ti & 1) * 64 * KP; const bf16_t* vt = Vs + (ti & 1) * 64 * KP;
        f32x4 Sx[4][4];
#pragma unroll
        for (int kb = 0; kb < 4; ++kb) {
          bf16x8 ak0 = *(const bf16x8*)(kt + (kb * 16 + fr) * KP + fq * 8), ak1 = *(const bf16x8*)(kt + (kb * 16 + fr) * KP + 32 + fq * 8);
#pragma unroll
          for (int qb = 0; qb < 4; ++qb) {
            f32x4 s = {0.f, 0.f, 0.f, 0.f};
            s = __builtin_amdgcn_mfma_f32_16x16x32_bf16(ak0, bq[qb][0], s, 0, 0, 0);
            s = __builtin_amdgcn_mfma_f32_16x16x32_bf16(ak1, bq[qb][1], s, 0, 0, 0);
            Sx[kb][qb] = s;
          }
        }
        bf16x8 pb[4][2];
#pragma unroll
        for (int qb = 0; qb < 4; ++qb) {
          const int qtok = tq0 + qb * 16 + fr;
          float mx = -3.0e38f;
#pragma unroll
          for (int kb = 0; kb < 4; ++kb)
#pragma unroll
            for (int jj = 0; jj < 4; ++jj) {
              float s = Sx[kb][qb][jj] * C2;
              if (lat) { int dk = kt0 + kb * 16 + fq * 4 + jj - qtok; if (dk > 128 || dk < -128) s = -3.0e38f; }
              Sx[kb][qb][jj] = s; mx = fmaxf(mx, s);
            }
          mx = fmaxf(mx, bperm_xor(mx, lane, 16)); mx = fmaxf(mx, bperm_xor(mx, lane, 32));
          constexpr float THR = 11.0f;
          float alpha = 1.f;
          if (__builtin_amdgcn_ballot_w64(mx > mrun[qb] + THR) != 0ull) {
            const float mnew = fmaxf(mrun[qb], mx);
            alpha = exp2f(mrun[qb] - mnew);
            mrun[qb] = mnew;
#pragma unroll
            for (int db = 0; db < 4; ++db) O[db][qb] *= alpha;
          }
          const float mcur = mrun[qb];
          float ps = 0.f; float pv[4][4];
#pragma unroll
          for (int kb = 0; kb < 4; ++kb)
#pragma unroll
            for (int jj = 0; jj < 4; ++jj) { float e = exp2f(Sx[kb][qb][jj] - mcur); pv[kb][jj] = e; ps += e; }
          lrun[qb] = lrun[qb] * alpha + ps;
#pragma unroll
          for (int ks = 0; ks < 2; ++ks) {
            unsigned w0 = pack2(pv[2 * ks][0], pv[2 * ks][1]), w1 = pack2(pv[2 * ks][2], pv[2 * ks][3]);
            unsigned w2 = pack2(pv[2 * ks + 1][0], pv[2 * ks + 1][1]), w3 = pack2(pv[2 * ks + 1][2], pv[2 * ks + 1][3]);
            uint4 t4 = {w0, w1, w2, w3}; pb[qb][ks] = __builtin_bit_cast(bf16x8, t4);
          }
        }
#pragma unroll
        for (int db = 0; db < 4; ++db)
#pragma unroll
          for (int ks = 0; ks < 2; ++ks) {
            uint2 v0 = *(const uint2*)(vt + (db * 16 + fr) * KP + (2 * ks) * 16 + fq * 4), v1 = *(const uint2*)(vt + (db * 16 + fr) * KP + (2 * ks + 1) * 16 + fq * 4);
            uint4 t4 = {v0.x, v0.y, v1.x, v1.y}; bf16x8 av = __builtin_bit_cast(bf16x8, t4);
#pragma unroll
            for (int qb = 0; qb < 4; ++qb) O[db][qb] = __builtin_amdgcn_mfma_f32_16x16x32_bf16(av, pb[qb][ks], O[db][qb], 0, 0, 0);
          }
      }
      if (ti + 1 < ntile) ls(ti + 1, (ti + 1) & 1);
      __syncthreads();
    }
#pragma unroll
    for (int qb = 0; qb < 4; ++qb) {
      float l = lrun[qb]; l += bperm_xor(l, lane, 16); l += bperm_xor(l, lane, 32);
      const float inv = 1.f / l;
      bf16_t* dst = P + (size_t)(rowbase + tq0 + qb * 16 + fr) * PW + A_IN + head * 64 + fq * 4;
#pragma unroll
      for (int db = 0; db < 4; ++db) {
        uint2 pk = {pack2(O[db][qb][0] * inv, O[db][qb][1] * inv), pack2(O[db][qb][2] * inv, O[db][qb][3] * inv)};
        if (!p.dry) *(uint2*)(dst + db * 16) = pk;
      }
    }
  }
}

DI void phase_rwkv_out(const DevP& p, int j, const int tid_, const int bid_) {
  bf16_t* P = (bf16_t*)(p.ws + OFF_BIG);
  const bf16_t* LO = (const bf16_t*)(p.ws + OFF_LO);
  const bf16_t* Y = (const bf16_t*)(p.ws + OFF_H);
  const int l16 = tid_ & 15;
  const int g0 = (bid_ * NTHR + tid_) >> 4, gs = ((int)gridDim.x * NTHR) >> 4, NIT = MROWS * 8;
  for (int it0 = g0; it0 < NIT; it0 += 2 * gs) {
    uint2 y0[2], y1[2], ur[2], uk[2], uv[2], ua0[2], ua1[2], ug[2]; f32x4 ka[2], rk[2], lw[2], lb[2]; bf16_t* prs[2]; bool ok[2];
#pragma unroll
    for (int k = 0; k < 2; ++k) {
      const int itk = it0 + k * gs; ok[k] = itk < NIT; const int it = ok[k] ? itk : it0;
      const int row = it >> 3, h = it & 7, c = h * 64 + 4 * l16;
      y0[k] = *(const uint2*)(Y + (size_t)row * 512 + c); y1[k] = *(const uint2*)(Y + ((size_t)MROWS + row) * 512 + c);
      bf16_t* pr = P + (size_t)row * PW + c; prs[k] = pr;
      ur[k] = *(const uint2*)pr; uk[k] = *(const uint2*)(pr + 512); uv[k] = *(const uint2*)(pr + 1024);
      const bf16_t* lo = LO + (size_t)row * LOW + c;
      ua0[k] = *(const uint2*)(lo + 1024); ua1[k] = *(const uint2*)(lo + 1536); ug[k] = *(const uint2*)(lo + 2048);
      ka[k] = *(const f32x4*)(pin(p, I_EKA) + j * 512 + c); rk[k] = *(const f32x4*)(pin(p, I_ERK) + j * 512 + c);
      lw[k] = *(const f32x4*)(pin(p, I_ELNW) + j * 512 + c); lb[k] = *(const f32x4*)(pin(p, I_ELNB) + j * 512 + c);
    }
#pragma unroll
    for (int k = 0; k < 2; ++k) {
      const float y[4] = {lo16(y0[k].x) + lo16(y1[k].x), hi16(y0[k].x) + hi16(y1[k].x), lo16(y0[k].y) + lo16(y1[k].y), hi16(y0[k].y) + hi16(y1[k].y)};
      const float r[4] = {lo16(ur[k].x), hi16(ur[k].x), lo16(ur[k].y), hi16(ur[k].y)}, kq[4] = {lo16(uk[k].x), hi16(uk[k].x), lo16(uk[k].y), hi16(uk[k].y)};
      const float v[4] = {lo16(uv[k].x), hi16(uv[k].x), lo16(uv[k].y), hi16(uv[k].y)}, a0[4] = {lo16(ua0[k].x), hi16(ua0[k].x), lo16(ua0[k].y), hi16(ua0[k].y)};
      const float a1[4] = {lo16(ua1[k].x), hi16(ua1[k].x), lo16(ua1[k].y), hi16(ua1[k].y)}, gg[4] = {lo16(ug[k].x), hi16(ug[k].x), lo16(ug[k].y), hi16(ug[k].y)};
      float sy = 0.f, bo = 0.f;
#pragma unroll
      for (int q = 0; q < 4; ++q) { sy += y[q]; const float kd = kq[q] * (2.f + (a0[q] + a1[q] - 2.f) * ka[k][q]); bo += r[q] * kd * rk[k][q]; }
      sy = sum16(sy); bo = sum16(bo);
      const float mu = sy * (1.f / 64.f);
      float sv = 0.f;
#pragma unroll
      for (int q = 0; q < 4; ++q) { const float dd = y[q] - mu; sv += dd * dd; }
      sv = sum16(sv);
      const float rs = rsqrtf(sv * (1.f / 64.f) + 64e-5f);
      float o[4];
#pragma unroll
      for (int q = 0; q < 4; ++q) o[q] = ((y[q] - mu) * rs * lw[k][q] + lb[k][q] + bo * v[q]) * gg[q];
      uint2 pk = {pack2(o[0], o[1]), pack2(o[2], o[3])};
      if (ok[k] && !p.dry) *(uint2*)prs[k] = pk;
    }
  }
}

DI int PI(int n) { return n + (n >> 5); }
DI float2 cmul(float2 a, float2 b) { return make_float2(a.x * b.x - a.y * b.y, a.x * b.y + a.y * b.x); }
DI float2 cmulc(float2 a, float2 b) { return make_float2(a.x * b.x + a.y * b.y, a.y * b.x - a.x * b.y); }
template <int M> DI float2 c16() {
  constexpr float cs[8] = {1.f, 0.9238795325112867f, 0.7071067811865476f, 0.3826834323650898f, 0.f, -0.3826834323650898f, -0.7071067811865476f, -0.9238795325112867f};
  constexpr float sn[8] = {0.f, -0.3826834323650898f, -0.7071067811865476f, -0.9238795325112867f, -1.f, -0.9238795325112867f, -0.7071067811865476f, -0.3826834323650898f};
  return make_float2(cs[M], sn[M]);
}
template <int S, int I, bool TWD> DI void bfly_f(float2 (&x)[16], float2 w) {
  constexpr int hs = 8 >> S, m = I & (hs - 1);
  float2 a = x[I], b = x[I + hs];
  x[I] = make_float2(a.x + b.x, a.y + b.y);
  float2 d = make_float2(a.x - b.x, a.y - b.y);
  float2 W = c16<m * (8 / hs)>();
  if (TWD) W = cmul(W, w);
  x[I + hs] = (m == 0 && !TWD) ? d : cmul(d, W);
}
template <int S, int I, bool TWD> DI void bfly_i(float2 (&x)[16], float2 w) {
  constexpr int hs = 8 >> S, m = I & (hs - 1);
  float2 W = c16<m * (8 / hs)>();
  if (TWD) W = cmul(W, w);
  float2 a = x[I], t = (m == 0 && !TWD) ? x[I + hs] : cmulc(x[I + hs], W);
  x[I] = make_float2(a.x + t.x, a.y + t.y);
  x[I + hs] = make_float2(a.x - t.x, a.y - t.y);
}
template <int S, bool TWD> DI void stage_f(float2 (&x)[16], float2 w) {
  constexpr int hs = 8 >> S;
  if (!(0 & hs)) bfly_f<S, 0, TWD>(x, w);
  if (!(1 & hs)) bfly_f<S, 1 & ~hs, TWD>(x, w);
  if (!(2 & hs)) bfly_f<S, 2 & ~hs, TWD>(x, w);
  if (!(3 & hs)) bfly_f<S, 3 & ~hs, TWD>(x, w);
  if (!(4 & hs)) bfly_f<S, 4 & ~hs, TWD>(x, w);
  if (!(5 & hs)) bfly_f<S, 5 & ~hs, TWD>(x, w);
  if (!(6 & hs)) bfly_f<S, 6 & ~hs, TWD>(x, w);
  if (!(7 & hs)) bfly_f<S, 7 & ~hs, TWD>(x, w);
  if (!(8 & hs)) bfly_f<S, 8 & ~hs, TWD>(x, w);
  if (!(9 & hs)) bfly_f<S, 9 & ~hs, TWD>(x, w);
  if (!(10 & hs)) bfly_f<S, 10 & ~hs, TWD>(x, w);
  if (!(11 & hs)) bfly_f<S, 11 & ~hs, TWD>(x, w);
  if (!(12 & hs)) bfly_f<S, 12 & ~hs, TWD>(x, w);
  if (!(13 & hs)) bfly_f<S, 13 & ~hs, TWD>(x, w);
  if (!(14 & hs)) bfly_f<S, 14 & ~hs, TWD>(x, w);
  if (!(15 & hs)) bfly_f<S, 15 & ~hs, TWD>(x, w);
}
template <int S, bool TWD> DI void stage_i(float2 (&x)[16], float2 w) {
  constexpr int hs = 8 >> S;
  if (!(0 & hs)) bfly_i<S, 0, TWD>(x, w);
  if (!(1 & hs)) bfly_i<S, 1 & ~hs, TWD>(x, w);
  if (!(2 & hs)) bfly_i<S, 2 & ~hs, TWD>(x, w);
  if (!(3 & hs)) bfly_i<S, 3 & ~hs, TWD>(x, w);
  if (!(4 & hs)) bfly_i<S, 4 & ~hs, TWD>(x, w);
  if (!(5 & hs)) bfly_i<S, 5 & ~hs, TWD>(x, w);
  if (!(6 & hs)) bfly_i<S, 6 & ~hs, TWD>(x, w);
  if (!(7 & hs)) bfly_i<S, 7 & ~hs, TWD>(x, w);
  if (!(8 & hs)) bfly_i<S, 8 & ~hs, TWD>(x, w);
  if (!(9 & hs)) bfly_i<S, 9 & ~hs, TWD>(x, w);
  if (!(10 & hs)) bfly_i<S, 10 & ~hs, TWD>(x, w);
  if (!(11 & hs)) bfly_i<S, 11 & ~hs, TWD>(x, w);
  if (!(12 & hs)) bfly_i<S, 12 & ~hs, TWD>(x, w);
  if (!(13 & hs)) bfly_i<S, 13 & ~hs, TWD>(x, w);
  if (!(14 & hs)) bfly_i<S, 14 & ~hs, TWD>(x, w);
  if (!(15 & hs)) bfly_i<S, 15 & ~hs, TWD>(x, w);
}
template <bool TWD> DI void r16_fwd(float2 (&x)[16], float2 w0) {
  float2 w1 = cmul(w0, w0), w2 = cmul(w1, w1), w3 = cmul(w2, w2);
  stage_f<0, TWD>(x, w0); stage_f<1, TWD>(x, w1); stage_f<2, TWD>(x, w2); stage_f<3, TWD>(x, w3);
}
template <bool TWD> DI void r16_inv(float2 (&x)[16], float2 w0) {
  float2 w1 = cmul(w0, w0), w2 = cmul(w1, w1), w3 = cmul(w2, w2);
  stage_i<3, TWD>(x, w3); stage_i<2, TWD>(x, w2); stage_i<1, TWD>(x, w1); stage_i<0, TWD>(x, w0);
}
DI void passA(float2* D, const float2 w0, int tid, bool inv) {
  const int base = (tid >> 8) * 4096 + (tid & 255);
  float2 x[16];
#pragma unroll
  for (int i = 0; i < 16; ++i) x[i] = D[PI(base + i * 256)];
  if (inv) r16_inv<true>(x, w0); else r16_fwd<true>(x, w0);
#pragma unroll
  for (int i = 0; i < 16; ++i) D[PI(base + i * 256)] = x[i];
}
DI void passB(float2* D, const float2 w0, int tid, bool inv) {
  const int base = (tid >> 4) * 256 + (tid & 15);
  float2 x[16];
#pragma unroll
  for (int i = 0; i < 16; ++i) x[i] = D[PI(base + i * 16)];
  if (inv) r16_inv<true>(x, w0); else r16_fwd<true>(x, w0);
#pragma unroll
  for (int i = 0; i < 16; ++i) D[PI(base + i * 16)] = x[i];
}

DI void phase_taps(const DevP& p, int j, char* shmc, const int tid_, const int bid_, const int nwk_) {
  float* hs = (float*)shmc;
  float* fs = hs + 64 * 65;
  const float* fout = pin(p, I_OFOUT) + (size_t)j * 64 * 4096;
  const float da = -3.0701134573253945f, db = -15.350567286626973f;
  const int tid = tid_;
  for (int it = bid_; it < 64 * 68; it += nwk_) {
    const int ct = it / 68, tt = it % 68, isc = tt >= 64, t0 = (isc ? tt - 64 : tt) * 64, c0 = ct * 64, n = isc ? 256 : 4096;
    const float* hdn = isc ? (const float*)(p.ws + OFF_HDNC) + (size_t)j * 256 * 64 : (const float*)(p.ws + OFF_HDNL) + (size_t)j * 4096 * 64;
    __syncthreads();
    { float hv_[8], fv_[8];
#pragma unroll
      for (int q = 0; q < 8; ++q) { const int e = tid + q * NTHR, r = e >> 6, cc = e & 63; hv_[q] = hdn[(size_t)(t0 + r) * 64 + cc]; fv_[q] = fout[(size_t)r * 4096 + c0 + cc]; }
      __builtin_amdgcn_sched_barrier(0);
#pragma unroll
      for (int q = 0; q < 8; ++q) { const int e = tid + q * NTHR, r = e >> 6, cc = e & 63; hs[r * 65 + cc] = hv_[q]; fs[r * 64 + cc] = fv_[q]; } }
    __syncthreads();
    const int tl = tid & 63, cg8 = (tid >> 6) * 8;
    float acc[8];
#pragma unroll
    for (int e = 0; e < 8; ++e) acc[e] = 0.f;
    for (int k = 0; k < 64; ++k) { const float hv = hs[tl * 65 + k];
#pragma unroll
      for (int e = 0; e < 8; ++e) acc[e] += hv * fs[k * 64 + cg8 + e]; }
    const float tpos = (float)(t0 + tl) / (float)(n - 1);
#pragma unroll
    for (int e = 0; e < 8; ++e) {
      const int c = c0 + cg8 + e, d = c & 1023;
      const float delta = fabsf(da + (db - da) * (float)d / (float)(DM - 1));
      const float v = acc[e] * (__expf(-tpos * delta) + 0.05f);
      if (isc) ((float*)(p.ws + OFF_LO) + (size_t)4096 * 4096)[(size_t)c * 256 + t0 + tl] = v;
      else ((float*)(p.ws + OFF_LO))[(size_t)c * 4096 + t0 + tl] = v;
    }
  }
}

DI void phase_hyena(const DevP& p, int j, char* shmc, const int tid_, const int bid_) {
  bf16_t* ZT = (bf16_t*)(p.ws + OFF_BIG);
  const float2* TW = (const float2*)(p.ws + OFF_TW);
  const float* HFL = (const float*)(p.ws + OFF_LO);
  const float* HFC = HFL + (size_t)4096 * 4096;
  float2* D = (float2*)shmc;
  float2* KF = D + 8448;
  const int tid = tid_;
  for (int d = bid_; d < DM; d += gridDim.x) {
#pragma unroll 1
    for (int o = 0; o < 2; ++o) {
      const float skip = pin(p, I_OSKIP)[(j * 2 + o) * DM + d];
      const float* cf = HFL + ((size_t)((o * 2 + 0) * DM + d)) * 4096;
      const float* cb = HFL + ((size_t)((o * 2 + 1) * DM + d)) * 4096;
      __syncthreads();
      for (int t = tid; t < 4096; t += NTHR) {
        const float lo = (t == 0) ? cf[0] + cb[0] : cf[t];
        const float hi = (t == 0) ? 0.f : cb[4096 - t];
        const float2 w = TW[t];
        D[PI(t)] = make_float2(lo + hi, 0.f);
        const float dd = lo - hi;
        D[PI(4096 + t)] = make_float2(dd * w.x, dd * w.y);
      }
      { const float2 w_ = TW[2 * (tid & 255)]; __syncthreads(); passA(D, w_, tid, false); }
      { const float2 w_ = TW[32 * (tid & 15)]; __syncthreads(); passB(D, w_, tid, false); }
      __syncthreads();
      { float2 x[16];
#pragma unroll
        for (int i = 0; i < 16; ++i) x[i] = D[PI(tid * 16 + i)];
        r16_fwd<false>(x, make_float2(1.f, 0.f));
#pragma unroll
        for (int i = 0; i < 16; ++i) KF[PI(tid * 16 + i)] = x[i]; }
      __syncthreads();
#pragma unroll 1
      for (int pr = 0; pr < 4; ++pr) {
        const bf16_t* u1 = ZT + ((size_t)((2 * pr) * HY3 + d)) * TPB + CTXL;
        const bf16_t* u2 = ZT + ((size_t)((2 * pr + 1) * HY3 + d)) * TPB + CTXL;
        for (int t = tid; t < 4096; t += NTHR) {
          const float2 u = make_float2(bf2f(u1[t]), bf2f(u2[t]));
          D[PI(t)] = u; D[PI(4096 + t)] = cmul(u, TW[t]);
        }
        { const float2 w_ = TW[2 * (tid & 255)]; __syncthreads(); passA(D, w_, tid, false); }
        { const float2 w_ = TW[32 * (tid & 15)]; __syncthreads(); passB(D, w_, tid, false); }
        __syncthreads();
        { float2 x[16];
#pragma unroll
          for (int i = 0; i < 16; ++i) x[i] = D[PI(tid * 16 + i)];
          r16_fwd<false>(x, make_float2(1.f, 0.f));
#pragma unroll
          for (int i = 0; i < 16; ++i) x[i] = cmul(x[i], KF[PI(tid * 16 + i)]);
          r16_inv<false>(x, make_float2(1.f, 0.f));
#pragma unroll
          for (int i = 0; i < 16; ++i) D[PI(tid * 16 + i)] = x[i]; }
        { const float2 w_ = TW[32 * (tid & 15)]; __syncthreads(); passB(D, w_, tid, true); }
        { const float2 w_ = TW[2 * (tid & 255)]; __syncthreads(); passA(D, w_, tid, true); }
        __syncthreads();
        const bf16_t* x1 = ZT + ((size_t)((2 * pr) * HY3 + (1 + o) * DM + d)) * TPB + CTXL;
        const bf16_t* x2 = ZT + ((size_t)((2 * pr + 1) * HY3 + (1 + o) * DM + d)) * TPB + CTXL;
        bf16_t* o1 = ZT + ((size_t)((2 * pr) * HY3 + d)) * TPB + CTXL;
        bf16_t* o2 = ZT + ((size_t)((2 * pr + 1) * HY3 + d)) * TPB + CTXL;
        {
          float2 twv[8]; bf16_t ua_[8], ub_[8], xa_[8], xb_[8];
#pragma unroll
          for (int k = 0; k < 8; ++k) { const int t = tid + k * NTHR; twv[k] = TW[t]; ua_[k] = u1[t]; ub_[k] = u2[t]; xa_[k] = x1[t]; xb_[k] = x2[t]; }
          __builtin_amdgcn_sched_barrier(0);
#pragma unroll
          for (int k = 0; k < 8; ++k) { const int t = tid + k * NTHR;
            const float2 a = D[PI(t)], b = cmulc(D[PI(4096 + t)], twv[k]);
            const float yx = (a.x + b.x) * (1.f / 8192.f), yy = (a.y + b.y) * (1.f / 8192.f);
            if (!p.dry) { o1[t] = f2bf(bf2f(xa_[k]) * (yx + bf2f(ua_[k]) * skip)); o2[t] = f2bf(bf2f(xb_[k]) * (yy + bf2f(ub_[k]) * skip)); } }
        }
        __syncthreads();
      }
      {
        const float* hfc = HFC + ((size_t)((o * 2 + 0) * DM + d)) * 256;
        const float* hbc = HFC + ((size_t)((o * 2 + 1) * DM + d)) * 256;
        for (int q = tid; q < 5 * 256; q += NTHR) {
          const int blk = q >> 8, t = q & 255; const float2 w = TW[16 * t];
          if (blk < 4) {
            const float2 u = make_float2(bf2f(ZT[((size_t)((2 * blk) * HY3 + d)) * TPB + t]), bf2f(ZT[((size_t)((2 * blk + 1) * HY3 + d)) * TPB + t]));
            D[PI(blk * 512 + t)] = u; D[PI(blk * 512 + 256 + t)] = cmul(u, w);
          } else {
            const float lo = (t == 0) ? hfc[0] + hbc[0] : hfc[t], hi = (t == 0) ? 0.f : hbc[256 - t];
            D[PI(2048 + t)] = make_float2(lo + hi, 0.f); const float dd = lo - hi; D[PI(2304 + t)] = make_float2(dd * w.x, dd * w.y);
          }
        }
        { const float2 w_ = TW[32 * (tid & 15)]; __syncthreads(); if (tid < 160) passB(D, w_, tid, false); }
        __syncthreads();
        if (tid >= 128 && tid < 160) { float2 x[16];
#pragma unroll
          for (int i = 0; i < 16; ++i) x[i] = D[PI(tid * 16 + i)];
          r16_fwd<false>(x, make_float2(1.f, 0.f));
#pragma unroll
          for (int i = 0; i < 16; ++i) D[PI(tid * 16 + i)] = x[i]; }
        __syncthreads();
        if (tid < 128) { float2 x[16];
          const int kb = 2048 + ((tid >> 4) & 1) * 256 + (tid & 15) * 16;
#pragma unroll
          for (int i = 0; i < 16; ++i) x[i] = D[PI(tid * 16 + i)];
          r16_fwd<false>(x, make_float2(1.f, 0.f));
#pragma unroll
          for (int i = 0; i < 16; ++i) x[i] = cmul(x[i], D[PI(kb + i)]);
          r16_inv<false>(x, make_float2(1.f, 0.f));
#pragma unroll
          for (int i = 0; i < 16; ++i) D[PI(tid * 16 + i)] = x[i]; }
        { const float2 w_ = TW[32 * (tid & 15)]; __syncthreads(); if (tid < 128) passB(D, w_, tid, true); }
        __syncthreads();
        { float2 twv[2]; bf16_t ua_[2], ub_[2], xa_[2], xb_[2];
#pragma unroll
          for (int k = 0; k < 2; ++k) { const int q = tid + k * NTHR, blk = q >> 8, t = q & 255;
            const bf16_t* p1 = ZT + ((size_t)((2 * blk) * HY3 + d)) * TPB + t; const bf16_t* p2 = ZT + ((size_t)((2 * blk + 1) * HY3 + d)) * TPB + t;
            twv[k] = TW[16 * t]; ua_[k] = *p1; ub_[k] = *p2; xa_[k] = p1[(size_t)(1 + o) * DM * TPB]; xb_[k] = p2[(size_t)(1 + o) * DM * TPB]; }
#pragma unroll
          for (int k = 0; k < 2; ++k) { const int q = tid + k * NTHR, blk = q >> 8, t = q & 255;
            const float2 a = D[PI(blk * 512 + t)], b = cmulc(D[PI(blk * 512 + 256 + t)], twv[k]);
            const float yx = (a.x + b.x) * (1.f / 512.f), yy = (a.y + b.y) * (1.f / 512.f);
            bf16_t* p1 = ZT + ((size_t)((2 * blk) * HY3 + d)) * TPB + t; bf16_t* p2 = ZT + ((size_t)((2 * blk + 1) * HY3 + d)) * TPB + t;
            if (!p.dry) { *p1 = f2bf(bf2f(xa_[k]) * (yx + bf2f(ua_[k]) * skip)); *p2 = f2bf(bf2f(xb_[k]) * (yy + bf2f(ub_[k]) * skip)); } }
        }
        __syncthreads();
      }
    }
  }
}

DI void phase_transpose(const DevP& p, char* shmc, const int tid_, const int bid_) {
  const bf16_t* ZT = (const bf16_t*)(p.ws + OFF_BIG);
  bf16_t* H = (bf16_t*)(p.ws + OFF_H);
  bf16_t* T = (bf16_t*)shmc;
  const int tid = tid_;
  for (int it = bid_; it < NB * 68 * 16; it += gridDim.x) {
    const int b = it / (68 * 16), rem = it % (68 * 16), s0 = (rem >> 4) * 64, d0 = (rem & 15) * 64;
    { const int dr = tid >> 3, sc = (tid & 7) * 8;
      *(uint4*)(T + dr * 72 + sc) = *(const uint4*)(ZT + ((size_t)(b * HY3 + d0 + dr)) * TPB + s0 + sc); }
    __syncthreads();
    { const int sr = tid >> 3, dc = (tid & 7) * 8; unsigned w[4];
#pragma unroll
      for (int e = 0; e < 4; ++e) w[e] = (unsigned)T[(dc + 2 * e) * 72 + sr] | ((unsigned)T[(dc + 2 * e + 1) * 72 + sr] << 16);
      uint4 pk = {w[0], w[1], w[2], w[3]};
      *(uint4*)(H + ((size_t)(b * TPB + s0 + sr)) * DM + d0 + dc) = pk; }
    __syncthreads();
  }
}


#define XB_TMO      128
#define XB_XCNT(j)  (256  + 64 * (j))
#define XB_XSUB(j)  (1280 + 64 * (j))
#define XB_XGEN(j)  (2304 + 64 * (j))
#define XB_TOP      3328
#define XB_TOPGEN   3392
#define XCD_BAR_WORDS 3456
#define XB_SPIN_CAP (1u << 22)
#define LAS __attribute__((address_space(3)))
DI unsigned xb_ld(unsigned* q)              { return __hip_atomic_load(q, __ATOMIC_RELAXED, __HIP_MEMORY_SCOPE_AGENT); }
DI unsigned xb_add(unsigned* q, unsigned v) { return __hip_atomic_fetch_add(q, v, __ATOMIC_RELAXED, __HIP_MEMORY_SCOPE_AGENT); }
DI unsigned xb_xcc_id() { return (unsigned)__builtin_amdgcn_s_getreg((3 << 11) | 20) & 0xFu; }
#define XB_SPIN(cond, bar) do { unsigned _sp = 0; while (cond) { __builtin_amdgcn_s_sleep(1); \
    if ((++_sp & 255u) == 0u) { if (xb_ld(&(bar)[XB_TMO])) break; if (_sp > XB_SPIN_CAP) { atomicAdd(&(bar)[XB_TMO], 1u); break; } } } } while (0)
struct XcdBarrier { unsigned* bar; unsigned x; volatile LAS unsigned* st; };
DI void xcd_barrier_complete(unsigned* bar, unsigned x, unsigned& nloc, unsigned& nx) {
  const unsigned G = gridDim.x;
  unsigned sum, cnt, mine, sp = 0u;
  for (;;) {
    sum = 0u; cnt = 0u; mine = 0u;
#pragma unroll
    for (unsigned j = 0; j < 16; ++j) { const unsigned c = xb_ld(&bar[XB_XCNT(j)]); sum += c; cnt += (c > 0u) ? 1u : 0u; mine = (j == x) ? c : mine; }
    if (sum == G) break;
    __builtin_amdgcn_s_sleep(1);
    if ((++sp & 255u) == 0u) { if (xb_ld(&bar[XB_TMO])) break; if (sp > XB_SPIN_CAP) { atomicAdd(&bar[XB_TMO], 1u); break; } }
  }
  nloc = mine > 0u ? mine : 1u; nx = cnt > 0u ? cnt : 1u;
}
DI void xcd_barrier(const XcdBarrier& b, int tid) {
  asm volatile("s_waitcnt vmcnt(0)" ::: "memory");
  __syncthreads();
  if (tid == 0) {
    unsigned* bar = b.bar;
    __builtin_amdgcn_s_waitcnt(0);
    unsigned nloc = b.st[0], nx = b.st[1];
    if (nloc == 0u) { xcd_barrier_complete(bar, b.x, nloc, nx); b.st[0] = nloc; b.st[1] = nx; }
    const unsigned old = xb_add(&bar[XB_XSUB(b.x)], 1u);
    const unsigned gen = old / nloc;
    if (old + 1u == (gen + 1u) * nloc) {
      __builtin_amdgcn_fence(__ATOMIC_RELEASE, "agent");
      asm volatile("s_waitcnt vmcnt(0)" ::: "memory");
      const unsigned og = xb_add(&bar[XB_TOP], 1u);
      const unsigned tg = og / nx;
      if (og + 1u == (tg + 1u) * nx) xb_add(&bar[XB_TOPGEN], 1u);
      else XB_SPIN(xb_ld(&bar[XB_TOPGEN]) == tg, bar);
      __builtin_amdgcn_fence(__ATOMIC_ACQUIRE, "agent");
      xb_add(&bar[XB_XGEN(b.x)], 1u);
      asm volatile("s_waitcnt vmcnt(0)" ::: "memory");
    } else {
      XB_SPIN(xb_ld(&bar[XB_XGEN(b.x)]) == gen, bar);
      __builtin_amdgcn_fence(__ATOMIC_ACQUIRE, "agent");
      asm volatile("s_waitcnt vmcnt(0)" ::: "memory");
    }
  }
  __syncthreads();
}

constexpr int NPHASE = 1 + 4 * 9;
#define NREP(t) (((PROBE_MASK >> (t)) & 1) ? 2 : 1)
#define REP(t, nonidem, call) for (int r_ = 0; r_ < NREP(t); ++r_) { p.dry = (nonidem) && (r_ + 1 < NREP(t)); call; }

template <int EN>
__global__ void __launch_bounds__(NTHR) fwd_kernel(Params pk, int ph0, int ph1, int coop) {
  extern __shared__ __attribute__((aligned(16))) char shm[];
  __shared__ const float* in_tab[N_IN];
  if (threadIdx.x < N_IN) in_tab[threadIdx.x] = pk.in[threadIdx.x];
  __shared__ uint4 xb_words;
  if (threadIdx.x == 0) xb_words = make_uint4(0u, 0u, 0u, 0u);
  __syncthreads();
  XcdBarrier xb; xb.bar = (unsigned*)(pk.ws + OFF_BAR); xb.x = xb_xcc_id(); xb.st = (volatile LAS unsigned*)&xb_words;
  if (EN == 0xffff && coop && threadIdx.x == 0) (void)xb_add(&xb.bar[XB_XCNT(xb.x)], 1u);
  bf16_t* shb = (bf16_t*)shm;
  const int wave_s = __builtin_amdgcn_readfirstlane(threadIdx.x >> 6);
  const int phend = (EN == 0xffff) ? ph1 : ph0 + 1;
  for (int ph = ph0; ph < phend; ++ph) {
    int lane_; asm volatile("v_mbcnt_lo_u32_b32 %0, -1, 0\n\tv_mbcnt_hi_u32_b32 %0, -1, %0" : "=v"(lane_));
    int tid_ = wave_s * 64 + lane_, bid_ = blockIdx.x;
    asm volatile("" : "+s"(bid_));
    DevP p; p.in = in_tab; p.dry = false;
    { unsigned long long w = (unsigned long long)pk.ws, o = (unsigned long long)pk.out;
      unsigned wl = (unsigned)w, wh = (unsigned)(w >> 32), ol = (unsigned)o, oh = (unsigned)(o >> 32);
      asm volatile("" : "+s"(wl), "+s"(wh), "+s"(ol), "+s"(oh));
      p.ws = (char*)(__attribute__((address_space(1))) char*)(((unsigned long long)wh << 32) | wl);
      p.out = (float*)(__attribute__((address_space(1))) float*)(((unsigned long long)oh << 32) | ol); }
    int conv_next = -1, conv_parts = 0;
    GemmCall g{}; int nM = 0, nN = 0; bool do_gemm = false, skip_sync = false;
    if (ph == 0) { if constexpr (EN & 1) REP(0, false, phase_setup(p, shm, tid_, bid_)) }
    else {
      const int layer = (ph - 1) / 9, sub = (ph - 1) % 9, even = (layer & 1) == 0, j = layer >> 1;
      const float* mod = (const float*)(p.ws + OFF_MOD) + (size_t)layer * 9 * 6144;
      const bf16_t* wt = (const bf16_t*)(p.ws + ((layer & 1) ? OFF_WT2 : OFF_WT));
      g.M = MROWS; g.ksk = 1 << 30; g.ksoff = 0;
      if (sub == 0) { if constexpr (EN & 2) REP(1, false, phase_start(p, layer, shm, tid_, bid_)) }
      else if (sub == 1) {
        g.A = (const bf16_t*)(p.ws + OFF_H); g.lda = DM; g.Bt = wt + WT_WIN; g.K = DM; do_gemm = true;
        if (even) { g.e0 = pin(p, I_EMUP) + j * A_IN; g.e1 = pin(p, I_EMUN) + j * A_IN; g.o0 = (bf16_t*)(p.ws + OFF_BIG); g.o1 = (bf16_t*)(p.ws + OFF_L);
          g.mode = M_EVEN; nM = (MROWS + 253) / 254; nN = 11; }
        else { g.bias = pin(p, I_OBIN) + j * HY3; g.e0 = pin(p, I_OCW) + (size_t)j * 3 * HY3; g.e1 = pin(p, I_OCB) + j * HY3; g.o0 = (bf16_t*)(p.ws + OFF_BIG);
          g.mode = M_ODD; nM = (MROWS + 247) / 248; nN = 12; }
      } else if (sub == 2) {
        if (even) {
          g.A = (const bf16_t*)(p.ws + OFF_L); g.lda = LW; g.Bt = wt + WT_LORA; g.K = LW;
          g.e0 = pin(p, I_EW0) + j * 1024; g.e1 = pin(p, I_EA0) + j * 1024; g.o0 = (bf16_t*)(p.ws + OFF_LO);
          g.mode = M_LORA; nM = MROWS / 256; nN = LOW / 256; do_gemm = true;
          if constexpr (EN & 32) phase_qkprep(p, j, tid_, bid_);
        } else { if constexpr (EN & 64) REP(6, true, phase_hyena(p, j, shm, tid_, bid_)) }
      } else if (sub == 3) {
        if (even) { if constexpr (EN & 128) REP(7, false, phase_scan(p, j, shm, tid_, bid_)) if constexpr (EN & 256) REP(8, true, phase_attn(p, j, shm, tid_, bid_))
          if (layer < 3) { __syncthreads();
            if ((int)gridDim.x == 256) { if (bid_ >= 32) convert_layer(p, layer + 1, (bf16_t*)(p.ws + (((layer + 1) & 1) ? OFF_WT2 : OFF_WT)), shm, tid_, bid_ - 32, 224, 4); }
            else convert_layer(p, layer + 1, (bf16_t*)(p.ws + (((layer + 1) & 1) ? OFF_WT2 : OFF_WT)), shm, tid_, bid_, (int)gridDim.x, 4); } }
        else { if constexpr (EN & 512) REP(9, false, phase_transpose(p, shm, tid_, bid_)) }
      } else if (sub == 4) {
        if (even) { if constexpr (EN & 1024) phase_rwkv_out(p, j, tid_, bid_); }
        else skip_sync = true;
      } else if (sub == 5) {
        g.Bt = wt + WT_WOUT; g.K = DM; g.mod = mod; g.msel = 2; g.mode = M_RES; nM = MROWS / 256; nN = DM / 256; do_gemm = true;
        if (layer < 3) { conv_next = layer + 1; conv_parts = 1; }
        if (even) { g.A = (const bf16_t*)(p.ws + OFF_BIG); g.lda = PW; g.ksk = 8; g.ksoff = A_IN - 512; g.bias = nullptr; }
        else { g.A = (const bf16_t*)(p.ws + OFF_H); g.lda = DM; g.bias = pin(p, I_OBOUT) + j * DM; }
      } else if (sub == 6) { if constexpr (EN & 4096) REP(12, false, norm_phase(p, layer, 1, tid_, bid_)) }
      else if (sub == 7) {
        g.A = (const bf16_t*)(p.ws + OFF_H); g.lda = DM; g.Bt = wt + WT_WUP; g.K = DM;
        g.e0 = pin(p, I_FCW) + (size_t)layer * 3 * FF2; g.e1 = pin(p, I_FCB) + (size_t)layer * FF2; g.o0 = (bf16_t*)(p.ws + OFF_BIG);
        g.mode = M_FFN; nM = (MROWS + 253) / 254; nN = FF / 128; do_gemm = true;
      } else {
        g.A = (const bf16_t*)(p.ws + OFF_BIG); g.lda = FF; g.Bt = wt + WT_WDN; g.K = FF; g.mod = mod; g.msel = 5; g.bias = nullptr;
        if (layer < 3) { conv_next = layer + 1; conv_parts = ((layer + 1) & 1) ? 2 : 4; }
        g.mode = M_RES; nM = MROWS / 256; nN = DM / 256; do_gemm = true;
      }
    }
    if (do_gemm) {
      if (g.mode == M_RES) { if constexpr (EN & 2048) REP(11, true, gemm_phase<M_RES>(p, shb, g, nM, nN, tid_, bid_)) }
      else if (g.mode == M_LORA) { if constexpr (EN & 16) REP(4, false, gemm_phase<M_LORA>(p, shb, g, nM, nN, tid_, bid_)) }
      else if (g.mode == M_FFN) { if constexpr (EN & 8192) REP(13, true, gemm_phase<M_FFN>(p, shb, g, nM, nN, tid_, bid_)) }
      else if (g.mode == M_EVEN) { if constexpr (EN & 4) REP(2, true, gemm_phase<M_EVEN>(p, shb, g, nM, nN, tid_, bid_)) }
      else { if constexpr (EN & 8) REP(3, true, gemm_phase<M_ODD>(p, shb, g, nM, nN, tid_, bid_)) }
    }
    if (conv_next >= 0 && (int)gridDim.x == 256 && (bid_ >> 3) >= 4)
      convert_layer(p, conv_next, (bf16_t*)(p.ws + ((conv_next & 1) ? OFF_WT2 : OFF_WT)), shm, tid_, (bid_ & 7) * 28 + (bid_ >> 3) - 4, 224, conv_parts);
    else if (conv_next >= 0 && (int)gridDim.x != 256)
      convert_layer(p, conv_next, (bf16_t*)(p.ws + ((conv_next & 1) ? OFF_WT2 : OFF_WT)), shm, tid_, bid_, (int)gridDim.x, conv_parts);
    if (EN == 0xffff && coop && ph + 1 < ph1 && !skip_sync) {
      if (ph1 < 0) { __threadfence(); cg::this_grid().sync(); }
      for (int r_ = 0; r_ < NREP(14); ++r_) xcd_barrier(xb, tid_);
    }
  }
}

#ifndef MK_MULTI
#define MK_MULTI 0
#endif

template <int EN>
static void launch_phase(const Params& p, int ph, hipStream_t stream) {
  static bool attr = false;
  if (!attr) { (void)hipFuncSetAttribute((const void*)fwd_kernel<EN>, hipFuncAttributeMaxDynamicSharedMemorySize, LDS_BYTES); attr = true; }
  fwd_kernel<EN><<<256, NTHR, LDS_BYTES, stream>>>(p, ph, ph + 1, 0);
}

extern "C" void kernel_launch(void* const* d_in, const int* in_sizes, int n_in, void* d_out, int out_size, void* d_ws, size_t ws_size, hipStream_t stream) {
  Params p{};
  for (int i = 0; i < N_IN; ++i) p.in[i] = (const float*)d_in[i];
  p.out = (float*)d_out; p.ws = (char*)d_ws;
  if (ws_size < WS_END2) { fprintf(stderr, "workspace too small: %zu < %zu\n", ws_size, (size_t)WS_END); return; }
#if MK_MULTI
  launch_phase<1>(p, 0, stream);
  for (int layer = 0; layer < 4; ++layer) {
    const int b = 1 + layer * 9; const bool even = (layer & 1) == 0;
    launch_phase<2>(p, b + 0, stream);
    if (even) {
      launch_phase<4>(p, b + 1, stream); launch_phase<16>(p, b + 2, stream); launch_phase<32>(p, b + 2, stream); launch_phase<128 | 256>(p, b + 3, stream); launch_phase<1024>(p, b + 4, stream);
    } else {
      launch_phase<8>(p, b + 1, stream); launch_phase<64>(p, b + 2, stream); launch_phase<512>(p, b + 3, stream);
    }
    launch_phase<2048>(p, b + 5, stream); launch_phase<4096>(p, b + 6, stream); launch_phase<8192>(p, b + 7, stream); launch_phase<2048>(p, b + 8, stream);
  }
#else
  static bool attr = false;
  if (!attr) { (void)hipFuncSetAttribute((const void*)fwd_kernel<0xffff>, hipFuncAttributeMaxDynamicSharedMemorySize, LDS_BYTES); attr = true; }
  (void)hipMemsetAsync((char*)d_ws + OFF_BAR, 0, XCD_BAR_WORDS * 4, stream);
  int ph0 = 0, ph1 = NPHASE, coop = 1;
  void* args[] = {&p, &ph0, &ph1, &coop};
  hipError_t e = hipLaunchCooperativeKernel((const void*)fwd_kernel<0xffff>, dim3(256), dim3(NTHR), args, LDS_BYTES, stream);
  if (e != hipSuccess) fprintf(stderr, "cooperative launch failed: %s\n", hipGetErrorString(e));
#endif
}
```

```cpp
#include <hip/hip_runtime.h>
#include <hip/hip_cooperative_groups.h>
#include <cstdio>
namespace cg = cooperative_groups;

typedef unsigned short bf16_t;
typedef short bf16x8 __attribute__((ext_vector_type(8)));
typedef float f32x4 __attribute__((ext_vector_type(4)));
typedef __bf16 bf16v2 __attribute__((ext_vector_type(2)));
#define DI __device__ __forceinline__
#ifndef PROBE_MASK
#define PROBE_MASK 0
#endif

constexpr int DM = 1024, NB = 8, SEQ = 4096, CTXL = 256, TPB = SEQ + CTXL, MROWS = NB * TPB;
constexpr int A_IN = 1920, EVEN_IN = 2688, PW = 2688, LW = 384, LOW = 2560, FF = 2816, FF2 = 5632, HY3 = 3072;
constexpr int NTHR = 512;
constexpr int TP = 264;
constexpr int LDS_BYTES = 256 * TP * 2;

enum { I_X = 0, I_C, I_CTX, I_CCTX, I_ADAW, I_ADAB, I_N1G, I_N2G, I_FUP, I_FCW, I_FCB, I_FDN,
       I_EWIN, I_EMUP, I_EMUN, I_EW0, I_EW2, I_EA0, I_EA2, I_EG2, I_EKK, I_EKA, I_ERK, I_ELNW, I_ELNB, I_EQN, I_EKN, I_ESINK, I_EWOUT,
       I_OWIN, I_OBIN, I_OCW, I_OCB, I_OFW1, I_OFB1, I_OFW2, I_OFB2, I_OFW3, I_OFB3, I_OFREQ, I_OFOUT, I_OSKIP, I_OWOUT, I_OBOUT, N_IN };

struct Params { const float* in[N_IN]; float* out; char* ws; };
struct DevP { const float* const* in; float* out; char* ws; bool dry; bool xin; };

constexpr size_t OFF_XC = 0;
constexpr size_t OFF_MOD = OFF_XC + (size_t)NB * CTXL * DM * 4;
constexpr size_t OFF_HDNL = OFF_MOD + (size_t)4 * 9 * 6144 * 4;
constexpr size_t OFF_HDNC = OFF_HDNL + (size_t)2 * 4096 * 64 * 4;
constexpr size_t OFF_TW = OFF_HDNC + (size_t)2 * 256 * 64 * 4;
constexpr size_t OFF_ROPE = OFF_TW + (size_t)4096 * 8;
constexpr size_t OFF_KN = OFF_ROPE + (size_t)4096 * 32 * 8;
constexpr size_t OFF_WT = OFF_KN + (size_t)MROWS * 8 * 4;
constexpr size_t WT_WIN = 0, WT_LORA = 3145728, WT_WOUT = WT_LORA + 983040, WT_WUP = WT_WOUT + 1048576, WT_WDN = WT_WUP + 5767168, WT_END = WT_WDN + 2883584;
constexpr size_t OFF_H = OFF_WT + WT_END * 2;
constexpr size_t OFF_BIG = OFF_H + (size_t)MROWS * DM * 2;
constexpr size_t OFF_LO = OFF_BIG + (size_t)NB * HY3 * TPB * 2;
constexpr size_t WS_END = OFF_LO + (size_t)MROWS * LOW * 2;
constexpr size_t OFF_BAR = WS_END;
constexpr size_t OFF_WT2 = OFF_BAR + 16384;
constexpr size_t WS_END2 = OFF_WT2 + WT_END * 2;
constexpr size_t OFF_L = OFF_BIG + (size_t)MROWS * PW * 2;

DI f32x4 ld_nt16(const float* q) { return __builtin_nontemporal_load((const f32x4*)q); }
DI float bf2f(bf16_t h) { return __uint_as_float(((unsigned)h) << 16); }
DI unsigned pack2(float a, float b) { bf16v2 v = {(__bf16)a, (__bf16)b}; return __builtin_bit_cast(unsigned, v); }
DI bf16_t f2bf(float a) { __bf16 v = (__bf16)a; return __builtin_bit_cast(bf16_t, v); }
DI float lo16(unsigned u) { return __uint_as_float(u << 16); }
DI float hi16(unsigned u) { return __uint_as_float(u & 0xffff0000u); }
DI float sigmoidf_(float x) { return 1.f / (1.f + __expf(-x)); }
DI float siluf_(float x) { return x / (1.f + __expf(-x)); }
DI float dpp_sum16(float x) {
  x += __builtin_bit_cast(float, __builtin_amdgcn_update_dpp(0, __builtin_bit_cast(int, x), 0x128, 0xf, 0xf, false));
  x += __builtin_bit_cast(float, __builtin_amdgcn_update_dpp(0, __builtin_bit_cast(int, x), 0x124, 0xf, 0xf, false));
  x += __builtin_bit_cast(float, __builtin_amdgcn_update_dpp(0, __builtin_bit_cast(int, x), 0x122, 0xf, 0xf, false));
  x += __builtin_bit_cast(float, __builtin_amdgcn_update_dpp(0, __builtin_bit_cast(int, x), 0x121, 0xf, 0xf, false));
  return x;
}
DI float bperm_xor(float v, int lane, int mask) {
  return __builtin_bit_cast(float, __builtin_amdgcn_ds_bpermute((lane ^ mask) << 2, __builtin_bit_cast(int, v)));
}
DI float sum16(float v) { return dpp_sum16(v); }
DI float wave_sum(float v, int lane) { v = dpp_sum16(v); v += bperm_xor(v, lane, 16); v += bperm_xor(v, lane, 32); return v; }
DI float* xrow(const DevP& p, int row, int& mi) {
  int b = row / TPB, s = row - b * TPB;
  if (s < CTXL) { mi = 8; return (float*)(p.ws + OFF_XC) + ((size_t)(b * CTXL + s)) * DM; }
  mi = b; return p.out + ((size_t)(b * SEQ + s - CTXL)) * DM;
}
DI bool prev_valid(int row) { int s = row % TPB; return s != 0 && s != CTXL; }
DI bool next_valid(int row) { int s = row % TPB; return s != CTXL - 1 && s != TPB - 1; }

constexpr int HT = 128 * 64;
DI const char* uni_ptr(const char* q) {
  unsigned lo = __builtin_amdgcn_readfirstlane((unsigned)(unsigned long long)q), hi = __builtin_amdgcn_readfirstlane((unsigned)((unsigned long long)q >> 32));
  return (const char*)(const __attribute__((address_space(1))) char*)(((unsigned long long)hi << 32) | lo);
}
DI const float* pin(const DevP& p, int i) { return (const float*)uni_ptr((const char*)p.in[i]); }
DI const float* xrow_src(const DevP& p, int row, int& mi) {
  if (!p.xin) return xrow(p, row, mi);
  const int b = row / TPB, s = row - b * TPB;
  if (s < CTXL) { mi = 8; return pin(p, I_CTX) + ((size_t)(b * CTXL + s)) * DM; }
  mi = b; return pin(p, I_X) + ((size_t)(b * SEQ + s - CTXL)) * DM;
}
DI int lds_byte(int r, int c) { int st = (r >> 4) * 2 + (c >> 5), rr = r & 15, cc = c & 31, ob = rr * 64 + cc * 2; return st * 1024 + (ob ^ (((ob >> 9) & 1) << 5)); }
DI void stage_rc(int b, int& R, int& C) { int st = b / 1024, sb = b % 1024, swz = sb ^ (((sb >> 9) & 1) << 5); R = (st >> 1) * 16 + swz / 64; C = (st & 1) * 32 + (swz % 64) / 2; }

#define WAIT_V(n) asm volatile("s_waitcnt vmcnt(" #n ")" ::: "memory")
#define WAIT_L(n) asm volatile("s_waitcnt lgkmcnt(" #n ")" ::: "memory")
#define BAR __builtin_amdgcn_s_barrier()
#define SCHED __builtin_amdgcn_sched_barrier(0)

enum { M_RES = 0, M_LORA = 1, M_FFN = 2, M_EVEN = 3, M_ODD = 4 };

struct GemmCall {
  const bf16_t* A; int lda; int M; int ksk; int ksoff;
  const bf16_t* Bt; int K;
  const float* bias; const float* mod; int msel;
  const float* e0; const float* e1; const float* e2; const float* e3;
  bf16_t* o0; bf16_t* o1;
  int mode;
};

template <int MODE>
DI void gemm_tile(const DevP& p, bf16_t* shm, const GemmCall& g, int pm, int pn, const int tid_, const int bid_) {
  constexpr bool CONV = (MODE >= M_FFN);
  constexpr int S = (MODE == M_ODD) ? 248 : 254, HALO = (MODE == M_ODD) ? 4 : 1;
  const int tid = tid_;
  const int K = g.K;
  int arow0, brow0, brow1;
  if (CONV) arow0 = pm * S - HALO; else arow0 = pm * 256;
  if (MODE == M_FFN) { brow0 = pn * 128; brow1 = FF + pn * 128; } else { brow0 = pn * 256; brow1 = pn * 256 + 128; }
  unsigned aoffv, boffv;
  { int r, c; stage_rc(tid * 16, r, c); aoffv = (unsigned)(r * g.lda + c) * 2u; boffv = (unsigned)(r * K + c) * 2u; }
  const long abase0 = (long)arow0 * g.lda, bbase0 = (long)brow0 * K, bbase1 = (long)brow1 * K;
  const bf16_t* gA = g.A; const bf16_t* gB = g.Bt; const int ksk = g.ksk, ksoff = g.ksoff;
  const int wvu = __builtin_amdgcn_readfirstlane(tid >> 6);
#define SA(b, h) (shm + ((b) * 2 + (h)) * HT)
#define SB(b, h) (shm + (4 + (b) * 2 + (h)) * HT)
#define STAGE_A(P, h, kt) do { const int _k = (kt); \
    const char* _b0 = uni_ptr((const char*)(gA + abase0 + (long)(h) * 128 * g.lda + _k * 64 + (_k >= ksk ? ksoff : 0))); \
    const char* _b1 = uni_ptr(_b0 + (long)128 * g.lda); \
    unsigned _o0 = aoffv; asm volatile("" : "+v"(_o0)); \
    __builtin_amdgcn_global_load_lds((const unsigned*)(_b0 + (size_t)_o0), (unsigned*)((char*)(P) + wvu * 1024), 16, 0, 0); \
    __builtin_amdgcn_global_load_lds((const unsigned*)(_b1 + (size_t)_o0), (unsigned*)((char*)(P) + wvu * 1024 + 8192), 16, 0, 0); } while (0)
#define STAGE_B(P, h, kt) do { \
    const char* _b0 = uni_ptr((const char*)(gB + ((h) ? bbase1 : bbase0) + (kt) * 64)); \
    const char* _b1 = uni_ptr(_b0 + (long)128 * K); \
    unsigned _o0 = boffv; asm volatile("" : "+v"(_o0)); \
    __builtin_amdgcn_global_load_lds((const unsigned*)(_b0 + (size_t)_o0), (unsigned*)((char*)(P) + wvu * 1024), 16, 0, 0); \
    __builtin_amdgcn_global_load_lds((const unsigned*)(_b1 + (size_t)_o0), (unsigned*)((char*)(P) + wvu * 1024 + 8192), 16, 0, 0); } while (0)
#define LDA(dst, b, h) for (int m = 0; m < 4; ++m) for (int k = 0; k < 2; ++k) \
    dst[m][k] = *reinterpret_cast<const bf16x8*>((char*)SA(b, h) + lds_byte(wr * 64 + m * 16 + fr, k * 32 + fq * 8))
#define LDB(dst, b, h) for (int n = 0; n < 2; ++n) for (int k = 0; k < 2; ++k) \
    dst[n][k] = *reinterpret_cast<const bf16x8*>((char*)SB(b, h) + lds_byte(wc * 32 + n * 16 + fr, k * 32 + fq * 8))
#define MMA(ai, bj, At, Bx) do { __builtin_amdgcn_s_setprio(1); \
    for (int m = 0; m < 4; ++m) for (int n = 0; n < 2; ++n) for (int k = 0; k < 2; ++k) \
      acc[ai][bj][m][n] = __builtin_amdgcn_mfma_f32_16x16x32_bf16(Bx[n][k], At[m][k], acc[ai][bj][m][n], 0, 0, 0); \
    __builtin_amdgcn_s_setprio(0); } while (0)

  const int wid = tid >> 6, lane = tid & 63, wr = wid >> 2, wc = wid & 3, fr = lane & 15, fq = lane >> 4;
  f32x4 acc[2][2][4][2] = {};
  bf16x8 At[4][2], B0[2][2], B1[2][2];
  const int nt = K / 64;
  STAGE_B(SB(0, 0), 0, 0); STAGE_A(SA(0, 0), 0, 0);
  STAGE_B(SB(0, 1), 1, 0); STAGE_A(SA(0, 1), 1, 0);
  if (wr == 1) BAR;
  WAIT_V(4); BAR;
  STAGE_B(SB(1, 0), 0, 1); STAGE_A(SA(1, 0), 0, 1); STAGE_B(SB(1, 1), 1, 1);
  WAIT_V(6); BAR;
  for (int t = 0; t < nt; t += 2) {
    const int t1 = t + 1, t2 = (t + 2 < nt) ? t + 2 : nt - 1, t3 = (t + 3 < nt) ? t + 3 : nt - 1;
    LDB(B0, 0, 0); SCHED; LDA(At, 0, 0); STAGE_A(SA(1, 1), 1, t1);
    WAIT_L(8); BAR; WAIT_L(0); MMA(0, 0, At, B0); BAR; SCHED;
    LDB(B1, 0, 1); STAGE_B(SB(0, 0), 0, t2);
    BAR; WAIT_L(0); MMA(0, 1, At, B1); BAR;
    LDA(At, 0, 1); STAGE_A(SA(0, 0), 0, t2);
    BAR; WAIT_L(0); MMA(1, 0, At, B0); BAR; SCHED;
    STAGE_B(SB(0, 1), 1, t2);
    WAIT_V(6); BAR; MMA(1, 1, At, B1); BAR;
    LDB(B0, 1, 0); SCHED; LDA(At, 1, 0); STAGE_A(SA(0, 1), 1, t2);
    WAIT_L(8); BAR; WAIT_L(0); MMA(0, 0, At, B0); BAR; SCHED;
    LDB(B1, 1, 1); STAGE_B(SB(1, 0), 0, t3);
    BAR; WAIT_L(0); MMA(0, 1, At, B1); BAR;
    LDA(At, 1, 1); STAGE_A(SA(1, 0), 0, t3);
    BAR; WAIT_L(0); MMA(1, 0, At, B0); BAR; SCHED;
    STAGE_B(SB(1, 1), 1, t3);
    WAIT_V(6); BAR; MMA(1, 1, At, B1); BAR;
  }
  WAIT_V(0);
  if (wr == 0) BAR;
#undef SA
#undef SB
#undef STAGE_A
#undef STAGE_B
#undef LDA
#undef LDB
#undef MMA
  if (PROBE_MASK != 0 && p.dry && MODE != M_RES) { __syncthreads(); return; }
  int te = tid; asm volatile("" : "+v"(te));
  const int ewr = te >> 8, ewc = (te >> 6) & 3, efr = te & 15, efq = (te & 63) >> 4;
  if (MODE == M_RES) {
    int mi; (void)xrow(p, pm * 256, mi);
    const float* gate = g.mod + mi * 6144 + g.msel * 1024;
    f32x4 gv[4], bb[4];
#pragma unroll
    for (int k = 0; k < 4; ++k) {
      const int col = pn * 256 + (k >> 1) * 128 + ewc * 32 + (k & 1) * 16 + efq * 4;
      gv[k] = *(const f32x4*)(gate + col);
      bb[k] = g.bias ? *(const f32x4*)(g.bias + col) : (f32x4){0.f, 0.f, 0.f, 0.f};
    }
#pragma unroll
    for (int ai = 0; ai < 2; ++ai)
#pragma unroll
      for (int mh = 0; mh < 4; mh += 2) {
        f32x4 xv[2][4]; float* xps[2];
#pragma unroll
        for (int m = 0; m < 2; ++m) {
          int mi2; const int rw = pm * 256 + ai * 128 + ewr * 64 + (mh + m) * 16 + efr;
          xps[m] = xrow(p, rw, mi2);
          const float* xs = p.xin ? xrow_src(p, rw, mi2) : xps[m];
#pragma unroll
          for (int k = 0; k < 4; ++k) xv[m][k] = *(const f32x4*)(xs + pn * 256 + (k >> 1) * 128 + ewc * 32 + (k & 1) * 16 + efq * 4);
        }
#pragma unroll
        for (int m = 0; m < 2; ++m)
#pragma unroll
          for (int k = 0; k < 4; ++k) {
            const f32x4 x = xv[m][k] + gv[k] * (acc[ai][k >> 1][mh + m][k & 1] + bb[k]);
            if (!p.dry) *(f32x4*)(xps[m] + pn * 256 + (k >> 1) * 128 + ewc * 32 + (k & 1) * 16 + efq * 4) = x;
          }
      }
    __syncthreads();
  } else if (MODE == M_LORA) {
    f32x4 cvs[4];
#pragma unroll
    for (int k = 0; k < 4; ++k) { const int col = pn * 256 + (k >> 1) * 128 + ewc * 32 + (k & 1) * 16 + efq * 4;
      cvs[k] = (f32x4){0.f, 0.f, 0.f, 0.f};
      if (col < 1024) cvs[k] = *(const f32x4*)(g.e0 + col); else if (col < 2048) cvs[k] = *(const f32x4*)(g.e1 + col - 1024); }
#pragma unroll
    for (int bj = 0; bj < 2; ++bj)
#pragma unroll
      for (int n = 0; n < 2; ++n) {
        const int col = pn * 256 + bj * 128 + ewc * 32 + n * 16 + efq * 4;
        const f32x4 cv = cvs[bj * 2 + n];
#pragma unroll
        for (int ai = 0; ai < 2; ++ai)
#pragma unroll
          for (int m = 0; m < 4; ++m) {
            const int row = pm * 256 + ai * 128 + ewr * 64 + m * 16 + efr;
            f32x4 a = acc[ai][bj][m][n];
            float o[4];
#pragma unroll
            for (int j = 0; j < 4; ++j) {
              float v = a[j] + cv[j];
              if (col < 1024) o[j] = 0.6065306597126334f * __builtin_amdgcn_rcpf(1.f + __expf(-v));
              else if (col < 2048) o[j] = __builtin_amdgcn_rcpf(1.f + __expf(-v));
              else o[j] = v;
            }
            uint2 pk = {pack2(o[0], o[1]), pack2(o[2], o[3])};
            *(uint2*)(g.o0 + (size_t)row * LOW + col) = pk;
          }
      }
    __syncthreads();
  } else {
    __syncthreads();
    bf16_t* T = shm;
#pragma unroll
    for (int bj = 0; bj < 2; ++bj)
#pragma unroll
      for (int n = 0; n < 2; ++n) {
        const int col = bj * 128 + ewc * 32 + n * 16 + efq * 4;
        f32x4 bv = {0.f, 0.f, 0.f, 0.f};
        if (MODE == M_ODD) bv = *(const f32x4*)(g.bias + pn * 256 + col);
#pragma unroll
        for (int ai = 0; ai < 2; ++ai)
#pragma unroll
          for (int m = 0; m < 4; ++m) {
            const int row = ai * 128 + ewr * 64 + m * 16 + efr;
            f32x4 a = acc[ai][bj][m][n] + bv;
            uint2 pk = {pack2(a[0], a[1]), pack2(a[2], a[3])};
            *(uint2*)(T + row * TP + col) = pk;
          }
      }
    float wg[3][8], bg[8], wv[3][8], bvv[8];
    if (MODE == M_FFN) {
      const int gc_ = pn * 128 + (te & 15) * 8;
#pragma unroll
      for (int e = 0; e < 8; ++e) {
#pragma unroll
        for (int q = 0; q < 3; ++q) { wg[q][e] = g.e0[q * FF2 + gc_ + e]; wv[q][e] = g.e0[q * FF2 + FF + gc_ + e]; }
        bg[e] = g.e1[gc_ + e]; bvv[e] = g.e1[FF + gc_ + e];
      }
    }
    __syncthreads();
    if (MODE == M_FFN) {
      const int cg8 = (te & 15) * 8, rsub = te >> 4;
      const int gc = pn * 128 + cg8;
      for (int i = HALO + rsub; i < HALO + S; i += 32) {
        const int grow = pm * S + (i - HALO);
        if (grow >= g.M) break;
        uint4 gp = *(const uint4*)(T + (i - 1) * TP + cg8), gcn = *(const uint4*)(T + i * TP + cg8), gn = *(const uint4*)(T + (i + 1) * TP + cg8);
        uint4 vp = *(const uint4*)(T + (i - 1) * TP + 128 + cg8), vc = *(const uint4*)(T + i * TP + 128 + cg8), vn = *(const uint4*)(T + (i + 1) * TP + 128 + cg8);
        const uint4 zz = {0u, 0u, 0u, 0u};
        const int sq = grow - (grow / TPB) * TPB;
        if (sq == 0 || sq == CTXL) { gp = zz; vp = zz; }
        if (sq == CTXL - 1 || sq == TPB - 1) { gn = zz; vn = zz; }
        const unsigned* gpa = (const unsigned*)&gp; const unsigned* gca = (const unsigned*)&gcn; const unsigned* gna = (const unsigned*)&gn;
        const unsigned* vpa = (const unsigned*)&vp; const unsigned* vca = (const unsigned*)&vc; const unsigned* vna = (const unsigned*)&vn;
        float o[8];
#pragma unroll
        for (int e = 0; e < 8; ++e) {
          const int w = e >> 1;
          const float a0 = (e & 1) ? hi16(gpa[w]) : lo16(gpa[w]), a1 = (e & 1) ? hi16(gca[w]) : lo16(gca[w]), a2 = (e & 1) ? hi16(gna[w]) : lo16(gna[w]);
          const float b0 = (e & 1) ? hi16(vpa[w]) : lo16(vpa[w]), b1 = (e & 1) ? hi16(vca[w]) : lo16(vca[w]), b2 = (e & 1) ? hi16(vna[w]) : lo16(vna[w]);
          const float gg = wg[0][e] * a0 + (wg[1][e] * a1 + (wg[2][e] * a2 + bg[e]));
          const float vv = wv[0][e] * b0 + (wv[1][e] * b1 + (wv[2][e] * b2 + bvv[e]));
          o[e] = gg * __builtin_amdgcn_rcpf(1.f + __expf(-gg)) * vv;
        }
        uint4 pk = {pack2(o[0], o[1]), pack2(o[2], o[3]), pack2(o[4], o[5]), pack2(o[6], o[7])};
        *(uint4*)(g.o0 + (size_t)grow * FF + gc) = pk;
      }
    } else if (MODE == M_EVEN) {
      const int cg8 = (te & 31) * 8, rsub = te >> 5;
      const int col = pn * 256 + cg8;
      if (col < EVEN_IN) {
        float mp[8], mn[8];
#pragma unroll
        for (int e = 0; e < 8; ++e) { mp[e] = col < A_IN ? g.e0[col + e] : 0.f; mn[e] = col < A_IN ? g.e1[col + e] : 0.f; }
        for (int i = HALO + rsub; i < HALO + S; i += 16) {
          const int grow = pm * S + (i - HALO);
          if (grow >= g.M) break;
          const int sq = grow - (grow / TPB) * TPB;
          const float pv = (sq == 0 || sq == CTXL) ? 0.f : 1.f, nv = (sq == CTXL - 1 || sq == TPB - 1) ? 0.f : 1.f;
          uint4 tp = *(const uint4*)(T + (i - 1) * TP + cg8), tc = *(const uint4*)(T + i * TP + cg8), tn = *(const uint4*)(T + (i + 1) * TP + cg8);
          const unsigned* tpa = (const unsigned*)&tp; const unsigned* tca = (const unsigned*)&tc; const unsigned* tna = (const unsigned*)&tn;
          float o[8];
#pragma unroll
          for (int e = 0; e < 8; ++e) {
            const int w = e >> 1;
            float a0 = ((e & 1) ? hi16(tpa[w]) : lo16(tpa[w])) * pv, a1 = (e & 1) ? hi16(tca[w]) : lo16(tca[w]), a2 = ((e & 1) ? hi16(tna[w]) : lo16(tna[w])) * nv;
            float z = a1 + mp[e] * (a0 - a1) + mn[e] * (a2 - a1);
            if (col >= 1536 && col < 1664) z = 1.f - 2.f / (1.f + __expf(2.f * z));
            else if (col >= 1792 && col < 1920) z = sigmoidf_(z);
            o[e] = z;
          }
          uint4 pk = {pack2(o[0], o[1]), pack2(o[2], o[3]), pack2(o[4], o[5]), pack2(o[6], o[7])};
          if (col >= 1536 && col < 1920) *(uint4*)(g.o1 + (size_t)grow * LW + (col - 1536)) = pk;
          else *(uint4*)(g.o0 + (size_t)grow * PW + col) = pk;
        }
      }
    } else {
      const int rgs = te & 3, csub = te >> 2;
#pragma unroll 1
      for (int cp = 0; cp < 2; ++cp) {
        const int cl = cp * 128 + csub, col = pn * 256 + cl;
        const float w0 = g.e0[col], w1 = g.e0[HY3 + col], w2 = g.e0[2 * HY3 + col], cb = g.e1[col];
#pragma unroll 1
        for (int rg = rgs; rg < 31; rg += 4) {
          const int grow0 = pm * S + rg * 8;
          if (grow0 >= g.M) break;
          const int i0 = HALO + rg * 8;
          float tv[10];
#pragma unroll
          for (int q = 0; q < 10; ++q) tv[q] = bf2f(T[(i0 - 1 + q) * TP + cl]);
          const int b = grow0 / TPB, s0 = grow0 - b * TPB;
          if (s0 == 0 || s0 == CTXL) tv[0] = 0.f;
          if (s0 + 8 == CTXL || s0 + 8 == TPB) tv[9] = 0.f;
          float o[8];
#pragma unroll
          for (int q = 0; q < 8; ++q) o[q] = w0 * tv[q] + (w1 * tv[q + 1] + (w2 * tv[q + 2] + cb));
          uint4 pk = {pack2(o[0], o[1]), pack2(o[2], o[3]), pack2(o[4], o[5]), pack2(o[6], o[7])};
          *(uint4*)(g.o0 + ((size_t)(b * HY3 + col)) * TPB + s0) = pk;
        }
      }
    }
    __syncthreads();
  }
}

template <int MODE>
DI void gemm_phase(const DevP& p, bf16_t* shm, const GemmCall& g, int nM, int nN, const int tid_, const int bid_) {
  const int total = nM * nN, share = (total + 7) >> 3, xcd = bid_ & 7, lb = bid_ >> 3, nlb = (int)gridDim.x >> 3;
  const int lend = min((xcd + 1) * share, total), nig = 8 * nN;
  for (int L = xcd * share + lb; L < lend; L += nlb) {
    const int gid = L / nig, fm = gid * 8, gsz = min(nM - fm, 8), wi = L - gid * nig;
    gemm_tile<MODE>(p, shm, g, fm + wi % gsz, wi / gsz, tid_, bid_);
  }
}

DI void wconv(const float* src, int K, int N, bf16_t* dst, float* sh, const int tid_, const int bid_, const int nwk_) {
  const int tid = tid_, tk = K / 64, tn = N / 64, ntile = tk * tn;
  const int kk0 = tid >> 4, nn4 = (tid & 15) * 4;
  int it = bid_;
  f32x4 v0 = {0.f, 0.f, 0.f, 0.f}, v1 = v0;
  if (it < ntile) { const int k0 = (it / tn) * 64, n0 = (it % tn) * 64;
    v0 = ld_nt16(src + (size_t)(k0 + kk0) * N + n0 + nn4); v1 = ld_nt16(src + (size_t)(k0 + kk0 + 32) * N + n0 + nn4); }
  while (it < ntile) {
    const int k0 = (it / tn) * 64, n0 = (it % tn) * 64;
    sh[kk0 * 65 + nn4] = v0[0]; sh[kk0 * 65 + nn4 + 1] = v0[1]; sh[kk0 * 65 + nn4 + 2] = v0[2]; sh[kk0 * 65 + nn4 + 3] = v0[3];
    sh[(kk0 + 32) * 65 + nn4] = v1[0]; sh[(kk0 + 32) * 65 + nn4 + 1] = v1[1]; sh[(kk0 + 32) * 65 + nn4 + 2] = v1[2]; sh[(kk0 + 32) * 65 + nn4 + 3] = v1[3];
    __syncthreads();
    const int itn = it + nwk_;
    if (itn < ntile) { const int k1 = (itn / tn) * 64, n1 = (itn % tn) * 64;
      v0 = ld_nt16(src + (size_t)(k1 + kk0) * N + n1 + nn4); v1 = ld_nt16(src + (size_t)(k1 + kk0 + 32) * N + n1 + nn4); }
    { const int nn = tid >> 3, kp = (tid & 7) * 8;
      uint4 pk = {pack2(sh[kp * 65 + nn], sh[(kp + 1) * 65 + nn]), pack2(sh[(kp + 2) * 65 + nn], sh[(kp + 3) * 65 + nn]),
                  pack2(sh[(kp + 4) * 65 + nn], sh[(kp + 5) * 65 + nn]), pack2(sh[(kp + 6) * 65 + nn], sh[(kp + 7) * 65 + nn])};
      *(uint4*)(dst + (size_t)(n0 + nn) * K + k0 + kp) = pk; }
    __syncthreads();
    it = itn;
  }
}

DI void norm_phase(const DevP& p, int layer, int which, const int tid_, const int bid_) {
  const float* gw = pin(p, which ? I_N2G : I_N1G) + layer * DM;
  const float* mod = (const float*)(p.ws + OFF_MOD) + (size_t)layer * 9 * 6144;
  bf16_t* H = (bf16_t*)(p.ws + OFF_H);
  const int lane = tid_ & 63, gw_id = bid_ * 8 + (tid_ >> 6), nw = gridDim.x * 8;
  for (int row0 = gw_id; row0 < MROWS; row0 += 2 * nw) {
    const int row1 = row0 + nw; const bool has1 = row1 < MROWS;
    int mi0, mi1; const float* xp0 = xrow_src(p, row0, mi0); const float* xp1 = xrow_src(p, has1 ? row1 : row0, mi1);
    f32x4 v0[4], v1[4]; float ss0 = 0.f, ss1 = 0.f;
#pragma unroll
    for (int q = 0; q < 4; ++q) { v0[q] = *(const f32x4*)(xp0 + q * 256 + lane * 4); v1[q] = *(const f32x4*)(xp1 + q * 256 + lane * 4); }
#pragma unroll
    for (int q = 0; q < 4; ++q) { ss0 += v0[q][0] * v0[q][0] + v0[q][1] * v0[q][1] + v0[q][2] * v0[q][2] + v0[q][3] * v0[q][3];
                                  ss1 += v1[q][0] * v1[q][0] + v1[q][1] * v1[q][1] + v1[q][2] * v1[q][2] + v1[q][3] * v1[q][3]; }
    ss0 = wave_sum(ss0, lane); ss1 = wave_sum(ss1, lane);
    const float rstd0 = rsqrtf(ss0 * (1.f / DM) + 1e-6f), rstd1 = rsqrtf(ss1 * (1.f / DM) + 1e-6f);
    const float* sh0 = mod + mi0 * 6144 + (which ? 3 : 0) * 1024; const float* sh1 = mod + mi1 * 6144 + (which ? 3 : 0) * 1024;
#pragma unroll
    for (int q = 0; q < 4; ++q) {
      const int c = q * 256 + lane * 4;
      const f32x4 gg = *(const f32x4*)(gw + c);
      { const f32x4 s1 = *(const f32x4*)(sh0 + 1024 + c), s0 = *(const f32x4*)(sh0 + c); float o[4];
#pragma unroll
        for (int j = 0; j < 4; ++j) o[j] = v0[q][j] * rstd0 * gg[j] * (1.f + s1[j]) + s0[j];
        uint2 pk = {pack2(o[0], o[1]), pack2(o[2], o[3])};
        *(uint2*)(H + (size_t)row0 * DM + c) = pk; }
      if (has1) { const f32x4 s1 = *(const f32x4*)(sh1 + 1024 + c), s0 = *(const f32x4*)(sh1 + c); float o[4];
#pragma unroll
        for (int j = 0; j < 4; ++j) o[j] = v1[q][j] * rstd1 * gg[j] * (1.f + s1[j]) + s0[j];
        uint2 pk = {pack2(o[0], o[1]), pack2(o[2], o[3])};
        *(uint2*)(H + (size_t)row1 * DM + c) = pk; }
    }
  }
}

DI void phase_setup(const DevP& p, char* shmc, const int tid_, const int bid_) {
  const int tid = tid_;
  const size_t gtid = (size_t)bid_ * NTHR + tid, gn = (size_t)gridDim.x * NTHR;
  { float2* tw = (float2*)(p.ws + OFF_TW);
    for (size_t i = gtid; i < 4096; i += gn) { float sn, cs; sincospif((float)i / 4096.f, &sn, &cs); tw[i] = make_float2(cs, -sn); }
    float2* rp = (float2*)(p.ws + OFF_ROPE);
    for (size_t i = gtid; i < 4096 * 32; i += gn) { int t = (int)(i >> 5), f = (int)(i & 31); float pos = (f < 16) ? (float)(t / 64) : (float)(t % 64);
      float inv = powf(10000.f, -(float)(f & 15) / 16.f); float a = pos * inv; rp[i] = make_float2(cosf(a), sinf(a)); } }
  { float* sc = (float*)shmc;
    float* red = sc + 9 * 1024;
    for (int i = tid; i < 9 * 1024; i += NTHR) { int mi = i >> 10, k = i & 1023; float v = (mi < 8) ? pin(p, I_C)[mi * 1024 + k] : pin(p, I_CCTX)[k]; sc[i] = siluf_(v); }
    __syncthreads();
    float* mod = (float*)(p.ws + OFF_MOD);
    float* red2 = sc + 9 * 1024;
    for (int it = bid_; it < 4 * 48; it += gridDim.x) {
      const int l = it / 48, c0 = (it % 48) * 128, n4 = (tid & 31) * 4, ks = tid >> 5;
      const float* w = pin(p, I_ADAW) + (size_t)l * 1024 * 6144 + c0 + n4;
      f32x4 a[9];
#pragma unroll
      for (int q = 0; q < 9; ++q) a[q] = (f32x4){0.f, 0.f, 0.f, 0.f};
#pragma unroll 8
      for (int k = ks * 64; k < ks * 64 + 64; ++k) { const f32x4 wv = *(const f32x4*)(w + (size_t)k * 6144);
#pragma unroll
        for (int q = 0; q < 9; ++q) a[q] += sc[q * 1024 + k] * wv; }
#pragma unroll
      for (int q = 0; q < 9; ++q) *(f32x4*)(red2 + (ks * 9 + q) * 128 + n4) = a[q];
      __syncthreads();
      for (int o = tid; o < 9 * 128; o += NTHR) { const int q = o >> 7, c = o & 127; float sum = 0.f;
#pragma unroll
        for (int k2 = 0; k2 < 16; ++k2) sum += red2[(k2 * 9 + q) * 128 + c];
        mod[((size_t)l * 9 + q) * 6144 + c0 + c] = sum + pin(p, I_ADAB)[l * 6144 + c0 + c]; }
      __syncthreads();
    }
  }
  { float* scr = (float*)shmc + (tid >> 6) * 128;
    const int lane = tid & 63, gw_id = bid_ * 8 + (tid >> 6), nw = gridDim.x * 8;
    for (int r = gw_id; r < 2 * (4096 + 256); r += nw) {
      const int j = r / 4352, rr = r % 4352, type = rr >= 4096, i = type ? rr - 4096 : rr, n = type ? 256 : 4096;
      const float tpos = (float)i / (float)(n - 1), ang = 6.283185307179586f * (float)i / (float)n;
      float z = 0.f;
      if (lane == 0) z = tpos;
      else if (lane <= 32) { int e = (lane - 1) & 15; float f = 1e-4f + (float)e * ((15.f - 1e-4f) / 15.f); z = (lane <= 16) ? cosf(f * ang) : -sinf(f * ang); }
      scr[lane] = z;
      __builtin_amdgcn_wave_barrier();
      const float fr = pin(p, I_OFREQ)[j * 64 + lane];
      float a = pin(p, I_OFB1)[j * 64 + lane];
      { const float* W = pin(p, I_OFW1) + (size_t)j * 33 * 64 + lane; float wr_[33];
#pragma unroll
        for (int e = 0; e < 33; ++e) wr_[e] = W[e * 64];
        __builtin_amdgcn_sched_barrier(0);
#pragma unroll
        for (int e = 0; e < 33; ++e) a += scr[e] * wr_[e]; }
      float h = sinf(fr * a);
      scr[64 + lane] = h;
      __builtin_amdgcn_wave_barrier();
      a = pin(p, I_OFB2)[j * 64 + lane];
      { const float* W = pin(p, I_OFW2) + (size_t)j * 64 * 64 + lane;
#pragma unroll
        for (int e0 = 0; e0 < 64; e0 += 32) { float wr_[32];
#pragma unroll
          for (int e = 0; e < 32; ++e) wr_[e] = W[(e0 + e) * 64];
          __builtin_amdgcn_sched_barrier(0);
#pragma unroll
          for (int e = 0; e < 32; ++e) a += scr[64 + e0 + e] * wr_[e]; } }
      h = sinf(fr * a);
      __builtin_amdgcn_wave_barrier();
      scr[lane] = h;
      __builtin_amdgcn_wave_barrier();
      a = pin(p, I_OFB3)[j * 64 + lane];
      { const float* W = pin(p, I_OFW3) + (size_t)j * 64 * 64 + lane;
#pragma unroll
        for (int e0 = 0; e0 < 64; e0 += 32) { float wr_[32];
#pragma unroll
          for (int e = 0; e < 32; ++e) wr_[e] = W[(e0 + e) * 64];
          __builtin_amdgcn_sched_barrier(0);
#pragma unroll
          for (int e = 0; e < 32; ++e) a += scr[e0 + e] * wr_[e]; } }
      h = sinf(fr * a);
      float* dst = type ? (float*)(p.ws + OFF_HDNC) + ((size_t)j * 256 + i) * 64 : (float*)(p.ws + OFF_HDNL) + ((size_t)j * 4096 + i) * 64;
      dst[lane] = h;
      __builtin_amdgcn_wave_barrier();
    }
  }
}

DI void phase_taps(const DevP& p, int j, char* shmc, const int tid_, const int bid_, const int nwk_);
DI void convert_layer(const DevP& p, int layer, bf16_t* wt, char* shmc, const int tid_, const int bid_, const int nwk_, const int parts) {
  float* sh = (float*)shmc;
  const int j = layer >> 1;
  if ((layer & 1) == 0) { if (parts & 1) {
    wconv(pin(p, I_EWIN) + (size_t)j * DM * EVEN_IN, DM, EVEN_IN, wt + WT_WIN, sh, tid_, bid_, nwk_);
    {
      unsigned* z = (unsigned*)(wt + WT_WIN + (size_t)EVEN_IN * DM);
      for (size_t i = (size_t)bid_ * NTHR + tid_; i < (size_t)128 * DM / 2; i += (size_t)nwk_ * NTHR) z[i] = 0u; }
    wconv(pin(p, I_EWOUT) + (size_t)j * DM * DM, DM, DM, wt + WT_WOUT, sh, tid_, bid_, nwk_);
    {
      bf16_t* lb = wt + WT_LORA;
      for (size_t i = (size_t)bid_ * NTHR + tid_; i < (size_t)LOW * LW; i += (size_t)nwk_ * NTHR) {
        const int n = (int)(i / LW), k = (int)(i % LW); float v = 0.f;
        if (n < 512) { if (k < 64) v = pin(p, I_EW2)[(((size_t)j * 2 + 0) * 64 + k) * 512 + n]; }
        else if (n < 1024) { if (k >= 64 && k < 128) v = pin(p, I_EW2)[(((size_t)j * 2 + 1) * 64 + (k - 64)) * 512 + (n - 512)]; }
        else if (n < 1536) { if (k >= 128 && k < 192) v = pin(p, I_EA2)[(((size_t)j * 2 + 0) * 64 + (k - 128)) * 512 + (n - 1024)]; }
        else if (n < 2048) { if (k >= 192 && k < 256) v = pin(p, I_EA2)[(((size_t)j * 2 + 1) * 64 + (k - 192)) * 512 + (n - 1536)]; }
        else { if (k >= 256) v = pin(p, I_EG2)[((size_t)j * 128 + (k - 256)) * 512 + (n - 2048)]; }
        lb[i] = f2bf(v);
      } }
  } } else {
    if (parts & 1) {
    wconv(pin(p, I_OWIN) + (size_t)j * DM * HY3, DM, HY3, wt + WT_WIN, sh, tid_, bid_, nwk_);
    wconv(pin(p, I_OWOUT) + (size_t)j * DM * DM, DM, DM, wt + WT_WOUT, sh, tid_, bid_, nwk_); }
    if (parts & 2) phase_taps(p, j, shmc, tid_, bid_, nwk_);
  }
  if (parts & 4) {
  wconv(pin(p, I_FUP) + (size_t)layer * DM * FF2, DM, FF2, wt + WT_WUP, sh, tid_, bid_, nwk_);
  wconv(pin(p, I_FDN) + (size_t)layer * FF * DM, FF, DM, wt + WT_WDN, sh, tid_, bid_, nwk_); }
}
DI void phase_start(const DevP& p, int layer, char* shmc, const int tid_, const int bid_) {
  norm_phase(p, layer, 0, tid_, bid_);
  if (layer == 0) convert_layer(p, 0, (bf16_t*)(p.ws + OFF_WT), shmc, tid_, bid_, (int)gridDim.x, 7);
}

DI void phase_qkprep(const DevP& p, int j, const int tid_, const int bid_) {
  bf16_t* P = (bf16_t*)(p.ws + OFF_BIG);
  float* KN = (float*)(p.ws + OFF_KN);
  const float2* rope = (const float2*)(p.ws + OFF_ROPE);
  const int l16 = tid_ & 15;
  const int g0 = (bid_ * NTHR + tid_) >> 4, gs = ((int)gridDim.x * NTHR) >> 4;
  const float* gq = pin(p, I_EQN) + j * 64; const float* gk = pin(p, I_EKN) + j * 64;
  const float gq0 = gq[2 * l16], gq1 = gq[2 * l16 + 1], gq2 = gq[32 + 2 * l16], gq3 = gq[33 + 2 * l16];
  const float gk0 = gk[2 * l16], gk1 = gk[2 * l16 + 1], gk2 = gk[32 + 2 * l16], gk3 = gk[33 + 2 * l16];
  for (int row = g0; row < MROWS; row += gs) {
    const int s = row % TPB, t = s >= CTXL ? s - CTXL : 0;
    bf16_t* base = P + (size_t)row * PW;
    unsigned u0[10], u1[10]; uint2 uk[8]; f32x4 kkw[8];
#pragma unroll
    for (int q = 0; q < 10; ++q) { u0[q] = *(const unsigned*)(base + A_IN + q * 64 + 2 * l16); u1[q] = *(const unsigned*)(base + A_IN + q * 64 + 32 + 2 * l16); }
#pragma unroll
    for (int h = 0; h < 8; ++h) { uk[h] = *(const uint2*)(base + 512 + h * 64 + 4 * l16); kkw[h] = *(const f32x4*)(pin(p, I_EKK) + j * 512 + h * 64 + 4 * l16); }
    const float2 c0 = rope[t * 32 + 2 * l16], c1 = rope[t * 32 + 2 * l16 + 1];
#pragma unroll
    for (int q = 0; q < 10; ++q) {
      float a0 = lo16(u0[q]), a1 = hi16(u0[q]), b0 = lo16(u1[q]), b1 = hi16(u1[q]);
      const float ss = sum16(a0 * a0 + a1 * a1 + b0 * b0 + b1 * b1);
      const float rstd = rsqrtf(ss * (1.f / 64.f) + 1e-6f);
      a0 = a0 * rstd * (q < 8 ? gq0 : gk0); a1 = a1 * rstd * (q < 8 ? gq1 : gk1); b0 = b0 * rstd * (q < 8 ? gq2 : gk2); b1 = b1 * rstd * (q < 8 ? gq3 : gk3);
      if (s >= CTXL) {
        const float na0 = a0 * c0.x - b0 * c0.y, nb0 = a0 * c0.y + b0 * c0.x, na1 = a1 * c1.x - b1 * c1.y, nb1 = a1 * c1.y + b1 * c1.x;
        a0 = na0; b0 = nb0; a1 = na1; b1 = nb1;
      }
      *(unsigned*)(base + A_IN + q * 64 + 2 * l16) = pack2(a0, a1); *(unsigned*)(base + A_IN + q * 64 + 32 + 2 * l16) = pack2(b0, b1);
    }
#pragma unroll
    for (int h = 0; h < 8; ++h) {
      const float a0 = lo16(uk[h].x) * kkw[h][0], a1 = hi16(uk[h].x) * kkw[h][1], a2 = lo16(uk[h].y) * kkw[h][2], a3 = hi16(uk[h].y) * kkw[h][3];
      const float ss = sum16(a0 * a0 + a1 * a1 + a2 * a2 + a3 * a3);
      if (l16 == 0) KN[(size_t)row * 8 + h] = 1.f / fmaxf(sqrtf(ss), 1e-12f);
    }
  }
}

template <int CTRL> DI float dppf(float x) { return __builtin_bit_cast(float, __builtin_amdgcn_update_dpp(0, __builtin_bit_cast(int, x), CTRL, 0xf, 0xf, false)); }
DI void phase_scan(const DevP& p, int j, char* shmc, const int tid_, const int bid_) {
  const bf16_t* P = (const bf16_t*)(p.ws + OFF_BIG);
  const bf16_t* LO = (const bf16_t*)(p.ws + OFF_LO);
  const float* KN = (const float*)(p.ws + OFF_KN);
  bf16_t* Y = (bf16_t*)(p.ws + OFF_H);
  const int tid = tid_, l16 = tid & 15, rloc = tid >> 4;
  constexpr int TT = 32, STEPF = 5 * 64 + 32 + 4;
  constexpr int NSTEP = CTXL + SEQ, NCH = NSTEP / TT;
  float* buf = (float*)shmc;
  float* ybuf = buf + 2 * TT * STEPF;
  for (int u = bid_; u < 256; u += gridDim.x) {
    const int chain = u >> 1, half = u & 1, d = chain >> 6, b = (chain >> 3) & 7, h = chain & 7;
    f32x4 kkw = *(const f32x4*)(pin(p, I_EKK) + j * 512 + h * 64 + 4 * l16), kaw = *(const f32x4*)(pin(p, I_EKA) + j * 512 + h * 64 + 4 * l16);
    f32x4 S = {0.f, 0.f, 0.f, 0.f};
    float sa = 0.f;
    uint2 gr, gk, ge, ga, gv, gk2; float gkn, gkn2;
    auto rowof = [&](int g) -> int {
      g = g > NSTEP - 1 ? NSTEP - 1 : g;
      const int seg = g >= CTXL, st = seg ? g - CTXL : g, n = seg ? SEQ : CTXL, t = d ? (n - 1 - st) : st;
      return b * TPB + (seg ? CTXL + t : t);
    };
    auto gload = [&](int c) {
      const int row = rowof(c * TT + rloc), row2 = rowof(c * TT + rloc + 1);
      const bf16_t* pr = P + (size_t)row * PW + h * 64 + 4 * l16;
      gr = *(const uint2*)pr; gk = *(const uint2*)(pr + 512);
      gk2 = *(const uint2*)(P + (size_t)row2 * PW + 512 + h * 64 + 4 * l16);
      const bf16_t* lo = LO + (size_t)row * LOW + d * 512 + h * 64 + 4 * l16;
      ge = *(const uint2*)lo; ga = *(const uint2*)(lo + 1024);
      gkn = KN[(size_t)row * 8 + h]; gkn2 = KN[(size_t)row2 * 8 + h];
      if (l16 < 8) gv = *(const uint2*)(P + (size_t)row * PW + 1024 + h * 64 + half * 32 + 4 * l16);
    };
    auto lstore = [&](int bi) {
      float* dst = buf + ((size_t)bi * TT + rloc) * STEPF;
      float k4[4] = {lo16(gk.x), hi16(gk.x), lo16(gk.y), hi16(gk.y)}, e4[4] = {lo16(ge.x), hi16(ge.x), lo16(ge.y), hi16(ge.y)};
      float a4[4] = {lo16(ga.x), hi16(ga.x), lo16(ga.y), hi16(ga.y)}, n4[4] = {lo16(gk2.x), hi16(gk2.x), lo16(gk2.y), hi16(gk2.y)};
      f32x4 w, q, kka, kd, r = {lo16(gr.x), hi16(gr.x), lo16(gr.y), hi16(gr.y)};
      float c1 = 0.f, c2 = 0.f;
#pragma unroll
      for (int e = 0; e < 4; ++e) {
        w[e] = __expf(-e4[e]); const float kk = k4[e] * kkw[e] * gkn, kkn = n4[e] * kkw[e] * gkn2;
        kka[e] = kk * a4[e]; kd[e] = k4[e] * (1.f + (a4[e] - 1.f) * kaw[e]); q[e] = w[e] * kkn;
        c1 += kka[e] * kkn; c2 += kd[e] * kkn;
      }
      c1 = dpp_sum16(c1); c2 = dpp_sum16(c2);
      *(f32x4*)(dst + 0 + 4 * l16) = q; *(f32x4*)(dst + 64 + 4 * l16) = kka; *(f32x4*)(dst + 128 + 4 * l16) = kd; *(f32x4*)(dst + 192 + 4 * l16) = w; *(f32x4*)(dst + 256 + 4 * l16) = r;
      if (l16 < 8) { f32x4 v = {lo16(gv.x), hi16(gv.x), lo16(gv.y), hi16(gv.y)}; *(f32x4*)(dst + 320 + 4 * l16) = v; }
      if (l16 == 0) { dst[352] = c1; dst[353] = c2; }
    };
    __syncthreads();
    gload(0); lstore(0);
    __syncthreads();
    for (int c = 0; c < NCH; ++c) {
      if (c + 1 < NCH) gload(c + 1);
      const float* sb = buf + (size_t)(c & 1) * TT * STEPF;
      float* yb = ybuf + (c & 1) * TT * 32;
      f32x4 Lq[3], Lka[3], Lkd[3], Lw[3], Lr[3]; float Lv[3]; float2 Lc[3];
#define SCAN_LD(slot, st) do { const float* q_ = sb + (st) * STEPF; \
        Lq[slot] = *(const f32x4*)(q_ + 4 * l16); Lka[slot] = *(const f32x4*)(q_ + 64 + 4 * l16); Lkd[slot] = *(const f32x4*)(q_ + 128 + 4 * l16); \
        Lw[slot] = *(const f32x4*)(q_ + 192 + 4 * l16); Lr[slot] = *(const f32x4*)(q_ + 256 + 4 * l16); Lv[slot] = q_[320 + rloc]; Lc[slot] = *(const float2*)(q_ + 352); } while (0)
      SCAN_LD(0, 0); SCAN_LD(1, 1);
      float yp[16];
#pragma unroll
      for (int st = 0; st < TT; ++st) {
        if (st + 2 < TT) SCAN_LD((st + 2) % 3, st + 2);
        __builtin_amdgcn_sched_barrier(0);
        { const int sl_ = st % 3;
          const f32x4 qq = Lq[sl_], kka = Lka[sl_], kd = Lkd[sl_], w = Lw[sl_], r = Lr[sl_]; const float v = Lv[sl_]; const float2 cc = Lc[sl_];
          float pd = S[0] * qq[0] + S[1] * qq[1] + S[2] * qq[2] + S[3] * qq[3];
          pd = dpp_sum16(pd);
#pragma unroll
          for (int e = 0; e < 4; ++e) S[e] = S[e] * w[e] + sa * kka[e] + v * kd[e];
          sa = -pd - sa * cc.x - v * cc.y;
          yp[st & 15] = S[0] * r[0] + S[1] * r[1] + S[2] * r[2] + S[3] * r[3];
        }
        if ((st & 15) == 15) {
          const bool h8 = l16 & 8, h4 = l16 & 4, h2 = l16 & 2, h1 = l16 & 1;
#pragma unroll
          for (int k = 0; k < 8; ++k) { const float a = yp[k], bq = yp[k + 8]; yp[k] = (h8 ? bq : a) + dppf<0x128>(h8 ? a : bq); }
#pragma unroll
          for (int k = 0; k < 4; ++k) { const float a = yp[k], bq = yp[k + 4]; yp[k] = (h4 ? bq : a) + dppf<0x141>(h4 ? a : bq); }
#pragma unroll
          for (int k = 0; k < 2; ++k) { const float a = yp[k], bq = yp[k + 2]; yp[k] = (h2 ? bq : a) + dppf<0x4E>(h2 ? a : bq); }
          { const float a = yp[0], bq = yp[1]; yp[0] = (h1 ? bq : a) + dppf<0xB1>(h1 ? a : bq); }
          yb[((st - 15) + l16) * 32 + rloc] = yp[0];
        }
      }
#undef SCAN_LD
      if (c + 1 < NCH) lstore((c + 1) & 1);
      __syncthreads();
      {
        const int sl = tid >> 4, i2 = (tid & 15) * 2;
        const int row = rowof(c * TT + sl);
        *(unsigned*)(Y + ((size_t)d * MROWS + row) * 512 + h * 64 + half * 32 + i2) = pack2(yb[sl * 32 + i2], yb[sl * 32 + i2 + 1]);
      }
    }
    __syncthreads();
  }
}

DI void phase_attn(const DevP& p, int j, char* shmc, const int tid_, const int bid_) {
  bf16_t* P = (bf16_t*)(p.ws + OFF_BIG);
  constexpr int KP = 72;
  bf16_t* Ks = (bf16_t*)shmc;
  bf16_t* Vs = Ks + 2 * 64 * KP;
  const int tid = tid_, wid = tid >> 6, lane = tid & 63, fr = lane & 15, fq = lane >> 4;
  const int gh = wid & 3, th = wid >> 2;
  const float C2 = 0.125f * 1.4426950408889634f;
  for (int it0 = bid_; it0 < 544; it0 += gridDim.x) {
    const int it = ((int)gridDim.x == 256 && it0 < 512) ? ((it0 & ~255) | ((it0 & 7) << 5) | ((it0 >> 3) & 31)) : it0;
    int b, kvh, qb0, isctx;
    if (it < 512) { b = it >> 6; kvh = (it >> 5) & 1; qb0 = it & 31; isctx = 0; }
    else { int i2 = it - 512; b = i2 >> 2; kvh = (i2 >> 1) & 1; qb0 = i2 & 1; isctx = 1; }
    const int head = kvh * 4 + gh;
    const int tq0 = qb0 * 128 + th * 64;
    const int rowbase = b * TPB + (isctx ? 0 : CTXL);
    bf16x8 bq[4][2];
#pragma unroll
    for (int qb = 0; qb < 4; ++qb)
#pragma unroll
      for (int ds = 0; ds < 2; ++ds)
        bq[qb][ds] = *(const bf16x8*)(P + (size_t)(rowbase + tq0 + qb * 16 + fr) * PW + A_IN + head * 64 + ds * 32 + fq * 8);
    f32x4 O[4][4];
#pragma unroll
    for (int a = 0; a < 4; ++a)
#pragma unroll
      for (int c = 0; c < 4; ++c) O[a][c] = (f32x4){0.f, 0.f, 0.f, 0.f};
    const float sinkl = pin(p, I_ESINK)[j * 8 + head] * 1.4426950408889634f;
    float mrun[4], lrun[4];
#pragma unroll
    for (int qb = 0; qb < 4; ++qb) { mrun[qb] = sinkl; lrun[qb] = (fq == 0) ? 1.f : 0.f; }
    const int ntile = isctx ? 4 : 10;
    auto tile_row0 = [&](int ti, bool& valid, bool& lat) -> int {
      if (!isctx && ti < 6) { int kb = qb0 * 128 + (ti - 2) * 64; lat = true; valid = (kb >= 0 && kb < SEQ); return b * TPB + CTXL + kb; }
      int ci = isctx ? ti : ti - 6; lat = false; valid = true; return b * TPB + ci * 64;
    };
    uint4 kreg, vreg;
    const int lkey = tid >> 3, ldg = tid & 7;
    auto gl = [&](int ti) { bool v, l; int r0 = tile_row0(ti, v, l); if (v) {
        const bf16_t* src = P + (size_t)(r0 + lkey) * PW + A_IN + 512 + kvh * 64 + ldg * 8;
        kreg = *(const uint4*)src; vreg = *(const uint4*)(src + 128); } };
    auto ls = [&](int ti, int bi) { bool v, l; tile_row0(ti, v, l); if (v) {
        *(uint4*)(Ks + bi * 64 * KP + lkey * KP + ldg * 8) = kreg;
        bf16_t* vt = Vs + bi * 64 * KP; const unsigned* vr = (const unsigned*)&vreg;
#pragma unroll
        for (int e = 0; e < 8; ++e) vt[(ldg * 8 + e) * KP + lkey] = (bf16_t)((e & 1) ? (vr[e >> 1] >> 16) : (vr[e >> 1] & 0xffffu)); } };
    __syncthreads();
    gl(0); ls(0, 0);
    __syncthreads();
    for (int ti = 0; ti < ntile; ++ti) {
      if (ti + 1 < ntile) gl(ti + 1);
      bool valid, lat; const int r0 = tile_row0(ti, valid, lat);
      bool work = valid;
      const int kt0 = lat ? (r0 - (b * TPB + CTXL)) : 0;
      if (lat && (kt0 + 63 < tq0 - 128 || kt0 > tq0 + 63 + 128)) work = false;
      if (work) {
        const bf16_t* kt = Ks + (ti & 1) * 64 * KP; const bf16_t* vt = Vs + (ti & 1) * 64 * KP;
        f32x4 Sx[4][4];
#pragma unroll
        for (int kb = 0; kb < 4; ++kb) {
          bf16x8 ak0 = *(const bf16x8*)(kt + (kb * 16 + fr) * KP + fq * 8), ak1 = *(const bf16x8*)(kt + (kb * 16 + fr) * KP + 32 + fq * 8);
#pragma unroll
          for (int qb = 0; qb < 4; ++qb) {
            f32x4 s = {0.f, 0.f, 0.f, 0.f};
            s = __builtin_amdgcn_mfma_f32_16x16x32_bf16(ak0, bq[qb][0], s, 0, 0, 0);
            s = __builtin_amdgcn_mfma_f32_16x16x32_bf16(ak1, bq[qb][1], s, 0, 0, 0);
            Sx[kb][qb] = s;
          }
        }
        bf16x8 pb[4][2];
#pragma unroll
        for (int qb = 0; qb < 4; ++qb) {
          const int qtok = tq0 + qb * 16 + fr;
          float mx = -3.0e38f;
#pragma unroll
          for (int kb = 0; kb < 4; ++kb)
#pragma unroll
            for (int jj = 0; jj < 4; ++jj) {
              float s = Sx[kb][qb][jj] * C2;
              if (lat) { int dk = kt0 + kb * 16 + fq * 4 + jj - qtok; if (dk > 128 || dk < -128) s = -3.0e38f; }
              Sx[kb][qb][jj] = s; mx = fmaxf(mx, s);
            }
          mx = fmaxf(mx, bperm_xor(mx, lane, 16)); mx = fmaxf(mx, bperm_xor(mx, lane, 32));
          constexpr float THR = 11.0f;
          float alpha = 1.f;
          if (__builtin_amdgcn_ballot_w64(mx > mrun[qb] + THR) != 0ull) {
            const float mnew = fmaxf(mrun[qb], mx);
            alpha = exp2f(mrun[qb] - mnew);
            mrun[qb] = mnew;
#pragma unroll
            for (int db = 0; db < 4; ++db) O[db][qb] *= alpha;
          }
          const float mcur = mrun[qb];
          float ps = 0.f; float pv[4][4];
#pragma unroll
          for (int kb = 0; kb < 4; ++kb)
#pragma unroll
            for (int jj = 0; jj < 4; ++jj) { float e = exp2f(Sx[kb][qb][jj] - mcur); pv[kb][jj] = e; ps += e; }
          lrun[qb] = lrun[qb] * alpha + ps;
#pragma unroll
          for (int ks = 0; ks < 2; ++ks) {
            unsigned w0 = pack2(pv[2 * ks][0], pv[2 * ks][1]), w1 = pack2(pv[2 * ks][2], pv[2 * ks][3]);
            unsigned w2 = pack2(pv[2 * ks + 1][0], pv[2 * ks + 1][1]), w3 = pack2(pv[2 * ks + 1][2], pv[2 * ks + 1][3]);
            uint4 t4 = {w0, w1, w2, w3}; pb[qb][ks] = __builtin_bit_cast(bf16x8, t4);
          }
        }
#pragma unroll
        for (int db = 0; db < 4; ++db)
#pragma unroll
          for (int ks = 0; ks < 2; ++ks) {
            uint2 v0 = *(const uint2*)(vt + (db * 16 + fr) * KP + (2 * ks) * 16 + fq * 4), v1 = *(const uint2*)(vt + (db * 16 + fr) * KP + (2 * ks + 1) * 16 + fq * 4);
            uint4 t4 = {v0.x, v0.y, v1.x, v1.y}; bf16x8 av = __builtin_bit_cast(bf16x8, t4);
#pragma unroll
            for (int qb = 0; qb < 4; ++qb) O[db][qb] = __builtin_amdgcn_mfma_f32_16x16x32_bf16(av, pb[qb][ks], O[db][qb], 0, 0, 0);
          }
      }
      if (ti + 1 < ntile) ls(ti + 1, (ti + 1) & 1);
      __syncthreads();
    }
#pragma unroll
    for (int qb = 0; qb < 4; ++qb) {
      float l = lrun[qb]; l += bperm_xor(l, lane, 16); l += bperm_xor(l, lane, 32);
      const float inv = 1.f / l;
      bf16_t* dst = P + (size_t)(rowbase + tq0 + qb * 16 + fr) * PW + A_IN + head * 64 + fq * 4;
#pragma unroll
      for (int db = 0; db < 4; ++db) {
        uint2 pk = {pack2(O[db][qb][0] * inv, O[db][qb][1] * inv), pack2(O[db][qb][2] * inv, O[db][qb][3] * inv)};
        if (!p.dry) *(uint2*)(dst + db * 16) = pk;
      }
    }
  }
}

DI void phase_rwkv_out(const DevP& p, int j, const int tid_, const int bid_) {
  bf16_t* P = (bf16_t*)(p.ws + OFF_BIG);
  const bf16_t* LO = (const bf16_t*)(p.ws + OFF_LO);
  const bf16_t* Y = (const bf16_t*)(p.ws + OFF_H);
  const int l16 = tid_ & 15;
  const int g0 = (bid_ * NTHR + tid_) >> 4, gs = ((int)gridDim.x * NTHR) >> 4, NIT = MROWS * 8;
  for (int it0 = g0; it0 < NIT; it0 += 2 * gs) {
    uint2 y0[2], y1[2], ur[2], uk[2], uv[2], ua0[2], ua1[2], ug[2]; f32x4 ka[2], rk[2], lw[2], lb[2]; bf16_t* prs[2]; bool ok[2];
#pragma unroll
    for (int k = 0; k < 2; ++k) {
      const int itk = it0 + k * gs; ok[k] = itk < NIT; const int it = ok[k] ? itk : it0;
      const int row = it >> 3, h = it & 7, c = h * 64 + 4 * l16;
      y0[k] = *(const uint2*)(Y + (size_t)row * 512 + c); y1[k] = *(const uint2*)(Y + ((size_t)MROWS + row) * 512 + c);
      bf16_t* pr = P + (size_t)row * PW + c; prs[k] = pr;
      ur[k] = *(const uint2*)pr; uk[k] = *(const uint2*)(pr + 512); uv[k] = *(const uint2*)(pr + 1024);
      const bf16_t* lo = LO + (size_t)row * LOW + c;
      ua0[k] = *(const uint2*)(lo + 1024); ua1[k] = *(const uint2*)(lo + 1536); ug[k] = *(const uint2*)(lo + 2048);
      ka[k] = *(const f32x4*)(pin(p, I_EKA) + j * 512 + c); rk[k] = *(const f32x4*)(pin(p, I_ERK) + j * 512 + c);
      lw[k] = *(const f32x4*)(pin(p, I_ELNW) + j * 512 + c); lb[k] = *(const f32x4*)(pin(p, I_ELNB) + j * 512 + c);
    }
#pragma unroll
    for (int k = 0; k < 2; ++k) {
      const float y[4] = {lo16(y0[k].x) + lo16(y1[k].x), hi16(y0[k].x) + hi16(y1[k].x), lo16(y0[k].y) + lo16(y1[k].y), hi16(y0[k].y) + hi16(y1[k].y)};
      const float r[4] = {lo16(ur[k].x), hi16(ur[k].x), lo16(ur[k].y), hi16(ur[k].y)}, kq[4] = {lo16(uk[k].x), hi16(uk[k].x), lo16(uk[k].y), hi16(uk[k].y)};
      const float v[4] = {lo16(uv[k].x), hi16(uv[k].x), lo16(uv[k].y), hi16(uv[k].y)}, a0[4] = {lo16(ua0[k].x), hi16(ua0[k].x), lo16(ua0[k].y), hi16(ua0[k].y)};
      const float a1[4] = {lo16(ua1[k].x), hi16(ua1[k].x), lo16(ua1[k].y), hi16(ua1[k].y)}, gg[4] = {lo16(ug[k].x), hi16(ug[k].x), lo16(ug[k].y), hi16(ug[k].y)};
      float sy = 0.f, bo = 0.f;
#pragma unroll
      for (int q = 0; q < 4; ++q) { sy += y[q]; const float kd = kq[q] * (2.f + (a0[q] + a1[q] - 2.f) * ka[k][q]); bo += r[q] * kd * rk[k][q]; }
      sy = sum16(sy); bo = sum16(bo);
      const float mu = sy * (1.f / 64.f);
      float sv = 0.f;
#pragma unroll
      for (int q = 0; q < 4; ++q) { const float dd = y[q] - mu; sv += dd * dd; }
      sv = sum16(sv);
      const float rs = rsqrtf(sv * (1.f / 64.f) + 64e-5f);
      float o[4];
#pragma unroll
      for (int q = 0; q < 4; ++q) o[q] = ((y[q] - mu) * rs * lw[k][q] + lb[k][q] + bo * v[q]) * gg[q];
      uint2 pk = {pack2(o[0], o[1]), pack2(o[2], o[3])};
      if (ok[k] && !p.dry) *(uint2*)prs[k] = pk;
    }
  }
}

DI int PI(int n) { return n + (n >> 5); }
DI float2 cmul(float2 a, float2 b) { return make_float2(a.x * b.x - a.y * b.y, a.x * b.y + a.y * b.x); }
DI float2 cmulc(float2 a, float2 b) { return make_float2(a.x * b.x + a.y * b.y, a.y * b.x - a.x * b.y); }
template <int M> DI float2 c16() {
  constexpr float cs[8] = {1.f, 0.9238795325112867f, 0.7071067811865476f, 0.3826834323650898f, 0.f, -0.3826834323650898f, -0.7071067811865476f, -0.9238795325112867f};
  constexpr float sn[8] = {0.f, -0.3826834323650898f, -0.7071067811865476f, -0.9238795325112867f, -1.f, -0.9238795325112867f, -0.7071067811865476f, -0.3826834323650898f};
  return make_float2(cs[M], sn[M]);
}
template <int S, int I, bool TWD> DI void bfly_f(float2 (&x)[16], float2 w) {
  constexpr int hs = 8 >> S, m = I & (hs - 1);
  float2 a = x[I], b = x[I + hs];
  x[I] = make_float2(a.x + b.x, a.y + b.y);
  float2 d = make_float2(a.x - b.x, a.y - b.y);
  float2 W = c16<m * (8 / hs)>();
  if (TWD) W = cmul(W, w);
  x[I + hs] = (m == 0 && !TWD) ? d : cmul(d, W);
}
template <int S, int I, bool TWD> DI void bfly_i(float2 (&x)[16], float2 w) {
  constexpr int hs = 8 >> S, m = I & (hs - 1);
  float2 W = c16<m * (8 / hs)>();
  if (TWD) W = cmul(W, w);
  float2 a = x[I], t = (m == 0 && !TWD) ? x[I + hs] : cmulc(x[I + hs], W);
  x[I] = make_float2(a.x + t.x, a.y + t.y);
  x[I + hs] = make_float2(a.x - t.x, a.y - t.y);
}
template <int S, bool TWD> DI void stage_f(float2 (&x)[16], float2 w) {
  constexpr int hs = 8 >> S;
  if (!(0 & hs)) bfly_f<S, 0, TWD>(x, w);
  if (!(1 & hs)) bfly_f<S, 1 & ~hs, TWD>(x, w);
  if (!(2 & hs)) bfly_f<S, 2 & ~hs, TWD>(x, w);
  if (!(3 & hs)) bfly_f<S, 3 & ~hs, TWD>(x, w);
  if (!(4 & hs)) bfly_f<S, 4 & ~hs, TWD>(x, w);
  if (!(5 & hs)) bfly_f<S, 5 & ~hs, TWD>(x, w);
  if (!(6 & hs)) bfly_f<S, 6 & ~hs, TWD>(x, w);
  if (!(7 & hs)) bfly_f<S, 7 & ~hs, TWD>(x, w);
  if (!(8 & hs)) bfly_f<S, 8 & ~hs, TWD>(x, w);
  if (!(9 & hs)) bfly_f<S, 9 & ~hs, TWD>(x, w);
  if (!(10 & hs)) bfly_f<S, 10 & ~hs, TWD>(x, w);
  if (!(11 & hs)) bfly_f<S, 11 & ~hs, TWD>(x, w);
  if (!(12 & hs)) bfly_f<S, 12 & ~hs, TWD>(x, w);
  if (!(13 & hs)) bfly_f<S, 13 & ~hs, TWD>(x, w);
  if (!(14 & hs)) bfly_f<S, 14 & ~hs, TWD>(x, w);
  if (!(15 & hs)) bfly_f<S, 15 & ~hs, TWD>(x, w);
}
template <int S, bool TWD> DI void stage_i(float2 (&x)[16], float2 w) {
  constexpr int hs = 8 >> S;
  if (!(0 & hs)) bfly_i<S, 0, TWD>(x, w);
  if (!(1 & hs)) bfly_i<S, 1 & ~hs, TWD>(x, w);
  if (!(2 & hs)) bfly_i<S, 2 & ~hs, TWD>(x, w);
  if (!(3 & hs)) bfly_i<S, 3 & ~hs, TWD>(x, w);
  if (!(4 & hs)) bfly_i<S, 4 & ~hs, TWD>(x, w);
  if (!(5 & hs)) bfly_i<S, 5 & ~hs, TWD>(x, w);
  if (!(6 & hs)) bfly_i<S, 6 & ~hs, TWD>(x, w);
  if (!(7 & hs)) bfly_i<S, 7 & ~hs, TWD>(x, w);
  if (!(8 & hs)) bfly_i<S, 8 & ~hs, TWD>(x, w);
  if (!(9 & hs)) bfly_i<S, 9 & ~hs, TWD>(x, w);
  if (!(10 & hs)) bfly_i<S, 10 & ~hs, TWD>(x, w);
  if (!(11 & hs)) bfly_i<S, 11 & ~hs, TWD>(x, w);
  if (!(12 & hs)) bfly_i<S, 12 & ~hs, TWD>(x, w);
  if (!(13 & hs)) bfly_i<S, 13 & ~hs, TWD>(x, w);
  if (!(14 & hs)) bfly_i<S, 14 & ~hs, TWD>(x, w);
  if (!(15 & hs)) bfly_i<S, 15 & ~hs, TWD>(x, w);
}
template <bool TWD> DI void r16_fwd(float2 (&x)[16], float2 w0) {
  float2 w1 = cmul(w0, w0), w2 = cmul(w1, w1), w3 = cmul(w2, w2);
  stage_f<0, TWD>(x, w0); stage_f<1, TWD>(x, w1); stage_f<2, TWD>(x, w2); stage_f<3, TWD>(x, w3);
}
template <bool TWD> DI void r16_inv(float2 (&x)[16], float2 w0) {
  float2 w1 = cmul(w0, w0), w2 = cmul(w1, w1), w3 = cmul(w2, w2);
  stage_i<3, TWD>(x, w3); stage_i<2, TWD>(x, w2); stage_i<1, TWD>(x, w1); stage_i<0, TWD>(x, w0);
}
DI void passA(float2* D, const float2 w0, int tid, bool inv) {
  const int base = (tid >> 8) * 4096 + (tid & 255);
  float2 x[16];
#pragma unroll
  for (int i = 0; i < 16; ++i) x[i] = D[PI(base + i * 256)];
  if (inv) r16_inv<true>(x, w0); else r16_fwd<true>(x, w0);
#pragma unroll
  for (int i = 0; i < 16; ++i) D[PI(base + i * 256)] = x[i];
}
DI void passB(float2* D, const float2 w0, int tid, bool inv) {
  const int base = (tid >> 4) * 256 + (tid & 15);
  float2 x[16];
#pragma unroll
  for (int i = 0; i < 16; ++i) x[i] = D[PI(base + i * 16)];
  if (inv) r16_inv<true>(x, w0); else r16_fwd<true>(x, w0);
#pragma unroll
  for (int i = 0; i < 16; ++i) D[PI(base + i * 16)] = x[i];
}

DI void phase_taps(const DevP& p, int j, char* shmc, const int tid_, const int bid_, const int nwk_) {
  float* hs = (float*)shmc;
  float* fs = hs + 64 * 65;
  const float* fout = pin(p, I_OFOUT) + (size_t)j * 64 * 4096;
  const float da = -3.0701134573253945f, db = -15.350567286626973f;
  const int tid = tid_;
  for (int it = bid_; it < 64 * 68; it += nwk_) {
    const int ct = it / 68, tt = it % 68, isc = tt >= 64, t0 = (isc ? tt - 64 : tt) * 64, c0 = ct * 64, n = isc ? 256 : 4096;
    const float* hdn = isc ? (const float*)(p.ws + OFF_HDNC) + (size_t)j * 256 * 64 : (const float*)(p.ws + OFF_HDNL) + (size_t)j * 4096 * 64;
    __syncthreads();
    { float hv_[8], fv_[8];
#pragma unroll
      for (int q = 0; q < 8; ++q) { const int e = tid + q * NTHR, r = e >> 6, cc = e & 63; hv_[q] = hdn[(size_t)(t0 + r) * 64 + cc]; fv_[q] = fout[(size_t)r * 4096 + c0 + cc]; }
      __builtin_amdgcn_sched_barrier(0);
#pragma unroll
      for (int q = 0; q < 8; ++q) { const int e = tid + q * NTHR, r = e >> 6, cc = e & 63; hs[r * 65 + cc] = hv_[q]; fs[r * 64 + cc] = fv_[q]; } }
    __syncthreads();
    const int tl = tid & 63, cg8 = (tid >> 6) * 8;
    float acc[8];
#pragma unroll
    for (int e = 0; e < 8; ++e) acc[e] = 0.f;
    for (int k = 0; k < 64; ++k) { const float hv = hs[tl * 65 + k];
#pragma unroll
      for (int e = 0; e < 8; ++e) acc[e] += hv * fs[k * 64 + cg8 + e]; }
    const float tpos = (float)(t0 + tl) / (float)(n - 1);
#pragma unroll
    for (int e = 0; e < 8; ++e) {
      const int c = c0 + cg8 + e, d = c & 1023;
      const float delta = fabsf(da + (db - da) * (float)d / (float)(DM - 1));
      const float v = acc[e] * (__expf(-tpos * delta) + 0.05f);
      if (isc) ((float*)(p.ws + OFF_LO) + (size_t)4096 * 4096)[(size_t)c * 256 + t0 + tl] = v;
      else ((float*)(p.ws + OFF_LO))[(size_t)c * 4096 + t0 + tl] = v;
    }
  }
}

DI void phase_hyena(const DevP& p, int j, char* shmc, const int tid_, const int bid_) {
  bf16_t* ZT = (bf16_t*)(p.ws + OFF_BIG);
  const float2* TW = (const float2*)(p.ws + OFF_TW);
  const float* HFL = (const float*)(p.ws + OFF_LO);
  const float* HFC = HFL + (size_t)4096 * 4096;
  float2* D = (float2*)shmc;
  float2* KF = D + 8448;
  const int tid = tid_;
  for (int d = bid_; d < DM; d += gridDim.x) {
#pragma unroll 1
    for (int o = 0; o < 2; ++o) {
      const float skip = pin(p, I_OSKIP)[(j * 2 + o) * DM + d];
      const float* cf = HFL + ((size_t)((o * 2 + 0) * DM + d)) * 4096;
      const float* cb = HFL + ((size_t)((o * 2 + 1) * DM + d)) * 4096;
      __syncthreads();
      for (int t = tid; t < 4096; t += NTHR) {
        const float lo = (t == 0) ? cf[0] + cb[0] : cf[t];
        const float hi = (t == 0) ? 0.f : cb[4096 - t];
        const float2 w = TW[t];
        D[PI(t)] = make_float2(lo + hi, 0.f);
        const float dd = lo - hi;
        D[PI(4096 + t)] = make_float2(dd * w.x, dd * w.y);
      }
      { const float2 w_ = TW[2 * (tid & 255)]; __syncthreads(); passA(D, w_, tid, false); }
      { const float2 w_ = TW[32 * (tid & 15)]; __syncthreads(); passB(D, w_, tid, false); }
      __syncthreads();
      { float2 x[16];
#pragma unroll
        for (int i = 0; i < 16; ++i) x[i] = D[PI(tid * 16 + i)];
        r16_fwd<false>(x, make_float2(1.f, 0.f));
#pragma unroll
        for (int i = 0; i < 16; ++i) KF[PI(tid * 16 + i)] = x[i]; }
      __syncthreads();
#pragma unroll 1
      for (int pr = 0; pr < 4; ++pr) {
        const bf16_t* u1 = ZT + ((size_t)((2 * pr) * HY3 + d)) * TPB + CTXL;
        const bf16_t* u2 = ZT + ((size_t)((2 * pr + 1) * HY3 + d)) * TPB + CTXL;
        for (int t = tid; t < 4096; t += NTHR) {
          const float2 u = make_float2(bf2f(u1[t]), bf2f(u2[t]));
          D[PI(t)] = u; D[PI(4096 + t)] = cmul(u, TW[t]);
        }
        { const float2 w_ = TW[2 * (tid & 255)]; __syncthreads(); passA(D, w_, tid, false); }
        { const float2 w_ = TW[32 * (tid & 15)]; __syncthreads(); passB(D, w_, tid, false); }
        __syncthreads();
        { float2 x[16];
#pragma unroll
          for (int i = 0; i < 16; ++i) x[i] = D[PI(tid * 16 + i)];
          r16_fwd<false>(x, make_float2(1.f, 0.f));
#pragma unroll
          for (int i = 0; i < 16; ++i) x[i] = cmul(x[i], KF[PI(tid * 16 + i)]);
          r16_inv<false>(x, make_float2(1.f, 0.f));
#pragma unroll
          for (int i = 0; i < 16; ++i) D[PI(tid * 16 + i)] = x[i]; }
        { const float2 w_ = TW[32 * (tid & 15)]; __syncthreads(); passB(D, w_, tid, true); }
        { const float2 w_ = TW[2 * (tid & 255)]; __syncthreads(); passA(D, w_, tid, true); }
        __syncthreads();
        const bf16_t* x1 = ZT + ((size_t)((2 * pr) * HY3 + (1 + o) * DM + d)) * TPB + CTXL;
        const bf16_t* x2 = ZT + ((size_t)((2 * pr + 1) * HY3 + (1 + o) * DM + d)) * TPB + CTXL;
        bf16_t* o1 = ZT + ((size_t)((2 * pr) * HY3 + d)) * TPB + CTXL;
        bf16_t* o2 = ZT + ((size_t)((2 * pr + 1) * HY3 + d)) * TPB + CTXL;
        {
          float2 twv[8]; bf16_t ua_[8], ub_[8], xa_[8], xb_[8];
#pragma unroll
          for (int k = 0; k < 8; ++k) { const int t = tid + k * NTHR; twv[k] = TW[t]; ua_[k] = u1[t]; ub_[k] = u2[t]; xa_[k] = x1[t]; xb_[k] = x2[t]; }
          __builtin_amdgcn_sched_barrier(0);
#pragma unroll
          for (int k = 0; k < 8; ++k) { const int t = tid + k * NTHR;
            const float2 a = D[PI(t)], b = cmulc(D[PI(4096 + t)], twv[k]);
            const float yx = (a.x + b.x) * (1.f / 8192.f), yy = (a.y + b.y) * (1.f / 8192.f);
            if (!p.dry) { o1[t] = f2bf(bf2f(xa_[k]) * (yx + bf2f(ua_[k]) * skip)); o2[t] = f2bf(bf2f(xb_[k]) * (yy + bf2f(ub_[k]) * skip)); } }
        }
        __syncthreads();
      }
      {
        const float* hfc = HFC + ((size_t)((o * 2 + 0) * DM + d)) * 256;
        const float* hbc = HFC + ((size_t)((o * 2 + 1) * DM + d)) * 256;
        for (int q = tid; q < 5 * 256; q += NTHR) {
          const int blk = q >> 8, t = q & 255; const float2 w = TW[16 * t];
          if (blk < 4) {
            const float2 u = make_float2(bf2f(ZT[((size_t)((2 * blk) * HY3 + d)) * TPB + t]), bf2f(ZT[((size_t)((2 * blk + 1) * HY3 + d)) * TPB + t]));
            D[PI(blk * 512 + t)] = u; D[PI(blk * 512 + 256 + t)] = cmul(u, w);
          } else {
            const float lo = (t == 0) ? hfc[0] + hbc[0] : hfc[t], hi = (t == 0) ? 0.f : hbc[256 - t];
            D[PI(2048 + t)] = make_float2(lo + hi, 0.f); const float dd = lo - hi; D[PI(2304 + t)] = make_float2(dd * w.x, dd * w.y);
          }
        }
        { const float2 w_ = TW[32 * (tid & 15)]; __syncthreads(); if (tid < 160) passB(D, w_, tid, false); }
        __syncthreads();
        if (tid >= 128 && tid < 160) { float2 x[16];
#pragma unroll
          for (int i = 0; i < 16; ++i) x[i] = D[PI(tid * 16 + i)];
          r16_fwd<false>(x, make_float2(1.f, 0.f));
#pragma unroll
          for (int i = 0; i < 16; ++i) D[PI(tid * 16 + i)] = x[i]; }
        __syncthreads();
        if (tid < 128) { float2 x[16];
          const int kb = 2048 + ((tid >> 4) & 1) * 256 + (tid & 15) * 16;
#pragma unroll
          for (int i = 0; i < 16; ++i) x[i] = D[PI(tid * 16 + i)];
          r16_fwd<false>(x, make_float2(1.f, 0.f));
#pragma unroll
          for (int i = 0; i < 16; ++i) x[i] = cmul(x[i], D[PI(kb + i)]);
          r16_inv<false>(x, make_float2(1.f, 0.f));
#pragma unroll
          for (int i = 0; i < 16; ++i) D[PI(tid * 16 + i)] = x[i]; }
        { const float2 w_ = TW[32 * (tid & 15)]; __syncthreads(); if (tid < 128) passB(D, w_, tid, true); }
        __syncthreads();
        { float2 twv[2]; bf16_t ua_[2], ub_[2], xa_[2], xb_[2];
#pragma unroll
          for (int k = 0; k < 2; ++k) { const int q = tid + k * NTHR, blk = q >> 8, t = q & 255;
            const bf16_t* p1 = ZT + ((size_t)((2 * blk) * HY3 + d)) * TPB + t; const bf16_t* p2 = ZT + ((size_t)((2 * blk + 1) * HY3 + d)) * TPB + t;
            twv[k] = TW[16 * t]; ua_[k] = *p1; ub_[k] = *p2; xa_[k] = p1[(size_t)(1 + o) * DM * TPB]; xb_[k] = p2[(size_t)(1 + o) * DM * TPB]; }
#pragma unroll
          for (int k = 0; k < 2; ++k) { const int q = tid + k * NTHR, blk = q >> 8, t = q & 255;
            const float2 a = D[PI(blk * 512 + t)], b = cmulc(D[PI(blk * 512 + 256 + t)], twv[k]);
            const float yx = (a.x + b.x) * (1.f / 512.f), yy = (a.y + b.y) * (1.f / 512.f);
            bf16_t* p1 = ZT + ((size_t)((2 * blk) * HY3 + d)) * TPB + t; bf16_t* p2 = ZT + ((size_t)((2 * blk + 1) * HY3 + d)) * TPB + t;
            if (!p.dry) { *p1 = f2bf(bf2f(xa_[k]) * (yx + bf2f(ua_[k]) * skip)); *p2 = f2bf(bf2f(xb_[k]) * (yy + bf2f(ub_[k]) * skip)); } }
        }
        __syncthreads();
      }
    }
  }
}

DI void phase_transpose(const DevP& p, char* shmc, const int tid_, const int bid_) {
  const bf16_t* ZT = (const bf16_t*)(p.ws + OFF_BIG);
  bf16_t* H = (bf16_t*)(p.ws + OFF_H);
  bf16_t* T = (bf16_t*)shmc;
  const int tid = tid_;
  for (int it = bid_; it < NB * 68 * 16; it += gridDim.x) {
    const int b = it / (68 * 16), rem = it % (68 * 16), s0 = (rem >> 4) * 64, d0 = (rem & 15) * 64;
    { const int dr = tid >> 3, sc = (tid & 7) * 8;
      *(uint4*)(T + dr * 72 + sc) = *(const uint4*)(ZT + ((size_t)(b * HY3 + d0 + dr)) * TPB + s0 + sc); }
    __syncthreads();
    { const int sr = tid >> 3, dc = (tid & 7) * 8; unsigned w[4];
#pragma unroll
      for (int e = 0; e < 4; ++e) w[e] = (unsigned)T[(dc + 2 * e) * 72 + sr] | ((unsigned)T[(dc + 2 * e + 1) * 72 + sr] << 16);
      uint4 pk = {w[0], w[1], w[2], w[3]};
      *(uint4*)(H + ((size_t)(b * TPB + s0 + sr)) * DM + d0 + dc) = pk; }
    __syncthreads();
  }
}


#define XB_TMO      128
#define XB_XCNT(j)  (256  + 64 * (j))
#define XB_XSUB(j)  (1280 + 64 * (j))
#define XB_XGEN(j)  (2304 + 64 * (j))
#define XB_TOP      3328
#define XB_TOPGEN   3392
#define XCD_BAR_WORDS 3456
#define XB_SPIN_CAP (1u << 22)
#define LAS __attribute__((address_space(3)))
DI unsigned xb_ld(unsigned* q)              { return __hip_atomic_load(q, __ATOMIC_RELAXED, __HIP_MEMORY_SCOPE_AGENT); }
DI unsigned xb_add(unsigned* q, unsigned v) { return __hip_atomic_fetch_add(q, v, __ATOMIC_RELAXED, __HIP_MEMORY_SCOPE_AGENT); }
DI unsigned xb_xcc_id() { return (unsigned)__builtin_amdgcn_s_getreg((3 << 11) | 20) & 0xFu; }
#define XB_SPIN(cond, bar) do { unsigned _sp = 0; while (cond) { __builtin_amdgcn_s_sleep(1); \
    if ((++_sp & 255u) == 0u) { if (xb_ld(&(bar)[XB_TMO])) break; if (_sp > XB_SPIN_CAP) { atomicAdd(&(bar)[XB_TMO], 1u); break; } } } } while (0)
struct XcdBarrier { unsigned* bar; unsigned x; volatile LAS unsigned* st; };
DI void xcd_barrier_complete(unsigned* bar, unsigned x, unsigned& nloc, unsigned& nx) {
  const unsigned G = gridDim.x;
  unsigned sum, cnt, mine, sp = 0u;
  for (;;) {
    sum = 0u; cnt = 0u; mine = 0u;
#pragma unroll
    for (unsigned j = 0; j < 16; ++j) { const unsigned c = xb_ld(&bar[XB_XCNT(j)]); sum += c; cnt += (c > 0u) ? 1u : 0u; mine = (j == x) ? c : mine; }
    if (sum == G) break;
    __builtin_amdgcn_s_sleep(1);
    if ((++sp & 255u) == 0u) { if (xb_ld(&bar[XB_TMO])) break; if (sp > XB_SPIN_CAP) { atomicAdd(&bar[XB_TMO], 1u); break; } }
  }
  nloc = mine > 0u ? mine : 1u; nx = cnt > 0u ? cnt : 1u;
}
DI void xcd_barrier(const XcdBarrier& b, int tid) {
  asm volatile("s_waitcnt vmcnt(0)" ::: "memory");
  __syncthreads();
  if (tid == 0) {
    unsigned* bar = b.bar;
    __builtin_amdgcn_s_waitcnt(0);
    unsigned nloc = b.st[0], nx = b.st[1];
    if (nloc == 0u) { xcd_barrier_complete(bar, b.x, nloc, nx); b.st[0] = nloc; b.st[1] = nx; }
    const unsigned old = xb_add(&bar[XB_XSUB(b.x)], 1u);
    const unsigned gen = old / nloc;
    if (old + 1u == (gen + 1u) * nloc) {
      __builtin_amdgcn_fence(__ATOMIC_RELEASE, "agent");
      asm volatile("s_waitcnt vmcnt(0)" ::: "memory");
      const unsigned og = xb_add(&bar[XB_TOP], 1u);
      const unsigned tg = og / nx;
      if (og + 1u == (tg + 1u) * nx) xb_add(&bar[XB_TOPGEN], 1u);
      else XB_SPIN(xb_ld(&bar[XB_TOPGEN]) == tg, bar);
      __builtin_amdgcn_fence(__ATOMIC_ACQUIRE, "agent");
      xb_add(&bar[XB_XGEN(b.x)], 1u);
      asm volatile("s_waitcnt vmcnt(0)" ::: "memory");
    } else {
      XB_SPIN(xb_ld(&bar[XB_XGEN(b.x)]) == gen, bar);
      __builtin_amdgcn_fence(__ATOMIC_ACQUIRE, "agent");
      asm volatile("s_waitcnt vmcnt(0)" ::: "memory");
    }
  }
  __syncthreads();
}

constexpr int NPHASE = 1 + 4 * 9;
#define NREP(t) (((PROBE_MASK >> (t)) & 1) ? 2 : 1)
#define REP(t, nonidem, call) for (int r_ = 0; r_ < NREP(t); ++r_) { p.dry = (nonidem) && (r_ + 1 < NREP(t)); call; }

template <int EN>
__global__ void __launch_bounds__(NTHR) fwd_kernel(Params pk, int ph0, int ph1, int coop) {
  extern __shared__ __attribute__((aligned(16))) char shm[];
  __shared__ const float* in_tab[N_IN];
  if (threadIdx.x < N_IN) in_tab[threadIdx.x] = pk.in[threadIdx.x];
  __shared__ uint4 xb_words;
  if (threadIdx.x == 0) xb_words = make_uint4(0u, 0u, 0u, 0u);
  __syncthreads();
  XcdBarrier xb; xb.bar = (unsigned*)(pk.ws + OFF_BAR); xb.x = xb_xcc_id(); xb.st = (volatile LAS unsigned*)&xb_words;
  if (EN == 0xffff && coop && threadIdx.x == 0) (void)xb_add(&xb.bar[XB_XCNT(xb.x)], 1u);
  bf16_t* shb = (bf16_t*)shm;
  const int wave_s = __builtin_amdgcn_readfirstlane(threadIdx.x >> 6);
  const int phend = (EN == 0xffff) ? ph1 : ph0 + 1;
  for (int ph = ph0; ph < phend; ++ph) {
    int lane_; asm volatile("v_mbcnt_lo_u32_b32 %0, -1, 0\n\tv_mbcnt_hi_u32_b32 %0, -1, %0" : "=v"(lane_));
    int tid_ = wave_s * 64 + lane_, bid_ = blockIdx.x;
    asm volatile("" : "+s"(bid_));
    DevP p; p.in = in_tab; p.dry = false; p.xin = (ph == 1 || ph == 6);
    { unsigned long long w = (unsigned long long)pk.ws, o = (unsigned long long)pk.out;
      unsigned wl = (unsigned)w, wh = (unsigned)(w >> 32), ol = (unsigned)o, oh = (unsigned)(o >> 32);
      asm volatile("" : "+s"(wl), "+s"(wh), "+s"(ol), "+s"(oh));
      p.ws = (char*)(__attribute__((address_space(1))) char*)(((unsigned long long)wh << 32) | wl);
      p.out = (float*)(__attribute__((address_space(1))) float*)(((unsigned long long)oh << 32) | ol); }
    int conv_next = -1, conv_parts = 0;
    GemmCall g{}; int nM = 0, nN = 0; bool do_gemm = false, skip_sync = false;
    if (ph == 0) { if constexpr (EN & 1) REP(0, false, phase_setup(p, shm, tid_, bid_)) }
    else {
      const int layer = (ph - 1) / 9, sub = (ph - 1) % 9, even = (layer & 1) == 0, j = layer >> 1;
      const float* mod = (const float*)(p.ws + OFF_MOD) + (size_t)layer * 9 * 6144;
      const bf16_t* wt = (const bf16_t*)(p.ws + ((layer & 1) ? OFF_WT2 : OFF_WT));
      g.M = MROWS; g.ksk = 1 << 30; g.ksoff = 0;
      if (sub == 0) { if constexpr (EN & 2) REP(1, false, phase_start(p, layer, shm, tid_, bid_)) }
      else if (sub == 1) {
        g.A = (const bf16_t*)(p.ws + OFF_H); g.lda = DM; g.Bt = wt + WT_WIN; g.K = DM; do_gemm = true;
        if (even) { g.e0 = pin(p, I_EMUP) + j * A_IN; g.e1 = pin(p, I_EMUN) + j * A_IN; g.o0 = (bf16_t*)(p.ws + OFF_BIG); g.o1 = (bf16_t*)(p.ws + OFF_L);
          g.mode = M_EVEN; nM = (MROWS + 253) / 254; nN = 11; }
        else { g.bias = pin(p, I_OBIN) + j * HY3; g.e0 = pin(p, I_OCW) + (size_t)j * 3 * HY3; g.e1 = pin(p, I_OCB) + j * HY3; g.o0 = (bf16_t*)(p.ws + OFF_BIG);
          g.mode = M_ODD; nM = (MROWS + 247) / 248; nN = 12; }
      } else if (sub == 2) {
        if (even) {
          g.A = (const bf16_t*)(p.ws + OFF_L); g.lda = LW; g.Bt = wt + WT_LORA; g.K = LW;
          g.e0 = pin(p, I_EW0) + j * 1024; g.e1 = pin(p, I_EA0) + j * 1024; g.o0 = (bf16_t*)(p.ws + OFF_LO);
          g.mode = M_LORA; nM = MROWS / 256; nN = LOW / 256; do_gemm = true;
          if constexpr (EN & 32) phase_qkprep(p, j, tid_, bid_);
        } else { if constexpr (EN & 64) REP(6, true, phase_hyena(p, j, shm, tid_, bid_)) }
      } else if (sub == 3) {
        if (even) { if constexpr (EN & 128) REP(7, false, phase_scan(p, j, shm, tid_, bid_)) if constexpr (EN & 256) REP(8, true, phase_attn(p, j, shm, tid_, bid_))
          if (layer < 3) { __syncthreads();
            if ((int)gridDim.x == 256) { if (bid_ >= 32) convert_layer(p, layer + 1, (bf16_t*)(p.ws + (((layer + 1) & 1) ? OFF_WT2 : OFF_WT)), shm, tid_, bid_ - 32, 224, 4); }
            else convert_layer(p, layer + 1, (bf16_t*)(p.ws + (((layer + 1) & 1) ? OFF_WT2 : OFF_WT)), shm, tid_, bid_, (int)gridDim.x, 4); } }
        else { if constexpr (EN & 512) REP(9, false, phase_transpose(p, shm, tid_, bid_)) }
      } else if (sub == 4) {
        if (even) { if constexpr (EN & 1024) phase_rwkv_out(p, j, tid_, bid_); }
        else skip_sync = true;
      } else if (sub == 5) {
        g.Bt = wt + WT_WOUT; g.K = DM; g.mod = mod; g.msel = 2; g.mode = M_RES; nM = MROWS / 256; nN = DM / 256; do_gemm = true;
        if (layer < 3) { conv_next = layer + 1; conv_parts = 1; }
        if (even) { g.A = (const bf16_t*)(p.ws + OFF_BIG); g.lda = PW; g.ksk = 8; g.ksoff = A_IN - 512; g.bias = nullptr; }
        else { g.A = (const bf16_t*)(p.ws + OFF_H); g.lda = DM; g.bias = pin(p, I_OBOUT) + j * DM; }
      } else if (sub == 6) { if constexpr (EN & 4096) REP(12, false, norm_phase(p, layer, 1, tid_, bid_)) }
      else if (sub == 7) {
        g.A = (const bf16_t*)(p.ws + OFF_H); g.lda = DM; g.Bt = wt + WT_WUP; g.K = DM;
        g.e0 = pin(p, I_FCW) + (size_t)layer * 3 * FF2; g.e1 = pin(p, I_FCB) + (size_t)layer * FF2; g.o0 = (bf16_t*)(p.ws + OFF_BIG);
        g.mode = M_FFN; nM = (MROWS + 253) / 254; nN = FF / 128; do_gemm = true;
      } else {
        g.A = (const bf16_t*)(p.ws + OFF_BIG); g.lda = FF; g.Bt = wt + WT_WDN; g.K = FF; g.mod = mod; g.msel = 5; g.bias = nullptr;
        if (layer < 3) { conv_next = layer + 1; conv_parts = ((layer + 1) & 1) ? 2 : 4; }
        g.mode = M_RES; nM = MROWS / 256; nN = DM / 256; do_gemm = true;
      }
    }
    if (do_gemm) {
      if (g.mode == M_RES) { if constexpr (EN & 2048) REP(11, true, gemm_phase<M_RES>(p, shb, g, nM, nN, tid_, bid_)) }
      else if (g.mode == M_LORA) { if constexpr (EN & 16) REP(4, false, gemm_phase<M_LORA>(p, shb, g, nM, nN, tid_, bid_)) }
      else if (g.mode == M_FFN) { if constexpr (EN & 8192) REP(13, true, gemm_phase<M_FFN>(p, shb, g, nM, nN, tid_, bid_)) }
      else if (g.mode == M_EVEN) { if constexpr (EN & 4) REP(2, true, gemm_phase<M_EVEN>(p, shb, g, nM, nN, tid_, bid_)) }
      else { if constexpr (EN & 8) REP(3, true, gemm_phase<M_ODD>(p, shb, g, nM, nN, tid_, bid_)) }
    }
    if (conv_next >= 0 && (int)gridDim.x == 256 && (bid_ >> 3) >= 4)
      convert_layer(p, conv_next, (bf16_t*)(p.ws + ((conv_next & 1) ? OFF_WT2 : OFF_WT)), shm, tid_, (bid_ & 7) * 28 + (bid_ >> 3) - 4, 224, conv_parts);
    else if (conv_next >= 0 && (int)gridDim.x != 256)
      convert_layer(p, conv_next, (bf16_t*)(p.ws + ((conv_next & 1) ? OFF_WT2 : OFF_WT)), shm, tid_, bid_, (int)gridDim.x, conv_parts);
    if (EN == 0xffff && coop && ph + 1 < ph1 && !skip_sync) {
      if (ph1 < 0) { __threadfence(); cg::this_grid().sync(); }
      for (int r_ = 0; r_ < NREP(14); ++r_) xcd_barrier(xb, tid_);
    }
  }
}

#ifndef MK_MULTI
#define MK_MULTI 0
#endif

template <int EN>
static void launch_phase(const Params& p, int ph, hipStream_t stream) {
  static bool attr = false;
  if (!attr) { (void)hipFuncSetAttribute((const void*)fwd_kernel<EN>, hipFuncAttributeMaxDynamicSharedMemorySize, LDS_BYTES); attr = true; }
  fwd_kernel<EN><<<256, NTHR, LDS_BYTES, stream>>>(p, ph, ph + 1, 0);
}

extern "C" void kernel_launch(void* const* d_in, const int* in_sizes, int n_in, void* d_out, int out_size, void* d_ws, size_t ws_size, hipStream_t stream) {
  Params p{};
  for (int i = 0; i < N_IN; ++i) p.in[i] = (const float*)d_in[i];
  p.out = (float*)d_out; p.ws = (char*)d_ws;
  if (ws_size < WS_END2) { fprintf(stderr, "workspace too small: %zu < %zu\n", ws_size, (size_t)WS_END); return; }
#if MK_MULTI
  launch_phase<1>(p, 0, stream);
  for (int layer = 0; layer < 4; ++layer) {
    const int b = 1 + layer * 9; const bool even = (layer & 1) == 0;
    launch_phase<2>(p, b + 0, stream);
    if (even) {
      launch_phase<4>(p, b + 1, stream); launch_phase<16>(p, b + 2, stream); launch_phase<32>(p, b + 2, stream); launch_phase<128 | 256>(p, b + 3, stream); launch_phase<1024>(p, b + 4, stream);
    } else {
      launch_phase<8>(p, b + 1, stream); launch_phase<64>(p, b + 2, stream); launch_phase<512>(p, b + 3, stream);
    }
    launch_phase<2048>(p, b + 5, stream); launch_phase<4096>(p, b + 6, stream); launch_phase<8192>(p, b + 7, stream); launch_phase<2048>(p, b + 8, stream);
  }
#else
  static bool attr = false;
  if (!attr) { (void)hipFuncSetAttribute((const void*)fwd_kernel<0xffff>, hipFuncAttributeMaxDynamicSharedMemorySize, LDS_BYTES); attr = true; }
  (void)hipMemsetAsync((char*)d_ws + OFF_BAR, 0, XCD_BAR_WORDS * 4, stream);
  int ph0 = 0, ph1 = NPHASE, coop = 1;
  void* args[] = {&p, &ph0, &ph1, &coop};
  hipError_t e = hipLaunchCooperativeKernel((const void*)fwd_kernel<0xffff>, dim3(256), dim3(NTHR), args, LDS_BYTES, stream);
  if (e != hipSuccess) fprintf(stderr, "cooperative launch failed: %s\n", hipGetErrorString(e));
#endif
}
```

```cpp
#include <hip/hip_runtime.h>
#include <hip/hip_cooperative_groups.h>
#include <cstdio>
namespace cg = cooperative_groups;

typedef unsigned short bf16_t;
typedef short bf16x8 __attribute__((ext_vector_type(8)));
typedef float f32x4 __attribute__((ext_vector_type(4)));
typedef __bf16 bf16v2 __attribute__((ext_vector_type(2)));
#define DI __device__ __forceinline__
#ifndef PROBE_MASK
#define PROBE_MASK 0
#endif

constexpr int DM = 1024, NB = 8, SEQ = 4096, CTXL = 256, TPB = SEQ + CTXL, MROWS = NB * TPB;
constexpr int A_IN = 1920, EVEN_IN = 2688, PW = 2688, LW = 384, LOW = 2560, FF = 2816, FF2 = 5632, HY3 = 3072;
constexpr int NTHR = 512;
constexpr int TP = 264;
constexpr int LDS_BYTES = 256 * TP * 2;

enum { I_X = 0, I_C, I_CTX, I_CCTX, I_ADAW, I_ADAB, I_N1G, I_N2G, I_FUP, I_FCW, I_FCB, I_FDN,
       I_EWIN, I_EMUP, I_EMUN, I_EW0, I_EW2, I_EA0, I_EA2, I_EG2, I_EKK, I_EKA, I_ERK, I_ELNW, I_ELNB, I_EQN, I_EKN, I_ESINK, I_EWOUT,
       I_OWIN, I_OBIN, I_OCW, I_OCB, I_OFW1, I_OFB1, I_OFW2, I_OFB2, I_OFW3, I_OFB3, I_OFREQ, I_OFOUT, I_OSKIP, I_OWOUT, I_OBOUT, N_IN };

struct Params { const float* in[N_IN]; float* out; char* ws; };
struct DevP { const float* const* in; float* out; char* ws; bool dry; bool xin; };

constexpr size_t OFF_XC = 0;
constexpr size_t OFF_MOD = OFF_XC + (size_t)NB * CTXL * DM * 4;
constexpr size_t OFF_HDNL = OFF_MOD + (size_t)4 * 9 * 6144 * 4;
constexpr size_t OFF_HDNC = OFF_HDNL + (size_t)2 * 4096 * 64 * 4;
constexpr size_t OFF_TW = OFF_HDNC + (size_t)2 * 256 * 64 * 4;
constexpr size_t OFF_ROPE = OFF_TW + (size_t)4096 * 8;
constexpr size_t OFF_KN = OFF_ROPE + (size_t)4096 * 32 * 8;
constexpr size_t OFF_WT = OFF_KN + (size_t)MROWS * 8 * 4;
constexpr size_t WT_WIN = 0, WT_LORA = 3145728, WT_WOUT = WT_LORA + 983040, WT_WUP = WT_WOUT + 1048576, WT_WDN = WT_WUP + 5767168, WT_END = WT_WDN + 2883584;
constexpr size_t OFF_H = OFF_WT + WT_END * 2;
constexpr size_t OFF_BIG = OFF_H + (size_t)MROWS * DM * 2;
constexpr size_t OFF_LO = OFF_BIG + (size_t)NB * HY3 * TPB * 2;
constexpr size_t WS_END = OFF_LO + (size_t)MROWS * LOW * 2;
constexpr size_t OFF_BAR = WS_END;
constexpr size_t OFF_WT2 = OFF_BAR + 16384;
constexpr size_t WS_END2 = OFF_WT2 + WT_END * 2;
constexpr size_t OFF_L = OFF_BIG + (size_t)MROWS * PW * 2;

DI f32x4 ld_nt16(const float* q) { return __builtin_nontemporal_load((const f32x4*)q); }
DI float bf2f(bf16_t h) { return __uint_as_float(((unsigned)h) << 16); }
DI unsigned pack2(float a, float b) { bf16v2 v = {(__bf16)a, (__bf16)b}; return __builtin_bit_cast(unsigned, v); }
DI bf16_t f2bf(float a) { __bf16 v = (__bf16)a; return __builtin_bit_cast(bf16_t, v); }
DI float lo16(unsigned u) { return __uint_as_float(u << 16); }
DI float hi16(unsigned u) { return __uint_as_float(u & 0xffff0000u); }
DI float sigmoidf_(float x) { return 1.f / (1.f + __expf(-x)); }
DI float siluf_(float x) { return x / (1.f + __expf(-x)); }
DI float dpp_sum16(float x) {
  x += __builtin_bit_cast(float, __builtin_amdgcn_update_dpp(0, __builtin_bit_cast(int, x), 0x128, 0xf, 0xf, false));
  x += __builtin_bit_cast(float, __builtin_amdgcn_update_dpp(0, __builtin_bit_cast(int, x), 0x124, 0xf, 0xf, false));
  x += __builtin_bit_cast(float, __builtin_amdgcn_update_dpp(0, __builtin_bit_cast(int, x), 0x122, 0xf, 0xf, false));
  x += __builtin_bit_cast(float, __builtin_amdgcn_update_dpp(0, __builtin_bit_cast(int, x), 0x121, 0xf, 0xf, false));
  return x;
}
DI float bperm_xor(float v, int lane, int mask) {
  return __builtin_bit_cast(float, __builtin_amdgcn_ds_bpermute((lane ^ mask) << 2, __builtin_bit_cast(int, v)));
}
DI float sum16(float v) { return dpp_sum16(v); }
DI float wave_sum(float v, int lane) { v = dpp_sum16(v); v += bperm_xor(v, lane, 16); v += bperm_xor(v, lane, 32); return v; }
DI float* xrow(const DevP& p, int row, int& mi) {
  int b = row / TPB, s = row - b * TPB;
  if (s < CTXL) { mi = 8; return (float*)(p.ws + OFF_XC) + ((size_t)(b * CTXL + s)) * DM; }
  mi = b; return p.out + ((size_t)(b * SEQ + s - CTXL)) * DM;
}
DI bool prev_valid(int row) { int s = row % TPB; return s != 0 && s != CTXL; }
DI bool next_valid(int row) { int s = row % TPB; return s != CTXL - 1 && s != TPB - 1; }

constexpr int HT = 128 * 64;
DI const char* uni_ptr(const char* q) {
  unsigned lo = __builtin_amdgcn_readfirstlane((unsigned)(unsigned long long)q), hi = __builtin_amdgcn_readfirstlane((unsigned)((unsigned long long)q >> 32));
  return (const char*)(const __attribute__((address_space(1))) char*)(((unsigned long long)hi << 32) | lo);
}
DI const float* pin(const DevP& p, int i) { return (const float*)uni_ptr((const char*)p.in[i]); }
DI const float* xrow_src(const DevP& p, int row, int& mi) {
  if (!p.xin) return xrow(p, row, mi);
  const int b = row / TPB, s = row - b * TPB;
  if (s < CTXL) { mi = 8; return pin(p, I_CTX) + ((size_t)(b * CTXL + s)) * DM; }
  mi = b; return pin(p, I_X) + ((size_t)(b * SEQ + s - CTXL)) * DM;
}
DI int lds_byte(int r, int c) { int st = (r >> 4) * 2 + (c >> 5), rr = r & 15, cc = c & 31, ob = rr * 64 + cc * 2; return st * 1024 + (ob ^ (((ob >> 9) & 1) << 5)); }
DI void stage_rc(int b, int& R, int& C) { int st = b / 1024, sb = b % 1024, swz = sb ^ (((sb >> 9) & 1) << 5); R = (st >> 1) * 16 + swz / 64; C = (st & 1) * 32 + (swz % 64) / 2; }

#define WAIT_V(n) asm volatile("s_waitcnt vmcnt(" #n ")" ::: "memory")
#define WAIT_L(n) asm volatile("s_waitcnt lgkmcnt(" #n ")" ::: "memory")
#define BAR __builtin_amdgcn_s_barrier()
#define SCHED __builtin_amdgcn_sched_barrier(0)

enum { M_RES = 0, M_LORA = 1, M_FFN = 2, M_EVEN = 3, M_ODD = 4 };

struct GemmCall {
  const bf16_t* A; int lda; int M; int ksk; int ksoff;
  const bf16_t* Bt; int K;
  const float* bias; const float* mod; int msel;
  const float* e0; const float* e1; const float* e2; const float* e3;
  bf16_t* o0; bf16_t* o1;
  int mode;
  int skipctx;
};

template <int MODE>
DI void gemm_tile(const DevP& p, bf16_t* shm, const GemmCall& g, int pm, int pn, const int tid_, const int bid_) {
  constexpr bool CONV = (MODE >= M_FFN);
  constexpr int S = (MODE == M_ODD) ? 248 : 254, HALO = (MODE == M_ODD) ? 4 : 1;
  const int tid = tid_;
  const int K = g.K;
  int arow0, brow0, brow1;
  if (CONV) arow0 = pm * S - HALO; else arow0 = pm * 256;
  if (MODE == M_FFN) { brow0 = pn * 128; brow1 = FF + pn * 128; } else { brow0 = pn * 256; brow1 = pn * 256 + 128; }
  unsigned aoffv, boffv;
  { int r, c; stage_rc(tid * 16, r, c); aoffv = (unsigned)(r * g.lda + c) * 2u; boffv = (unsigned)(r * K + c) * 2u; }
  const long abase0 = (long)arow0 * g.lda, bbase0 = (long)brow0 * K, bbase1 = (long)brow1 * K;
  const bf16_t* gA = g.A; const bf16_t* gB = g.Bt; const int ksk = g.ksk, ksoff = g.ksoff;
  const int wvu = __builtin_amdgcn_readfirstlane(tid >> 6);
#define SA(b, h) (shm + ((b) * 2 + (h)) * HT)
#define SB(b, h) (shm + (4 + (b) * 2 + (h)) * HT)
#define STAGE_A(P, h, kt) do { const int _k = (kt); \
    const char* _b0 = uni_ptr((const char*)(gA + abase0 + (long)(h) * 128 * g.lda + _k * 64 + (_k >= ksk ? ksoff : 0))); \
    const char* _b1 = uni_ptr(_b0 + (long)128 * g.lda); \
    unsigned _o0 = aoffv; asm volatile("" : "+v"(_o0)); \
    __builtin_amdgcn_global_load_lds((const unsigned*)(_b0 + (size_t)_o0), (unsigned*)((char*)(P) + wvu * 1024), 16, 0, 0); \
    __builtin_amdgcn_global_load_lds((const unsigned*)(_b1 + (size_t)_o0), (unsigned*)((char*)(P) + wvu * 1024 + 8192), 16, 0, 0); } while (0)
#define STAGE_B(P, h, kt) do { \
    const char* _b0 = uni_ptr((const char*)(gB + ((h) ? bbase1 : bbase0) + (kt) * 64)); \
    const char* _b1 = uni_ptr(_b0 + (long)128 * K); \
    unsigned _o0 = boffv; asm volatile("" : "+v"(_o0)); \
    __builtin_amdgcn_global_load_lds((const unsigned*)(_b0 + (size_t)_o0), (unsigned*)((char*)(P) + wvu * 1024), 16, 0, 0); \
    __builtin_amdgcn_global_load_lds((const unsigned*)(_b1 + (size_t)_o0), (unsigned*)((char*)(P) + wvu * 1024 + 8192), 16, 0, 0); } while (0)
#define LDA(dst, b, h) for (int m = 0; m < 4; ++m) for (int k = 0; k < 2; ++k) \
    dst[m][k] = *reinterpret_cast<const bf16x8*>((char*)SA(b, h) + lds_byte(wr * 64 + m * 16 + fr, k * 32 + fq * 8))
#define LDB(dst, b, h) for (int n = 0; n < 2; ++n) for (int k = 0; k < 2; ++k) \
    dst[n][k] = *reinterpret_cast<const bf16x8*>((char*)SB(b, h) + lds_byte(wc * 32 + n * 16 + fr, k * 32 + fq * 8))
#define MMA(ai, bj, At, Bx) do { __builtin_amdgcn_s_setprio(1); \
    for (int m = 0; m < 4; ++m) for (int n = 0; n < 2; ++n) for (int k = 0; k < 2; ++k) \
      acc[ai][bj][m][n] = __builtin_amdgcn_mfma_f32_16x16x32_bf16(Bx[n][k], At[m][k], acc[ai][bj][m][n], 0, 0, 0); \
    __builtin_amdgcn_s_setprio(0); } while (0)

  const int wid = tid >> 6, lane = tid & 63, wr = wid >> 2, wc = wid & 3, fr = lane & 15, fq = lane >> 4;
  f32x4 acc[2][2][4][2] = {};
  bf16x8 At[4][2], B0[2][2], B1[2][2];
  const int nt = K / 64;
  STAGE_B(SB(0, 0), 0, 0); STAGE_A(SA(0, 0), 0, 0);
  STAGE_B(SB(0, 1), 1, 0); STAGE_A(SA(0, 1), 1, 0);
  if (wr == 1) BAR;
  WAIT_V(4); BAR;
  STAGE_B(SB(1, 0), 0, 1); STAGE_A(SA(1, 0), 0, 1); STAGE_B(SB(1, 1), 1, 1);
  WAIT_V(6); BAR;
  for (int t = 0; t < nt; t += 2) {
    const int t1 = t + 1, t2 = (t + 2 < nt) ? t + 2 : nt - 1, t3 = (t + 3 < nt) ? t + 3 : nt - 1;
    LDB(B0, 0, 0); SCHED; LDA(At, 0, 0); STAGE_A(SA(1, 1), 1, t1);
    WAIT_L(8); BAR; WAIT_L(0); MMA(0, 0, At, B0); BAR; SCHED;
    LDB(B1, 0, 1); STAGE_B(SB(0, 0), 0, t2);
    BAR; WAIT_L(0); MMA(0, 1, At, B1); BAR;
    LDA(At, 0, 1); STAGE_A(SA(0, 0), 0, t2);
    BAR; WAIT_L(0); MMA(1, 0, At, B0); BAR; SCHED;
    STAGE_B(SB(0, 1), 1, t2);
    WAIT_V(6); BAR; MMA(1, 1, At, B1); BAR;
    LDB(B0, 1, 0); SCHED; LDA(At, 1, 0); STAGE_A(SA(0, 1), 1, t2);
    WAIT_L(8); BAR; WAIT_L(0); MMA(0, 0, At, B0); BAR; SCHED;
    LDB(B1, 1, 1); STAGE_B(SB(1, 0), 0, t3);
    BAR; WAIT_L(0); MMA(0, 1, At, B1); BAR;
    LDA(At, 1, 1); STAGE_A(SA(1, 0), 0, t3);
    BAR; WAIT_L(0); MMA(1, 0, At, B0); BAR; SCHED;
    STAGE_B(SB(1, 1), 1, t3);
    WAIT_V(6); BAR; MMA(1, 1, At, B1); BAR;
  }
  WAIT_V(0);
  if (wr == 0) BAR;
#undef SA
#undef SB
#undef STAGE_A
#undef STAGE_B
#undef LDA
#undef LDB
#undef MMA
  if (PROBE_MASK != 0 && p.dry && MODE != M_RES) { __syncthreads(); return; }
  int te = tid; asm volatile("" : "+v"(te));
  const int ewr = te >> 8, ewc = (te >> 6) & 3, efr = te & 15, efq = (te & 63) >> 4;
  if (MODE == M_RES) {
    int mi; (void)xrow(p, pm * 256, mi);
    const float* gate = g.mod + mi * 6144 + g.msel * 1024;
    f32x4 gv[4], bb[4];
#pragma unroll
    for (int k = 0; k < 4; ++k) {
      const int col = pn * 256 + (k >> 1) * 128 + ewc * 32 + (k & 1) * 16 + efq * 4;
      gv[k] = *(const f32x4*)(gate + col);
      bb[k] = g.bias ? *(const f32x4*)(g.bias + col) : (f32x4){0.f, 0.f, 0.f, 0.f};
    }
#pragma unroll
    for (int ai = 0; ai < 2; ++ai)
#pragma unroll
      for (int mh = 0; mh < 4; mh += 2) {
        f32x4 xv[2][4]; float* xps[2];
#pragma unroll
        for (int m = 0; m < 2; ++m) {
          int mi2; const int rw = pm * 256 + ai * 128 + ewr * 64 + (mh + m) * 16 + efr;
          xps[m] = xrow(p, rw, mi2);
          const float* xs = p.xin ? xrow_src(p, rw, mi2) : xps[m];
#pragma unroll
          for (int k = 0; k < 4; ++k) xv[m][k] = *(const f32x4*)(xs + pn * 256 + (k >> 1) * 128 + ewc * 32 + (k & 1) * 16 + efq * 4);
        }
#pragma unroll
        for (int m = 0; m < 2; ++m)
#pragma unroll
          for (int k = 0; k < 4; ++k) {
            const f32x4 x = xv[m][k] + gv[k] * (acc[ai][k >> 1][mh + m][k & 1] + bb[k]);
            if (!p.dry) *(f32x4*)(xps[m] + pn * 256 + (k >> 1) * 128 + ewc * 32 + (k & 1) * 16 + efq * 4) = x;
          }
      }
    __syncthreads();
  } else if (MODE == M_LORA) {
    f32x4 cvs[4];
#pragma unroll
    for (int k = 0; k < 4; ++k) { const int col = pn * 256 + (k >> 1) * 128 + ewc * 32 + (k & 1) * 16 + efq * 4;
      cvs[k] = (f32x4){0.f, 0.f, 0.f, 0.f};
      if (col < 1024) cvs[k] = *(const f32x4*)(g.e0 + col); else if (col < 2048) cvs[k] = *(const f32x4*)(g.e1 + col - 1024); }
#pragma unroll
    for (int bj = 0; bj < 2; ++bj)
#pragma unroll
      for (int n = 0; n < 2; ++n) {
        const int col = pn * 256 + bj * 128 + ewc * 32 + n * 16 + efq * 4;
        const f32x4 cv = cvs[bj * 2 + n];
#pragma unroll
        for (int ai = 0; ai < 2; ++ai)
#pragma unroll
          for (int m = 0; m < 4; ++m) {
            const int row = pm * 256 + ai * 128 + ewr * 64 + m * 16 + efr;
            f32x4 a = acc[ai][bj][m][n];
            float o[4];
#pragma unroll
            for (int j = 0; j < 4; ++j) {
              float v = a[j] + cv[j];
              if (col < 1024) o[j] = 0.6065306597126334f * __builtin_amdgcn_rcpf(1.f + __expf(-v));
              else if (col < 2048) o[j] = __builtin_amdgcn_rcpf(1.f + __expf(-v));
              else o[j] = v;
            }
            uint2 pk = {pack2(o[0], o[1]), pack2(o[2], o[3])};
            *(uint2*)(g.o0 + (size_t)row * LOW + col) = pk;
          }
      }
    __syncthreads();
  } else {
    __syncthreads();
    bf16_t* T = shm;
#pragma unroll
    for (int bj = 0; bj < 2; ++bj)
#pragma unroll
      for (int n = 0; n < 2; ++n) {
        const int col = bj * 128 + ewc * 32 + n * 16 + efq * 4;
        f32x4 bv = {0.f, 0.f, 0.f, 0.f};
        if (MODE == M_ODD) bv = *(const f32x4*)(g.bias + pn * 256 + col);
#pragma unroll
        for (int ai = 0; ai < 2; ++ai)
#pragma unroll
          for (int m = 0; m < 4; ++m) {
            const int row = ai * 128 + ewr * 64 + m * 16 + efr;
            f32x4 a = acc[ai][bj][m][n] + bv;
            uint2 pk = {pack2(a[0], a[1]), pack2(a[2], a[3])};
            *(uint2*)(T + row * TP + col) = pk;
          }
      }
    float wg[3][8], bg[8], wv[3][8], bvv[8];
    if (MODE == M_FFN) {
      const int gc_ = pn * 128 + (te & 15) * 8;
#pragma unroll
      for (int e = 0; e < 8; ++e) {
#pragma unroll
        for (int q = 0; q < 3; ++q) { wg[q][e] = g.e0[q * FF2 + gc_ + e]; wv[q][e] = g.e0[q * FF2 + FF + gc_ + e]; }
        bg[e] = g.e1[gc_ + e]; bvv[e] = g.e1[FF + gc_ + e];
      }
    }
    __syncthreads();
    if (MODE == M_FFN) {
      const int cg8 = (te & 15) * 8, rsub = te >> 4;
      const int gc = pn * 128 + cg8;
      for (int i = HALO + rsub; i < HALO + S; i += 32) {
        const int grow = pm * S + (i - HALO);
        if (grow >= g.M) break;
        uint4 gp = *(const uint4*)(T + (i - 1) * TP + cg8), gcn = *(const uint4*)(T + i * TP + cg8), gn = *(const uint4*)(T + (i + 1) * TP + cg8);
        uint4 vp = *(const uint4*)(T + (i - 1) * TP + 128 + cg8), vc = *(const uint4*)(T + i * TP + 128 + cg8), vn = *(const uint4*)(T + (i + 1) * TP + 128 + cg8);
        const uint4 zz = {0u, 0u, 0u, 0u};
        const int sq = grow - (grow / TPB) * TPB;
        if (sq == 0 || sq == CTXL) { gp = zz; vp = zz; }
        if (sq == CTXL - 1 || sq == TPB - 1) { gn = zz; vn = zz; }
        const unsigned* gpa = (const unsigned*)&gp; const unsigned* gca = (const unsigned*)&gcn; const unsigned* gna = (const unsigned*)&gn;
        const unsigned* vpa = (const unsigned*)&vp; const unsigned* vca = (const unsigned*)&vc; const unsigned* vna = (const unsigned*)&vn;
        float o[8];
#pragma unroll
        for (int e = 0; e < 8; ++e) {
          const int w = e >> 1;
          const float a0 = (e & 1) ? hi16(gpa[w]) : lo16(gpa[w]), a1 = (e & 1) ? hi16(gca[w]) : lo16(gca[w]), a2 = (e & 1) ? hi16(gna[w]) : lo16(gna[w]);
          const float b0 = (e & 1) ? hi16(vpa[w]) : lo16(vpa[w]), b1 = (e & 1) ? hi16(vca[w]) : lo16(vca[w]), b2 = (e & 1) ? hi16(vna[w]) : lo16(vna[w]);
          const float gg = wg[0][e] * a0 + (wg[1][e] * a1 + (wg[2][e] * a2 + bg[e]));
          const float vv = wv[0][e] * b0 + (wv[1][e] * b1 + (wv[2][e] * b2 + bvv[e]));
          o[e] = gg * __builtin_amdgcn_rcpf(1.f + __expf(-gg)) * vv;
        }
        uint4 pk = {pack2(o[0], o[1]), pack2(o[2], o[3]), pack2(o[4], o[5]), pack2(o[6], o[7])};
        *(uint4*)(g.o0 + (size_t)grow * FF + gc) = pk;
      }
    } else if (MODE == M_EVEN) {
      const int cg8 = (te & 31) * 8, rsub = te >> 5;
      const int col = pn * 256 + cg8;
      if (col < EVEN_IN) {
        float mp[8], mn[8];
#pragma unroll
        for (int e = 0; e < 8; ++e) { mp[e] = col < A_IN ? g.e0[col + e] : 0.f; mn[e] = col < A_IN ? g.e1[col + e] : 0.f; }
        for (int i = HALO + rsub; i < HALO + S; i += 16) {
          const int grow = pm * S + (i - HALO);
          if (grow >= g.M) break;
          const int sq = grow - (grow / TPB) * TPB;
          const float pv = (sq == 0 || sq == CTXL) ? 0.f : 1.f, nv = (sq == CTXL - 1 || sq == TPB - 1) ? 0.f : 1.f;
          uint4 tp = *(const uint4*)(T + (i - 1) * TP + cg8), tc = *(const uint4*)(T + i * TP + cg8), tn = *(const uint4*)(T + (i + 1) * TP + cg8);
          const unsigned* tpa = (const unsigned*)&tp; const unsigned* tca = (const unsigned*)&tc; const unsigned* tna = (const unsigned*)&tn;
          float o[8];
#pragma unroll
          for (int e = 0; e < 8; ++e) {
            const int w = e >> 1;
            float a0 = ((e & 1) ? hi16(tpa[w]) : lo16(tpa[w])) * pv, a1 = (e & 1) ? hi16(tca[w]) : lo16(tca[w]), a2 = ((e & 1) ? hi16(tna[w]) : lo16(tna[w])) * nv;
            float z = a1 + mp[e] * (a0 - a1) + mn[e] * (a2 - a1);
            if (col >= 1536 && col < 1664) z = 1.f - 2.f / (1.f + __expf(2.f * z));
            else if (col >= 1792 && col < 1920) z = sigmoidf_(z);
            o[e] = z;
          }
          uint4 pk = {pack2(o[0], o[1]), pack2(o[2], o[3]), pack2(o[4], o[5]), pack2(o[6], o[7])};
          if (col >= 1536 && col < 1920) *(uint4*)(g.o1 + (size_t)grow * LW + (col - 1536)) = pk;
          else *(uint4*)(g.o0 + (size_t)grow * PW + col) = pk;
        }
      }
    } else {
      const int rgs = te & 3, csub = te >> 2;
#pragma unroll 1
      for (int cp = 0; cp < 2; ++cp) {
        const int cl = cp * 128 + csub, col = pn * 256 + cl;
        const float w0 = g.e0[col], w1 = g.e0[HY3 + col], w2 = g.e0[2 * HY3 + col], cb = g.e1[col];
#pragma unroll 1
        for (int rg = rgs; rg < 31; rg += 4) {
          const int grow0 = pm * S + rg * 8;
          if (grow0 >= g.M) break;
          const int i0 = HALO + rg * 8;
          float tv[10];
#pragma unroll
          for (int q = 0; q < 10; ++q) tv[q] = bf2f(T[(i0 - 1 + q) * TP + cl]);
          const int b = grow0 / TPB, s0 = grow0 - b * TPB;
          if (s0 == 0 || s0 == CTXL) tv[0] = 0.f;
          if (s0 + 8 == CTXL || s0 + 8 == TPB) tv[9] = 0.f;
          float o[8];
#pragma unroll
          for (int q = 0; q < 8; ++q) o[q] = w0 * tv[q] + (w1 * tv[q + 1] + (w2 * tv[q + 2] + cb));
          uint4 pk = {pack2(o[0], o[1]), pack2(o[2], o[3]), pack2(o[4], o[5]), pack2(o[6], o[7])};
          *(uint4*)(g.o0 + ((size_t)(b * HY3 + col)) * TPB + s0) = pk;
        }
      }
    }
    __syncthreads();
  }
}

template <int MODE>
DI void gemm_phase(const DevP& p, bf16_t* shm, const GemmCall& g, int nM, int nN, const int tid_, const int bid_) {
  if (g.skipctx) nM = 128;
  const int total = nM * nN, share = (total + 7) >> 3, xcd = bid_ & 7, lb = bid_ >> 3, nlb = (int)gridDim.x >> 3;
  const int lend = min((xcd + 1) * share, total), nig = 8 * nN;
  for (int L = xcd * share + lb; L < lend; L += nlb) {
    const int gid = L / nig, fm = gid * 8, gsz = min(nM - fm, 8), wi = L - gid * nig;
    const int pmr = fm + wi % gsz;
    gemm_tile<MODE>(p, shm, g, g.skipctx ? (pmr >> 4) * 17 + 1 + (pmr & 15) : pmr, wi / gsz, tid_, bid_);
  }
}

DI void wconv(const float* src, int K, int N, bf16_t* dst, float* sh, const int tid_, const int bid_, const int nwk_) {
  const int tid = tid_, tk = K / 64, tn = N / 64, ntile = tk * tn;
  const int kk0 = tid >> 4, nn4 = (tid & 15) * 4;
  int it = bid_;
  f32x4 v0 = {0.f, 0.f, 0.f, 0.f}, v1 = v0;
  if (it < ntile) { const int k0 = (it / tn) * 64, n0 = (it % tn) * 64;
    v0 = ld_nt16(src + (size_t)(k0 + kk0) * N + n0 + nn4); v1 = ld_nt16(src + (size_t)(k0 + kk0 + 32) * N + n0 + nn4); }
  while (it < ntile) {
    const int k0 = (it / tn) * 64, n0 = (it % tn) * 64;
    sh[kk0 * 65 + nn4] = v0[0]; sh[kk0 * 65 + nn4 + 1] = v0[1]; sh[kk0 * 65 + nn4 + 2] = v0[2]; sh[kk0 * 65 + nn4 + 3] = v0[3];
    sh[(kk0 + 32) * 65 + nn4] = v1[0]; sh[(kk0 + 32) * 65 + nn4 + 1] = v1[1]; sh[(kk0 + 32) * 65 + nn4 + 2] = v1[2]; sh[(kk0 + 32) * 65 + nn4 + 3] = v1[3];
    __syncthreads();
    const int itn = it + nwk_;
    if (itn < ntile) { const int k1 = (itn / tn) * 64, n1 = (itn % tn) * 64;
      v0 = ld_nt16(src + (size_t)(k1 + kk0) * N + n1 + nn4); v1 = ld_nt16(src + (size_t)(k1 + kk0 + 32) * N + n1 + nn4); }
    { const int nn = tid >> 3, kp = (tid & 7) * 8;
      uint4 pk = {pack2(sh[kp * 65 + nn], sh[(kp + 1) * 65 + nn]), pack2(sh[(kp + 2) * 65 + nn], sh[(kp + 3) * 65 + nn]),
                  pack2(sh[(kp + 4) * 65 + nn], sh[(kp + 5) * 65 + nn]), pack2(sh[(kp + 6) * 65 + nn], sh[(kp + 7) * 65 + nn])};
      *(uint4*)(dst + (size_t)(n0 + nn) * K + k0 + kp) = pk; }
    __syncthreads();
    it = itn;
  }
}

DI void norm_phase(const DevP& p, int layer, int which, const int tid_, const int bid_) {
  const float* gw = pin(p, which ? I_N2G : I_N1G) + layer * DM;
  const float* mod = (const float*)(p.ws + OFF_MOD) + (size_t)layer * 9 * 6144;
  bf16_t* H = (bf16_t*)(p.ws + OFF_H);
  const int lane = tid_ & 63, gw_id = bid_ * 8 + (tid_ >> 6), nw = gridDim.x * 8;
  for (int row0 = gw_id; row0 < MROWS; row0 += 2 * nw) {
    const int row1 = row0 + nw; const bool has1 = row1 < MROWS;
    int mi0, mi1; const float* xp0 = xrow_src(p, row0, mi0); const float* xp1 = xrow_src(p, has1 ? row1 : row0, mi1);
    f32x4 v0[4], v1[4]; float ss0 = 0.f, ss1 = 0.f;
#pragma unroll
    for (int q = 0; q < 4; ++q) { v0[q] = *(const f32x4*)(xp0 + q * 256 + lane * 4); v1[q] = *(const f32x4*)(xp1 + q * 256 + lane * 4); }
#pragma unroll
    for (int q = 0; q < 4; ++q) { ss0 += v0[q][0] * v0[q][0] + v0[q][1] * v0[q][1] + v0[q][2] * v0[q][2] + v0[q][3] * v0[q][3];
                                  ss1 += v1[q][0] * v1[q][0] + v1[q][1] * v1[q][1] + v1[q][2] * v1[q][2] + v1[q][3] * v1[q][3]; }
    ss0 = wave_sum(ss0, lane); ss1 = wave_sum(ss1, lane);
    const float rstd0 = rsqrtf(ss0 * (1.f / DM) + 1e-6f), rstd1 = rsqrtf(ss1 * (1.f / DM) + 1e-6f);
    const float* sh0 = mod + mi0 * 6144 + (which ? 3 : 0) * 1024; const float* sh1 = mod + mi1 * 6144 + (which ? 3 : 0) * 1024;
#pragma unroll
    for (int q = 0; q < 4; ++q) {
      const int c = q * 256 + lane * 4;
      const f32x4 gg = *(const f32x4*)(gw + c);
      { const f32x4 s1 = *(const f32x4*)(sh0 + 1024 + c), s0 = *(const f32x4*)(sh0 + c); float o[4];
#pragma unroll
        for (int j = 0; j < 4; ++j) o[j] = v0[q][j] * rstd0 * gg[j] * (1.f + s1[j]) + s0[j];
        uint2 pk = {pack2(o[0], o[1]), pack2(o[2], o[3])};
        *(uint2*)(H + (size_t)row0 * DM + c) = pk; }
      if (has1) { const f32x4 s1 = *(const f32x4*)(sh1 + 1024 + c), s0 = *(const f32x4*)(sh1 + c); float o[4];
#pragma unroll
        for (int j = 0; j < 4; ++j) o[j] = v1[q][j] * rstd1 * gg[j] * (1.f + s1[j]) + s0[j];
        uint2 pk = {pack2(o[0], o[1]), pack2(o[2], o[3])};
        *(uint2*)(H + (size_t)row1 * DM + c) = pk; }
    }
  }
}

DI void phase_setup(const DevP& p, char* shmc, const int tid_, const int bid_) {
  const int tid = tid_;
  const size_t gtid = (size_t)bid_ * NTHR + tid, gn = (size_t)gridDim.x * NTHR;
  { float2* tw = (float2*)(p.ws + OFF_TW);
    for (size_t i = gtid; i < 4096; i += gn) { float sn, cs; sincospif((float)i / 4096.f, &sn, &cs); tw[i] = make_float2(cs, -sn); }
    float2* rp = (float2*)(p.ws + OFF_ROPE);
    for (size_t i = gtid; i < 4096 * 32; i += gn) { int t = (int)(i >> 5), f = (int)(i & 31); float pos = (f < 16) ? (float)(t / 64) : (float)(t % 64);
      float inv = powf(10000.f, -(float)(f & 15) / 16.f); float a = pos * inv; rp[i] = make_float2(cosf(a), sinf(a)); } }
  { float* sc = (float*)shmc;
    float* red = sc + 9 * 1024;
    for (int i = tid; i < 9 * 1024; i += NTHR) { int mi = i >> 10, k = i & 1023; float v = (mi < 8) ? pin(p, I_C)[mi * 1024 + k] : pin(p, I_CCTX)[k]; sc[i] = siluf_(v); }
    __syncthreads();
    float* mod = (float*)(p.ws + OFF_MOD);
    float* red2 = sc + 9 * 1024;
    for (int it = bid_; it < 4 * 48; it += gridDim.x) {
      const int l = it / 48, c0 = (it % 48) * 128, n4 = (tid & 31) * 4, ks = tid >> 5;
      const float* w = pin(p, I_ADAW) + (size_t)l * 1024 * 6144 + c0 + n4;
      f32x4 a[9];
#pragma unroll
      for (int q = 0; q < 9; ++q) a[q] = (f32x4){0.f, 0.f, 0.f, 0.f};
#pragma unroll 8
      for (int k = ks * 64; k < ks * 64 + 64; ++k) { const f32x4 wv = *(const f32x4*)(w + (size_t)k * 6144);
#pragma unroll
        for (int q = 0; q < 9; ++q) a[q] += sc[q * 1024 + k] * wv; }
#pragma unroll
      for (int q = 0; q < 9; ++q) *(f32x4*)(red2 + (ks * 9 + q) * 128 + n4) = a[q];
      __syncthreads();
      for (int o = tid; o < 9 * 128; o += NTHR) { const int q = o >> 7, c = o & 127; float sum = 0.f;
#pragma unroll
        for (int k2 = 0; k2 < 16; ++k2) sum += red2[(k2 * 9 + q) * 128 + c];
        mod[((size_t)l * 9 + q) * 6144 + c0 + c] = sum + pin(p, I_ADAB)[l * 6144 + c0 + c]; }
      __syncthreads();
    }
  }
  { float* scr = (float*)shmc + (tid >> 6) * 128;
    const int lane = tid & 63, gw_id = bid_ * 8 + (tid >> 6), nw = gridDim.x * 8;
    for (int r = gw_id; r < 2 * (4096 + 256); r += nw) {
      const int j = r / 4352, rr = r % 4352, type = rr >= 4096, i = type ? rr - 4096 : rr, n = type ? 256 : 4096;
      const float tpos = (float)i / (float)(n - 1), ang = 6.283185307179586f * (float)i / (float)n;
      float z = 0.f;
      if (lane == 0) z = tpos;
      else if (lane <= 32) { int e = (lane - 1) & 15; float f = 1e-4f + (float)e * ((15.f - 1e-4f) / 15.f); z = (lane <= 16) ? cosf(f * ang) : -sinf(f * ang); }
      scr[lane] = z;
      __builtin_amdgcn_wave_barrier();
      const float fr = pin(p, I_OFREQ)[j * 64 + lane];
      float a = pin(p, I_OFB1)[j * 64 + lane];
      { const float* W = pin(p, I_OFW1) + (size_t)j * 33 * 64 + lane; float wr_[33];
#pragma unroll
        for (int e = 0; e < 33; ++e) wr_[e] = W[e * 64];
        __builtin_amdgcn_sched_barrier(0);
#pragma unroll
        for (int e = 0; e < 33; ++e) a += scr[e] * wr_[e]; }
      float h = sinf(fr * a);
      scr[64 + lane] = h;
      __builtin_amdgcn_wave_barrier();
      a = pin(p, I_OFB2)[j * 64 + lane];
      { const float* W = pin(p, I_OFW2) + (size_t)j * 64 * 64 + lane;
#pragma unroll
        for (int e0 = 0; e0 < 64; e0 += 32) { float wr_[32];
#pragma unroll
          for (int e = 0; e < 32; ++e) wr_[e] = W[(e0 + e) * 64];
          __builtin_amdgcn_sched_barrier(0);
#pragma unroll
          for (int e = 0; e < 32; ++e) a += scr[64 + e0 + e] * wr_[e]; } }
      h = sinf(fr * a);
      __builtin_amdgcn_wave_barrier();
      scr[lane] = h;
      __builtin_amdgcn_wave_barrier();
      a = pin(p, I_OFB3)[j * 64 + lane];
      { const float* W = pin(p, I_OFW3) + (size_t)j * 64 * 64 + lane;
#pragma unroll
        for (int e0 = 0; e0 < 64; e0 += 32) { float wr_[32];
#pragma unroll
          for (int e = 0; e < 32; ++e) wr_[e] = W[(e0 + e) * 64];
          __builtin_amdgcn_sched_barrier(0);
#pragma unroll
          for (int e = 0; e < 32; ++e) a += scr[e0 + e] * wr_[e]; } }
      h = sinf(fr * a);
      float* dst = type ? (float*)(p.ws + OFF_HDNC) + ((size_t)j * 256 + i) * 64 : (float*)(p.ws + OFF_HDNL) + ((size_t)j * 4096 + i) * 64;
      dst[lane] = h;
      __builtin_amdgcn_wave_barrier();
    }
  }
}

DI void phase_taps(const DevP& p, int j, char* shmc, const int tid_, const int bid_, const int nwk_);
DI void convert_layer(const DevP& p, int layer, bf16_t* wt, char* shmc, const int tid_, const int bid_, const int nwk_, const int parts) {
  float* sh = (float*)shmc;
  const int j = layer >> 1;
  if ((layer & 1) == 0) { if (parts & 1) {
    wconv(pin(p, I_EWIN) + (size_t)j * DM * EVEN_IN, DM, EVEN_IN, wt + WT_WIN, sh, tid_, bid_, nwk_);
    {
      unsigned* z = (unsigned*)(wt + WT_WIN + (size_t)EVEN_IN * DM);
      for (size_t i = (size_t)bid_ * NTHR + tid_; i < (size_t)128 * DM / 2; i += (size_t)nwk_ * NTHR) z[i] = 0u; }
    wconv(pin(p, I_EWOUT) + (size_t)j * DM * DM, DM, DM, wt + WT_WOUT, sh, tid_, bid_, nwk_);
    {
      bf16_t* lb = wt + WT_LORA;
      for (size_t i = (size_t)bid_ * NTHR + tid_; i < (size_t)LOW * LW; i += (size_t)nwk_ * NTHR) {
        const int n = (int)(i / LW), k = (int)(i % LW); float v = 0.f;
        if (n < 512) { if (k < 64) v = pin(p, I_EW2)[(((size_t)j * 2 + 0) * 64 + k) * 512 + n]; }
        else if (n < 1024) { if (k >= 64 && k < 128) v = pin(p, I_EW2)[(((size_t)j * 2 + 1) * 64 + (k - 64)) * 512 + (n - 512)]; }
        else if (n < 1536) { if (k >= 128 && k < 192) v = pin(p, I_EA2)[(((size_t)j * 2 + 0) * 64 + (k - 128)) * 512 + (n - 1024)]; }
        else if (n < 2048) { if (k >= 192 && k < 256) v = pin(p, I_EA2)[(((size_t)j * 2 + 1) * 64 + (k - 192)) * 512 + (n - 1536)]; }
        else { if (k >= 256) v = pin(p, I_EG2)[((size_t)j * 128 + (k - 256)) * 512 + (n - 2048)]; }
        lb[i] = f2bf(v);
      } }
  } } else {
    if (parts & 1) {
    wconv(pin(p, I_OWIN) + (size_t)j * DM * HY3, DM, HY3, wt + WT_WIN, sh, tid_, bid_, nwk_);
    wconv(pin(p, I_OWOUT) + (size_t)j * DM * DM, DM, DM, wt + WT_WOUT, sh, tid_, bid_, nwk_); }
    if (parts & 2) phase_taps(p, j, shmc, tid_, bid_, nwk_);
  }
  if (parts & 4) {
  wconv(pin(p, I_FUP) + (size_t)layer * DM * FF2, DM, FF2, wt + WT_WUP, sh, tid_, bid_, nwk_);
  wconv(pin(p, I_FDN) + (size_t)layer * FF * DM, FF, DM, wt + WT_WDN, sh, tid_, bid_, nwk_); }
}
DI void phase_start(const DevP& p, int layer, char* shmc, const int tid_, const int bid_) {
  norm_phase(p, layer, 0, tid_, bid_);
  if (layer == 0) convert_layer(p, 0, (bf16_t*)(p.ws + OFF_WT), shmc, tid_, bid_, (int)gridDim.x, 7);
}

DI void phase_qkprep(const DevP& p, int j, const int tid_, const int bid_) {
  bf16_t* P = (bf16_t*)(p.ws + OFF_BIG);
  float* KN = (float*)(p.ws + OFF_KN);
  const float2* rope = (const float2*)(p.ws + OFF_ROPE);
  const int l16 = tid_ & 15;
  const int g0 = (bid_ * NTHR + tid_) >> 4, gs = ((int)gridDim.x * NTHR) >> 4;
  const float* gq = pin(p, I_EQN) + j * 64; const float* gk = pin(p, I_EKN) + j * 64;
  const float gq0 = gq[2 * l16], gq1 = gq[2 * l16 + 1], gq2 = gq[32 + 2 * l16], gq3 = gq[33 + 2 * l16];
  const float gk0 = gk[2 * l16], gk1 = gk[2 * l16 + 1], gk2 = gk[32 + 2 * l16], gk3 = gk[33 + 2 * l16];
  for (int row = g0; row < MROWS; row += gs) {
    const int s = row % TPB, t = s >= CTXL ? s - CTXL : 0;
    bf16_t* base = P + (size_t)row * PW;
    unsigned u0[10], u1[10]; uint2 uk[8]; f32x4 kkw[8];
#pragma unroll
    for (int q = 0; q < 10; ++q) { u0[q] = *(const unsigned*)(base + A_IN + q * 64 + 2 * l16); u1[q] = *(const unsigned*)(base + A_IN + q * 64 + 32 + 2 * l16); }
#pragma unroll
    for (int h = 0; h < 8; ++h) { uk[h] = *(const uint2*)(base + 512 + h * 64 + 4 * l16); kkw[h] = *(const f32x4*)(pin(p, I_EKK) + j * 512 + h * 64 + 4 * l16); }
    const float2 c0 = rope[t * 32 + 2 * l16], c1 = rope[t * 32 + 2 * l16 + 1];
#pragma unroll
    for (int q = 0; q < 10; ++q) {
      float a0 = lo16(u0[q]), a1 = hi16(u0[q]), b0 = lo16(u1[q]), b1 = hi16(u1[q]);
      const float ss = sum16(a0 * a0 + a1 * a1 + b0 * b0 + b1 * b1);
      const float rstd = rsqrtf(ss * (1.f / 64.f) + 1e-6f);
      a0 = a0 * rstd * (q < 8 ? gq0 : gk0); a1 = a1 * rstd * (q < 8 ? gq1 : gk1); b0 = b0 * rstd * (q < 8 ? gq2 : gk2); b1 = b1 * rstd * (q < 8 ? gq3 : gk3);
      if (s >= CTXL) {
        const float na0 = a0 * c0.x - b0 * c0.y, nb0 = a0 * c0.y + b0 * c0.x, na1 = a1 * c1.x - b1 * c1.y, nb1 = a1 * c1.y + b1 * c1.x;
        a0 = na0; b0 = nb0; a1 = na1; b1 = nb1;
      }
      *(unsigned*)(base + A_IN + q * 64 + 2 * l16) = pack2(a0, a1); *(unsigned*)(base + A_IN + q * 64 + 32 + 2 * l16) = pack2(b0, b1);
    }
#pragma unroll
    for (int h = 0; h < 8; ++h) {
      const float a0 = lo16(uk[h].x) * kkw[h][0], a1 = hi16(uk[h].x) * kkw[h][1], a2 = lo16(uk[h].y) * kkw[h][2], a3 = hi16(uk[h].y) * kkw[h][3];
      const float ss = sum16(a0 * a0 + a1 * a1 + a2 * a2 + a3 * a3);
      if (l16 == 0) KN[(size_t)row * 8 + h] = 1.f / fmaxf(sqrtf(ss), 1e-12f);
    }
  }
}

template <int CTRL> DI float dppf(float x) { return __builtin_bit_cast(float, __builtin_amdgcn_update_dpp(0, __builtin_bit_cast(int, x), CTRL, 0xf, 0xf, false)); }
DI void phase_scan(const DevP& p, int j, char* shmc, const int tid_, const int bid_) {
  const bf16_t* P = (const bf16_t*)(p.ws + OFF_BIG);
  const bf16_t* LO = (const bf16_t*)(p.ws + OFF_LO);
  const float* KN = (const float*)(p.ws + OFF_KN);
  bf16_t* Y = (bf16_t*)(p.ws + OFF_H);
  const int tid = tid_, l16 = tid & 15, rloc = tid >> 4;
  constexpr int TT = 32, STEPF = 5 * 64 + 32 + 4;
  constexpr int NSTEP = CTXL + SEQ, NCH = NSTEP / TT;
  float* buf = (float*)shmc;
  float* ybuf = buf + 2 * TT * STEPF;
  for (int u = bid_; u < 256; u += gridDim.x) {
    const int chain = u >> 1, half = u & 1, d = chain >> 6, b = (chain >> 3) & 7, h = chain & 7;
    f32x4 kkw = *(const f32x4*)(pin(p, I_EKK) + j * 512 + h * 64 + 4 * l16), kaw = *(const f32x4*)(pin(p, I_EKA) + j * 512 + h * 64 + 4 * l16);
    f32x4 S = {0.f, 0.f, 0.f, 0.f};
    float sa = 0.f;
    uint2 gr, gk, ge, ga, gv, gk2; float gkn, gkn2;
    auto rowof = [&](int g) -> int {
      g = g > NSTEP - 1 ? NSTEP - 1 : g;
      const int seg = g >= CTXL, st = seg ? g - CTXL : g, n = seg ? SEQ : CTXL, t = d ? (n - 1 - st) : st;
      return b * TPB + (seg ? CTXL + t : t);
    };
    auto gload = [&](int c) {
      const int row = rowof(c * TT + rloc), row2 = rowof(c * TT + rloc + 1);
      const bf16_t* pr = P + (size_t)row * PW + h * 64 + 4 * l16;
      gr = *(const uint2*)pr; gk = *(const uint2*)(pr + 512);
      gk2 = *(const uint2*)(P + (size_t)row2 * PW + 512 + h * 64 + 4 * l16);
      const bf16_t* lo = LO + (size_t)row * LOW + d * 512 + h * 64 + 4 * l16;
      ge = *(const uint2*)lo; ga = *(const uint2*)(lo + 1024);
      gkn = KN[(size_t)row * 8 + h]; gkn2 = KN[(size_t)row2 * 8 + h];
      if (l16 < 8) gv = *(const uint2*)(P + (size_t)row * PW + 1024 + h * 64 + half * 32 + 4 * l16);
    };
    auto lstore = [&](int bi) {
      float* dst = buf + ((size_t)bi * TT + rloc) * STEPF;
      float k4[4] = {lo16(gk.x), hi16(gk.x), lo16(gk.y), hi16(gk.y)}, e4[4] = {lo16(ge.x), hi16(ge.x), lo16(ge.y), hi16(ge.y)};
      float a4[4] = {lo16(ga.x), hi16(ga.x), lo16(ga.y), hi16(ga.y)}, n4[4] = {lo16(gk2.x), hi16(gk2.x), lo16(gk2.y), hi16(gk2.y)};
      f32x4 w, q, kka, kd, r = {lo16(gr.x), hi16(gr.x), lo16(gr.y), hi16(gr.y)};
      float c1 = 0.f, c2 = 0.f;
#pragma unroll
      for (int e = 0; e < 4; ++e) {
        w[e] = __expf(-e4[e]); const float kk = k4[e] * kkw[e] * gkn, kkn = n4[e] * kkw[e] * gkn2;
        kka[e] = kk * a4[e]; kd[e] = k4[e] * (1.f + (a4[e] - 1.f) * kaw[e]); q[e] = w[e] * kkn;
        c1 += kka[e] * kkn; c2 += kd[e] * kkn;
      }
      c1 = dpp_sum16(c1); c2 = dpp_sum16(c2);
      *(f32x4*)(dst + 0 + 4 * l16) = q; *(f32x4*)(dst + 64 + 4 * l16) = kka; *(f32x4*)(dst + 128 + 4 * l16) = kd; *(f32x4*)(dst + 192 + 4 * l16) = w; *(f32x4*)(dst + 256 + 4 * l16) = r;
      if (l16 < 8) { f32x4 v = {lo16(gv.x), hi16(gv.x), lo16(gv.y), hi16(gv.y)}; *(f32x4*)(dst + 320 + 4 * l16) = v; }
      if (l16 == 0) { dst[352] = c1; dst[353] = c2; }
    };
    __syncthreads();
    gload(0); lstore(0);
    __syncthreads();
    for (int c = 0; c < NCH; ++c) {
      if (c + 1 < NCH) gload(c + 1);
      const float* sb = buf + (size_t)(c & 1) * TT * STEPF;
      float* yb = ybuf + (c & 1) * TT * 32;
      f32x4 Lq[3], Lka[3], Lkd[3], Lw[3], Lr[3]; float Lv[3]; float2 Lc[3];
#define SCAN_LD(slot, st) do { const float* q_ = sb + (st) * STEPF; \
        Lq[slot] = *(const f32x4*)(q_ + 4 * l16); Lka[slot] = *(const f32x4*)(q_ + 64 + 4 * l16); Lkd[slot] = *(const f32x4*)(q_ + 128 + 4 * l16); \
        Lw[slot] = *(const f32x4*)(q_ + 192 + 4 * l16); Lr[slot] = *(const f32x4*)(q_ + 256 + 4 * l16); Lv[slot] = q_[320 + rloc]; Lc[slot] = *(const float2*)(q_ + 352); } while (0)
      SCAN_LD(0, 0); SCAN_LD(1, 1);
      float yp[16];
#pragma unroll
      for (int st = 0; st < TT; ++st) {
        if (st + 2 < TT) SCAN_LD((st + 2) % 3, st + 2);
        __builtin_amdgcn_sched_barrier(0);
        { const int sl_ = st % 3;
          const f32x4 qq = Lq[sl_], kka = Lka[sl_], kd = Lkd[sl_], w = Lw[sl_], r = Lr[sl_]; const float v = Lv[sl_]; const float2 cc = Lc[sl_];
          float pd = S[0] * qq[0] + S[1] * qq[1] + S[2] * qq[2] + S[3] * qq[3];
          pd = dpp_sum16(pd);
#pragma unroll
          for (int e = 0; e < 4; ++e) S[e] = S[e] * w[e] + sa * kka[e] + v * kd[e];
          sa = -pd - sa * cc.x - v * cc.y;
          yp[st & 15] = S[0] * r[0] + S[1] * r[1] + S[2] * r[2] + S[3] * r[3];
        }
        if ((st & 15) == 15) {
          const bool h8 = l16 & 8, h4 = l16 & 4, h2 = l16 & 2, h1 = l16 & 1;
#pragma unroll
          for (int k = 0; k < 8; ++k) { const float a = yp[k], bq = yp[k + 8]; yp[k] = (h8 ? bq : a) + dppf<0x128>(h8 ? a : bq); }
#pragma unroll
          for (int k = 0; k < 4; ++k) { const float a = yp[k], bq = yp[k + 4]; yp[k] = (h4 ? bq : a) + dppf<0x141>(h4 ? a : bq); }
#pragma unroll
          for (int k = 0; k < 2; ++k) { const float a = yp[k], bq = yp[k + 2]; yp[k] = (h2 ? bq : a) + dppf<0x4E>(h2 ? a : bq); }
          { const float a = yp[0], bq = yp[1]; yp[0] = (h1 ? bq : a) + dppf<0xB1>(h1 ? a : bq); }
          yb[((st - 15) + l16) * 32 + rloc] = yp[0];
        }
      }
#undef SCAN_LD
      if (c + 1 < NCH) lstore((c + 1) & 1);
      __syncthreads();
      {
        const int sl = tid >> 4, i2 = (tid & 15) * 2;
        const int row = rowof(c * TT + sl);
        *(unsigned*)(Y + ((size_t)d * MROWS + row) * 512 + h * 64 + half * 32 + i2) = pack2(yb[sl * 32 + i2], yb[sl * 32 + i2 + 1]);
      }
    }
    __syncthreads();
  }
}

DI void phase_attn(const DevP& p, int j, char* shmc, const int tid_, const int bid_) {
  bf16_t* P = (bf16_t*)(p.ws + OFF_BIG);
  constexpr int KP = 72;
  bf16_t* Ks = (bf16_t*)shmc;
  bf16_t* Vs = Ks + 2 * 64 * KP;
  const int tid = tid_, wid = tid >> 6, lane = tid & 63, fr = lane & 15, fq = lane >> 4;
  const int gh = wid & 3, th = wid >> 2;
  const float C2 = 0.125f * 1.4426950408889634f;
  for (int it0 = bid_; it0 < 544; it0 += gridDim.x) {
    const int it = ((int)gridDim.x == 256 && it0 < 512) ? ((it0 & ~255) | ((it0 & 7) << 5) | ((it0 >> 3) & 31)) : it0;
    int b, kvh, qb0, isctx;
    if (it < 512) { b = it >> 6; kvh = (it >> 5) & 1; qb0 = it & 31; isctx = 0; }
    else { int i2 = it - 512; b = i2 >> 2; kvh = (i2 >> 1) & 1; qb0 = i2 & 1; isctx = 1; }
    const int head = kvh * 4 + gh;
    const int tq0 = qb0 * 128 + th * 64;
    const int rowbase = b * TPB + (isctx ? 0 : CTXL);
    bf16x8 bq[4][2];
#pragma unroll
    for (int qb = 0; qb < 4; ++qb)
#pragma unroll
      for (int ds = 0; ds < 2; ++ds)
        bq[qb][ds] = *(const bf16x8*)(P + (size_t)(rowbase + tq0 + qb * 16 + fr) * PW + A_IN + head * 64 + ds * 32 + fq * 8);
    f32x4 O[4][4];
#pragma unroll
    for (int a = 0; a < 4; ++a)
#pragma unroll
      for (int c = 0; c < 4; ++c) O[a][c] = (f32x4){0.f, 0.f, 0.f, 0.f};
    const float sinkl = pin(p, I_ESINK)[j * 8 + head] * 1.4426950408889634f;
    float mrun[4], lrun[4];
#pragma unroll
    for (int qb = 0; qb < 4; ++qb) { mrun[qb] = sinkl; lrun[qb] = (fq == 0) ? 1.f : 0.f; }
    const int ntile = isctx ? 4 : 10;
    auto tile_row0 = [&](int ti, bool& valid, bool& lat) -> int {
      if (!isctx && ti < 6) { int kb = qb0 * 128 + (ti - 2) * 64; lat = true; valid = (kb >= 0 && kb < SEQ); return b * TPB + CTXL + kb; }
      int ci = isctx ? ti : ti - 6; lat = false; valid = true; return b * TPB + ci * 64;
    };
    uint4 kreg, vreg;
    const int lkey = tid >> 3, ldg = tid & 7;
    auto gl = [&](int ti) { bool v, l; int r0 = tile_row0(ti, v, l); if (v) {
        const bf16_t* src = P + (size_t)(r0 + lkey) * PW + A_IN + 512 + kvh * 64 + ldg * 8;
        kreg = *(const uint4*)src; vreg = *(const uint4*)(src + 128); } };
    auto ls = [&](int ti, int bi) { bool v, l; tile_row0(ti, v, l); if (v) {
        *(uint4*)(Ks + bi * 64 * KP + lkey * KP + ldg * 8) = kreg;
        bf16_t* vt = Vs + bi * 64 * KP; const unsigned* vr = (const unsigned*)&vreg;
#pragma unroll
        for (int e = 0; e < 8; ++e) vt[(ldg * 8 + e) * KP + lkey] = (bf16_t)((e & 1) ? (vr[e >> 1] >> 16) : (vr[e >> 1] & 0xffffu)); } };
    __syncthreads();
    gl(0); ls(0, 0);
    __syncthreads();
    for (int ti = 0; ti < ntile; ++ti) {
      if (ti + 1 < ntile) gl(ti + 1);
      bool valid, lat; const int r0 = tile_row0(ti, valid, lat);
      bool work = valid;
      const int kt0 = lat ? (r0 - (b * TPB + CTXL)) : 0;
      if (lat && (kt0 + 63 < tq0 - 128 || kt0 > tq0 + 63 + 128)) work = false;
      if (work) {
        const bf16_t* kt = Ks + (ti & 1) * 64 * KP; const bf16_t* vt = Vs + (ti & 1) * 64 * KP;
        f32x4 Sx[4][4];
#pragma unroll
        for (int kb = 0; kb < 4; ++kb) {
          bf16x8 ak0 = *(const bf16x8*)(kt + (kb * 16 + fr) * KP + fq * 8), ak1 = *(const bf16x8*)(kt + (kb * 16 + fr) * KP + 32 + fq * 8);
#pragma unroll
          for (int qb = 0; qb < 4; ++qb) {
            f32x4 s = {0.f, 0.f, 0.f, 0.f};
            s = __builtin_amdgcn_mfma_f32_16x16x32_bf16(ak0, bq[qb][0], s, 0, 0, 0);
            s = __builtin_amdgcn_mfma_f32_16x16x32_bf16(ak1, bq[qb][1], s, 0, 0, 0);
            Sx[kb][qb] = s;
          }
        }
        bf16x8 pb[4][2];
#pragma unroll
        for (int qb = 0; qb < 4; ++qb) {
          const int qtok = tq0 + qb * 16 + fr;
          float mx = -3.0e38f;
#pragma unroll
          for (int kb = 0; kb < 4; ++kb)
#pragma unroll
            for (int jj = 0; jj < 4; ++jj) {
              float s = Sx[kb][qb][jj] * C2;
              if (lat) { int dk = kt0 + kb * 16 + fq * 4 + jj - qtok; if (dk > 128 || dk < -128) s = -3.0e38f; }
              Sx[kb][qb][jj] = s; mx = fmaxf(mx, s);
            }
          mx = fmaxf(mx, bperm_xor(mx, lane, 16)); mx = fmaxf(mx, bperm_xor(mx, lane, 32));
          constexpr float THR = 11.0f;
          float alpha = 1.f;
          if (__builtin_amdgcn_ballot_w64(mx > mrun[qb] + THR) != 0ull) {
            const float mnew = fmaxf(mrun[qb], mx);
            alpha = exp2f(mrun[qb] - mnew);
            mrun[qb] = mnew;
#pragma unroll
            for (int db = 0; db < 4; ++db) O[db][qb] *= alpha;
          }
          const float mcur = mrun[qb];
          float ps = 0.f; float pv[4][4];
#pragma unroll
          for (int kb = 0; kb < 4; ++kb)
#pragma unroll
            for (int jj = 0; jj < 4; ++jj) { float e = exp2f(Sx[kb][qb][jj] - mcur); pv[kb][jj] = e; ps += e; }
          lrun[qb] = lrun[qb] * alpha + ps;
#pragma unroll
          for (int ks = 0; ks < 2; ++ks) {
            unsigned w0 = pack2(pv[2 * ks][0], pv[2 * ks][1]), w1 = pack2(pv[2 * ks][2], pv[2 * ks][3]);
            unsigned w2 = pack2(pv[2 * ks + 1][0], pv[2 * ks + 1][1]), w3 = pack2(pv[2 * ks + 1][2], pv[2 * ks + 1][3]);
            uint4 t4 = {w0, w1, w2, w3}; pb[qb][ks] = __builtin_bit_cast(bf16x8, t4);
          }
        }
#pragma unroll
        for (int db = 0; db < 4; ++db)
#pragma unroll
          for (int ks = 0; ks < 2; ++ks) {
            uint2 v0 = *(const uint2*)(vt + (db * 16 + fr) * KP + (2 * ks) * 16 + fq * 4), v1 = *(const uint2*)(vt + (db * 16 + fr) * KP + (2 * ks + 1) * 16 + fq * 4);
            uint4 t4 = {v0.x, v0.y, v1.x, v1.y}; bf16x8 av = __builtin_bit_cast(bf16x8, t4);
#pragma unroll
            for (int qb = 0; qb < 4; ++qb) O[db][qb] = __builtin_amdgcn_mfma_f32_16x16x32_bf16(av, pb[qb][ks], O[db][qb], 0, 0, 0);
          }
      }
      if (ti + 1 < ntile) ls(ti + 1, (ti + 1) & 1);
      __syncthreads();
    }
#pragma unroll
    for (int qb = 0; qb < 4; ++qb) {
      float l = lrun[qb]; l += bperm_xor(l, lane, 16); l += bperm_xor(l, lane, 32);
      const float inv = 1.f / l;
      bf16_t* dst = P + (size_t)(rowbase + tq0 + qb * 16 + fr) * PW + A_IN + head * 64 + fq * 4;
#pragma unroll
      for (int db = 0; db < 4; ++db) {
        uint2 pk = {pack2(O[db][qb][0] * inv, O[db][qb][1] * inv), pack2(O[db][qb][2] * inv, O[db][qb][3] * inv)};
        if (!p.dry) *(uint2*)(dst + db * 16) = pk;
      }
    }
  }
}

DI void phase_rwkv_out(const DevP& p, int j, const int tid_, const int bid_) {
  bf16_t* P = (bf16_t*)(p.ws + OFF_BIG);
  const bf16_t* LO = (const bf16_t*)(p.ws + OFF_LO);
  const bf16_t* Y = (const bf16_t*)(p.ws + OFF_H);
  const int l16 = tid_ & 15;
  const int g0 = (bid_ * NTHR + tid_) >> 4, gs = ((int)gridDim.x * NTHR) >> 4, NIT = MROWS * 8;
  for (int it0 = g0; it0 < NIT; it0 += 2 * gs) {
    uint2 y0[2], y1[2], ur[2], uk[2], uv[2], ua0[2], ua1[2], ug[2]; f32x4 ka[2], rk[2], lw[2], lb[2]; bf16_t* prs[2]; bool ok[2];
#pragma unroll
    for (int k = 0; k < 2; ++k) {
      const int itk = it0 + k * gs; ok[k] = itk < NIT; const int it = ok[k] ? itk : it0;
      const int row = it >> 3, h = it & 7, c = h * 64 + 4 * l16;
      y0[k] = *(const uint2*)(Y + (size_t)row * 512 + c); y1[k] = *(const uint2*)(Y + ((size_t)MROWS + row) * 512 + c);
      bf16_t* pr = P + (size_t)row * PW + c; prs[k] = pr;
      ur[k] = *(const uint2*)pr; uk[k] = *(const uint2*)(pr + 512); uv[k] = *(const uint2*)(pr + 1024);
      const bf16_t* lo = LO + (size_t)row * LOW + c;
      ua0[k] = *(const uint2*)(lo + 1024); ua1[k] = *(const uint2*)(lo + 1536); ug[k] = *(const uint2*)(lo + 2048);
      ka[k] = *(const f32x4*)(pin(p, I_EKA) + j * 512 + c); rk[k] = *(const f32x4*)(pin(p, I_ERK) + j * 512 + c);
      lw[k] = *(const f32x4*)(pin(p, I_ELNW) + j * 512 + c); lb[k] = *(const f32x4*)(pin(p, I_ELNB) + j * 512 + c);
    }
#pragma unroll
    for (int k = 0; k < 2; ++k) {
      const float y[4] = {lo16(y0[k].x) + lo16(y1[k].x), hi16(y0[k].x) + hi16(y1[k].x), lo16(y0[k].y) + lo16(y1[k].y), hi16(y0[k].y) + hi16(y1[k].y)};
      const float r[4] = {lo16(ur[k].x), hi16(ur[k].x), lo16(ur[k].y), hi16(ur[k].y)}, kq[4] = {lo16(uk[k].x), hi16(uk[k].x), lo16(uk[k].y), hi16(uk[k].y)};
      const float v[4] = {lo16(uv[k].x), hi16(uv[k].x), lo16(uv[k].y), hi16(uv[k].y)}, a0[4] = {lo16(ua0[k].x), hi16(ua0[k].x), lo16(ua0[k].y), hi16(ua0[k].y)};
      const float a1[4] = {lo16(ua1[k].x), hi16(ua1[k].x), lo16(ua1[k].y), hi16(ua1[k].y)}, gg[4] = {lo16(ug[k].x), hi16(ug[k].x), lo16(ug[k].y), hi16(ug[k].y)};
      float sy = 0.f, bo = 0.f;
#pragma unroll
      for (int q = 0; q < 4; ++q) { sy += y[q]; const float kd = kq[q] * (2.f + (a0[q] + a1[q] - 2.f) * ka[k][q]); bo += r[q] * kd * rk[k][q]; }
      sy = sum16(sy); bo = sum16(bo);
      const float mu = sy * (1.f / 64.f);
      float sv = 0.f;
#pragma unroll
      for (int q = 0; q < 4; ++q) { const float dd = y[q] - mu; sv += dd * dd; }
      sv = sum16(sv);
      const float rs = rsqrtf(sv * (1.f / 64.f) + 64e-5f);
      float o[4];
#pragma unroll
      for (int q = 0; q < 4; ++q) o[q] = ((y[q] - mu) * rs * lw[k][q] + lb[k][q] + bo * v[q]) * gg[q];
      uint2 pk = {pack2(o[0], o[1]), pack2(o[2], o[3])};
      if (ok[k] && !p.dry) *(uint2*)prs[k] = pk;
    }
  }
}

DI int PI(int n) { return n + (n >> 5); }
DI float2 cmul(float2 a, float2 b) { return make_float2(a.x * b.x - a.y * b.y, a.x * b.y + a.y * b.x); }
DI float2 cmulc(float2 a, float2 b) { return make_float2(a.x * b.x + a.y * b.y, a.y * b.x - a.x * b.y); }
template <int M> DI float2 c16() {
  constexpr float cs[8] = {1.f, 0.9238795325112867f, 0.7071067811865476f, 0.3826834323650898f, 0.f, -0.3826834323650898f, -0.7071067811865476f, -0.9238795325112867f};
  constexpr float sn[8] = {0.f, -0.3826834323650898f, -0.7071067811865476f, -0.9238795325112867f, -1.f, -0.9238795325112867f, -0.7071067811865476f, -0.3826834323650898f};
  return make_float2(cs[M], sn[M]);
}
template <int S, int I, bool TWD> DI void bfly_f(float2 (&x)[16], float2 w) {
  constexpr int hs = 8 >> S, m = I & (hs - 1);
  float2 a = x[I], b = x[I + hs];
  x[I] = make_float2(a.x + b.x, a.y + b.y);
  float2 d = make_float2(a.x - b.x, a.y - b.y);
  float2 W = c16<m * (8 / hs)>();
  if (TWD) W = cmul(W, w);
  x[I + hs] = (m == 0 && !TWD) ? d : cmul(d, W);
}
template <int S, int I, bool TWD> DI void bfly_i(float2 (&x)[16], float2 w) {
  constexpr int hs = 8 >> S, m = I & (hs - 1);
  float2 W = c16<m * (8 / hs)>();
  if (TWD) W = cmul(W, w);
  float2 a = x[I], t = (m == 0 && !TWD) ? x[I + hs] : cmulc(x[I + hs], W);
  x[I] = make_float2(a.x + t.x, a.y + t.y);
  x[I + hs] = make_float2(a.x - t.x, a.y - t.y);
}
template <int S, bool TWD> DI void stage_f(float2 (&x)[16], float2 w) {
  constexpr int hs = 8 >> S;
  if (!(0 & hs)) bfly_f<S, 0, TWD>(x, w);
  if (!(1 & hs)) bfly_f<S, 1 & ~hs, TWD>(x, w);
  if (!(2 & hs)) bfly_f<S, 2 & ~hs, TWD>(x, w);
  if (!(3 & hs)) bfly_f<S, 3 & ~hs, TWD>(x, w);
  if (!(4 & hs)) bfly_f<S, 4 & ~hs, TWD>(x, w);
  if (!(5 & hs)) bfly_f<S, 5 & ~hs, TWD>(x, w);
  if (!(6 & hs)) bfly_f<S, 6 & ~hs, TWD>(x, w);
  if (!(7 & hs)) bfly_f<S, 7 & ~hs, TWD>(x, w);
  if (!(8 & hs)) bfly_f<S, 8 & ~hs, TWD>(x, w);
  if (!(9 & hs)) bfly_f<S, 9 & ~hs, TWD>(x, w);
  if (!(10 & hs)) bfly_f<S, 10 & ~hs, TWD>(x, w);
  if (!(11 & hs)) bfly_f<S, 11 & ~hs, TWD>(x, w);
  if (!(12 & hs)) bfly_f<S, 12 & ~hs, TWD>(x, w);
  if (!(13 & hs)) bfly_f<S, 13 & ~hs, TWD>(x, w);
  if (!(14 & hs)) bfly_f<S, 14 & ~hs, TWD>(x, w);
  if (!(15 & hs)) bfly_f<S, 15 & ~hs, TWD>(x, w);
}
template <int S, bool TWD> DI void stage_i(float2 (&x)[16], float2 w) {
  constexpr int hs = 8 >> S;
  if (!(0 & hs)) bfly_i<S, 0, TWD>(x, w);
  if (!(1 & hs)) bfly_i<S, 1 & ~hs, TWD>(x, w);
  if (!(2 & hs)) bfly_i<S, 2 & ~hs, TWD>(x, w);
  if (!(3 & hs)) bfly_i<S, 3 & ~hs, TWD>(x, w);
  if (!(4 & hs)) bfly_i<S, 4 & ~hs, TWD>(x, w);
  if (!(5 & hs)) bfly_i<S, 5 & ~hs, TWD>(x, w);
  if (!(6 & hs)) bfly_i<S, 6 & ~hs, TWD>(x, w);
  if (!(7 & hs)) bfly_i<S, 7 & ~hs, TWD>(x, w);
  if (!(8 & hs)) bfly_i<S, 8 & ~hs, TWD>(x, w);
  if (!(9 & hs)) bfly_i<S, 9 & ~hs, TWD>(x, w);
  if (!(10 & hs)) bfly_i<S, 10 & ~hs, TWD>(x, w);
  if (!(11 & hs)) bfly_i<S, 11 & ~hs, TWD>(x, w);
  if (!(12 & hs)) bfly_i<S, 12 & ~hs, TWD>(x, w);
  if (!(13 & hs)) bfly_i<S, 13 & ~hs, TWD>(x, w);
  if (!(14 & hs)) bfly_i<S, 14 & ~hs, TWD>(x, w);
  if (!(15 & hs)) bfly_i<S, 15 & ~hs, TWD>(x, w);
}
template <bool TWD> DI void r16_fwd(float2 (&x)[16], float2 w0) {
  float2 w1 = cmul(w0, w0), w2 = cmul(w1, w1), w3 = cmul(w2, w2);
  stage_f<0, TWD>(x, w0); stage_f<1, TWD>(x, w1); stage_f<2, TWD>(x, w2); stage_f<3, TWD>(x, w3);
}
template <bool TWD> DI void r16_inv(float2 (&x)[16], float2 w0) {
  float2 w1 = cmul(w0, w0), w2 = cmul(w1, w1), w3 = cmul(w2, w2);
  stage_i<3, TWD>(x, w3); stage_i<2, TWD>(x, w2); stage_i<1, TWD>(x, w1); stage_i<0, TWD>(x, w0);
}
DI void passA(float2* D, const float2 w0, int tid, bool inv) {
  const int base = (tid >> 8) * 4096 + (tid & 255);
  float2 x[16];
#pragma unroll
  for (int i = 0; i < 16; ++i) x[i] = D[PI(base + i * 256)];
  if (inv) r16_inv<true>(x, w0); else r16_fwd<true>(x, w0);
#pragma unroll
  for (int i = 0; i < 16; ++i) D[PI(base + i * 256)] = x[i];
}
DI void passB(float2* D, const float2 w0, int tid, bool inv) {
  const int base = (tid >> 4) * 256 + (tid & 15);
  float2 x[16];
#pragma unroll
  for (int i = 0; i < 16; ++i) x[i] = D[PI(base + i * 16)];
  if (inv) r16_inv<true>(x, w0); else r16_fwd<true>(x, w0);
#pragma unroll
  for (int i = 0; i < 16; ++i) D[PI(base + i * 16)] = x[i];
}

DI void phase_taps(const DevP& p, int j, char* shmc, const int tid_, const int bid_, const int nwk_) {
  float* hs = (float*)shmc;
  float* fs = hs + 64 * 65;
  const float* fout = pin(p, I_OFOUT) + (size_t)j * 64 * 4096;
  const float da = -3.0701134573253945f, db = -15.350567286626973f;
  const int tid = tid_;
  for (int it = bid_; it < 64 * 68; it += nwk_) {
    const int ct = it / 68, tt = it % 68, isc = tt >= 64, t0 = (isc ? tt - 64 : tt) * 64, c0 = ct * 64, n = isc ? 256 : 4096;
    const float* hdn = isc ? (const float*)(p.ws + OFF_HDNC) + (size_t)j * 256 * 64 : (const float*)(p.ws + OFF_HDNL) + (size_t)j * 4096 * 64;
    __syncthreads();
    { float hv_[8], fv_[8];
#pragma unroll
      for (int q = 0; q < 8; ++q) { const int e = tid + q * NTHR, r = e >> 6, cc = e & 63; hv_[q] = hdn[(size_t)(t0 + r) * 64 + cc]; fv_[q] = fout[(size_t)r * 4096 + c0 + cc]; }
      __builtin_amdgcn_sched_barrier(0);
#pragma unroll
      for (int q = 0; q < 8; ++q) { const int e = tid + q * NTHR, r = e >> 6, cc = e & 63; hs[r * 65 + cc] = hv_[q]; fs[r * 64 + cc] = fv_[q]; } }
    __syncthreads();
    const int tl = tid & 63, cg8 = (tid >> 6) * 8;
    float acc[8];
#pragma unroll
    for (int e = 0; e < 8; ++e) acc[e] = 0.f;
    for (int k = 0; k < 64; ++k) { const float hv = hs[tl * 65 + k];
#pragma unroll
      for (int e = 0; e < 8; ++e) acc[e] += hv * fs[k * 64 + cg8 + e]; }
    const float tpos = (float)(t0 + tl) / (float)(n - 1);
#pragma unroll
    for (int e = 0; e < 8; ++e) {
      const int c = c0 + cg8 + e, d = c & 1023;
      const float delta = fabsf(da + (db - da) * (float)d / (float)(DM - 1));
      const float v = acc[e] * (__expf(-tpos * delta) + 0.05f);
      if (isc) ((float*)(p.ws + OFF_LO) + (size_t)4096 * 4096)[(size_t)c * 256 + t0 + tl] = v;
      else ((float*)(p.ws + OFF_LO))[(size_t)c * 4096 + t0 + tl] = v;
    }
  }
}

DI void phase_hyena(const DevP& p, int j, char* shmc, const int tid_, const int bid_) {
  bf16_t* ZT = (bf16_t*)(p.ws + OFF_BIG);
  const float2* TW = (const float2*)(p.ws + OFF_TW);
  const float* HFL = (const float*)(p.ws + OFF_LO);
  const float* HFC = HFL + (size_t)4096 * 4096;
  float2* D = (float2*)shmc;
  float2* KF = D + 8448;
  const int tid = tid_;
  for (int d = bid_; d < DM; d += gridDim.x) {
#pragma unroll 1
    for (int o = 0; o < 2; ++o) {
      const float skip = pin(p, I_OSKIP)[(j * 2 + o) * DM + d];
      const float* cf = HFL + ((size_t)((o * 2 + 0) * DM + d)) * 4096;
      const float* cb = HFL + ((size_t)((o * 2 + 1) * DM + d)) * 4096;
      __syncthreads();
      for (int t = tid; t < 4096; t += NTHR) {
        const float lo = (t == 0) ? cf[0] + cb[0] : cf[t];
        const float hi = (t == 0) ? 0.f : cb[4096 - t];
        const float2 w = TW[t];
        D[PI(t)] = make_float2(lo + hi, 0.f);
        const float dd = lo - hi;
        D[PI(4096 + t)] = make_float2(dd * w.x, dd * w.y);
      }
      { const float2 w_ = TW[2 * (tid & 255)]; __syncthreads(); passA(D, w_, tid, false); }
      { const float2 w_ = TW[32 * (tid & 15)]; __syncthreads(); passB(D, w_, tid, false); }
      __syncthreads();
      { float2 x[16];
#pragma unroll
        for (int i = 0; i < 16; ++i) x[i] = D[PI(tid * 16 + i)];
        r16_fwd<false>(x, make_float2(1.f, 0.f));
#pragma unroll
        for (int i = 0; i < 16; ++i) KF[PI(tid * 16 + i)] = x[i]; }
      __syncthreads();
#pragma unroll 1
      for (int pr = 0; pr < 4; ++pr) {
        const bf16_t* u1 = ZT + ((size_t)((2 * pr) * HY3 + d)) * TPB + CTXL;
        const bf16_t* u2 = ZT + ((size_t)((2 * pr + 1) * HY3 + d)) * TPB + CTXL;
        for (int t = tid; t < 4096; t += NTHR) {
          const float2 u = make_float2(bf2f(u1[t]), bf2f(u2[t]));
          D[PI(t)] = u; D[PI(4096 + t)] = cmul(u, TW[t]);
        }
        { const float2 w_ = TW[2 * (tid & 255)]; __syncthreads(); passA(D, w_, tid, false); }
        { const float2 w_ = TW[32 * (tid & 15)]; __syncthreads(); passB(D, w_, tid, false); }
        __syncthreads();
        { float2 x[16];
#pragma unroll
          for (int i = 0; i < 16; ++i) x[i] = D[PI(tid * 16 + i)];
          r16_fwd<false>(x, make_float2(1.f, 0.f));
#pragma unroll
          for (int i = 0; i < 16; ++i) x[i] = cmul(x[i], KF[PI(tid * 16 + i)]);
          r16_inv<false>(x, make_float2(1.f, 0.f));
#pragma unroll
          for (int i = 0; i < 16; ++i) D[PI(tid * 16 + i)] = x[i]; }
        { const float2 w_ = TW[32 * (tid & 15)]; __syncthreads(); passB(D, w_, tid, true); }
        { const float2 w_ = TW[2 * (tid & 255)]; __syncthreads(); passA(D, w_, tid, true); }
        __syncthreads();
        const bf16_t* x1 = ZT + ((size_t)((2 * pr) * HY3 + (1 + o) * DM + d)) * TPB + CTXL;
        const bf16_t* x2 = ZT + ((size_t)((2 * pr + 1) * HY3 + (1 + o) * DM + d)) * TPB + CTXL;
        bf16_t* o1 = ZT + ((size_t)((2 * pr) * HY3 + d)) * TPB + CTXL;
        bf16_t* o2 = ZT + ((size_t)((2 * pr + 1) * HY3 + d)) * TPB + CTXL;
        {
          float2 twv[8]; bf16_t ua_[8], ub_[8], xa_[8], xb_[8];
#pragma unroll
          for (int k = 0; k < 8; ++k) { const int t = tid + k * NTHR; twv[k] = TW[t]; ua_[k] = u1[t]; ub_[k] = u2[t]; xa_[k] = x1[t]; xb_[k] = x2[t]; }
          __builtin_amdgcn_sched_barrier(0);
#pragma unroll
          for (int k = 0; k < 8; ++k) { const int t = tid + k * NTHR;
            const float2 a = D[PI(t)], b = cmulc(D[PI(4096 + t)], twv[k]);
            const float yx = (a.x + b.x) * (1.f / 8192.f), yy = (a.y + b.y) * (1.f / 8192.f);
            if (!p.dry) { o1[t] = f2bf(bf2f(xa_[k]) * (yx + bf2f(ua_[k]) * skip)); o2[t] = f2bf(bf2f(xb_[k]) * (yy + bf2f(ub_[k]) * skip)); } }
        }
        __syncthreads();
      }
      {
        const float* hfc = HFC + ((size_t)((o * 2 + 0) * DM + d)) * 256;
        const float* hbc = HFC + ((size_t)((o * 2 + 1) * DM + d)) * 256;
        for (int q = tid; q < 5 * 256; q += NTHR) {
          const int blk = q >> 8, t = q & 255; const float2 w = TW[16 * t];
          if (blk < 4) {
            const float2 u = make_float2(bf2f(ZT[((size_t)((2 * blk) * HY3 + d)) * TPB + t]), bf2f(ZT[((size_t)((2 * blk + 1) * HY3 + d)) * TPB + t]));
            D[PI(blk * 512 + t)] = u; D[PI(blk * 512 + 256 + t)] = cmul(u, w);
          } else {
            const float lo = (t == 0) ? hfc[0] + hbc[0] : hfc[t], hi = (t == 0) ? 0.f : hbc[256 - t];
            D[PI(2048 + t)] = make_float2(lo + hi, 0.f); const float dd = lo - hi; D[PI(2304 + t)] = make_float2(dd * w.x, dd * w.y);
          }
        }
        { const float2 w_ = TW[32 * (tid & 15)]; __syncthreads(); if (tid < 160) passB(D, w_, tid, false); }
        __syncthreads();
        if (tid >= 128 && tid < 160) { float2 x[16];
#pragma unroll
          for (int i = 0; i < 16; ++i) x[i] = D[PI(tid * 16 + i)];
          r16_fwd<false>(x, make_float2(1.f, 0.f));
#pragma unroll
          for (int i = 0; i < 16; ++i) D[PI(tid * 16 + i)] = x[i]; }
        __syncthreads();
        if (tid < 128) { float2 x[16];
          const int kb = 2048 + ((tid >> 4) & 1) * 256 + (tid & 15) * 16;
#pragma unroll
          for (int i = 0; i < 16; ++i) x[i] = D[PI(tid * 16 + i)];
          r16_fwd<false>(x, make_float2(1.f, 0.f));
#pragma unroll
          for (int i = 0; i < 16; ++i) x[i] = cmul(x[i], D[PI(kb + i)]);
          r16_inv<false>(x, make_float2(1.f, 0.f));
#pragma unroll
          for (int i = 0; i < 16; ++i) D[PI(tid * 16 + i)] = x[i]; }
        { const float2 w_ = TW[32 * (tid & 15)]; __syncthreads(); if (tid < 128) passB(D, w_, tid, true); }
        __syncthreads();
        { float2 twv[2]; bf16_t ua_[2], ub_[2], xa_[2], xb_[2];
#pragma unroll
          for (int k = 0; k < 2; ++k) { const int q = tid + k * NTHR, blk = q >> 8, t = q & 255;
            const bf16_t* p1 = ZT + ((size_t)((2 * blk) * HY3 + d)) * TPB + t; const bf16_t* p2 = ZT + ((size_t)((2 * blk + 1) * HY3 + d)) * TPB + t;
            twv[k] = TW[16 * t]; ua_[k] = *p1; ub_[k] = *p2; xa_[k] = p1[(size_t)(1 + o) * DM * TPB]; xb_[k] = p2[(size_t)(1 + o) * DM * TPB]; }
#pragma unroll
          for (int k = 0; k < 2; ++k) { const int q = tid + k * NTHR, blk = q >> 8, t = q & 255;
            const float2 a = D[PI(blk * 512 + t)], b = cmulc(D[PI(blk * 512 + 256 + t)], twv[k]);
            const float yx = (a.x + b.x) * (1.f / 512.f), yy = (a.y + b.y) * (1.f / 512.f);
            bf16_t* p1 = ZT + ((size_t)((2 * blk) * HY3 + d)) * TPB + t; bf16_t* p2 = ZT + ((size_t)((2 * blk + 1) * HY3 + d)) * TPB + t;
            if (!p.dry) { *p1 = f2bf(bf2f(xa_[k]) * (yx + bf2f(ua_[k]) * skip)); *p2 = f2bf(bf2f(xb_[k]) * (yy + bf2f(ub_[k]) * skip)); } }
        }
        __syncthreads();
      }
    }
  }
}

DI void phase_transpose(const DevP& p, char* shmc, const int tid_, const int bid_) {
  const bf16_t* ZT = (const bf16_t*)(p.ws + OFF_BIG);
  bf16_t* H = (bf16_t*)(p.ws + OFF_H);
  bf16_t* T = (bf16_t*)shmc;
  const int tid = tid_;
  for (int it = bid_; it < NB * 68 * 16; it += gridDim.x) {
    const int b = it / (68 * 16), rem = it % (68 * 16), s0 = (rem >> 4) * 64, d0 = (rem & 15) * 64;
    { const int dr = tid >> 3, sc = (tid & 7) * 8;
      *(uint4*)(T + dr * 72 + sc) = *(const uint4*)(ZT + ((size_t)(b * HY3 + d0 + dr)) * TPB + s0 + sc); }
    __syncthreads();
    { const int sr = tid >> 3, dc = (tid & 7) * 8; unsigned w[4];
#pragma unroll
      for (int e = 0; e < 4; ++e) w[e] = (unsigned)T[(dc + 2 * e) * 72 + sr] | ((unsigned)T[(dc + 2 * e + 1) * 72 + sr] << 16);
      uint4 pk = {w[0], w[1], w[2], w[3]};
      *(uint4*)(H + ((size_t)(b * TPB + s0 + sr)) * DM + d0 + dc) = pk; }
    __syncthreads();
  }
}


#define XB_TMO      128
#define XB_XCNT(j)  (256  + 64 * (j))
#define XB_XSUB(j)  (1280 + 64 * (j))
#define XB_XGEN(j)  (2304 + 64 * (j))
#define XB_TOP      3328
#define XB_TOPGEN   3392
#define XCD_BAR_WORDS 3456
#define XB_SPIN_CAP (1u << 22)
#define LAS __attribute__((address_space(3)))
DI unsigned xb_ld(unsigned* q)              { return __hip_atomic_load(q, __ATOMIC_RELAXED, __HIP_MEMORY_SCOPE_AGENT); }
DI unsigned xb_add(unsigned* q, unsigned v) { return __hip_atomic_fetch_add(q, v, __ATOMIC_RELAXED, __HIP_MEMORY_SCOPE_AGENT); }
DI unsigned xb_xcc_id() { return (unsigned)__builtin_amdgcn_s_getreg((3 << 11) | 20) & 0xFu; }
#define XB_SPIN(cond, bar) do { unsigned _sp = 0; while (cond) { __builtin_amdgcn_s_sleep(1); \
    if ((++_sp & 255u) == 0u) { if (xb_ld(&(bar)[XB_TMO])) break; if (_sp > XB_SPIN_CAP) { atomicAdd(&(bar)[XB_TMO], 1u); break; } } } } while (0)
struct XcdBarrier { unsigned* bar; unsigned x; volatile LAS unsigned* st; };
DI void xcd_barrier_complete(unsigned* bar, unsigned x, unsigned& nloc, unsigned& nx) {
  const unsigned G = gridDim.x;
  unsigned sum, cnt, mine, sp = 0u;
  for (;;) {
    sum = 0u; cnt = 0u; mine = 0u;
#pragma unroll
    for (unsigned j = 0; j < 16; ++j) { const unsigned c = xb_ld(&bar[XB_XCNT(j)]); sum += c; cnt += (c > 0u) ? 1u : 0u; mine = (j == x) ? c : mine; }
    if (sum == G) break;
    __builtin_amdgcn_s_sleep(1);
    if ((++sp & 255u) == 0u) { if (xb_ld(&bar[XB_TMO])) break; if (sp > XB_SPIN_CAP) { atomicAdd(&bar[XB_TMO], 1u); break; } }
  }
  nloc = mine > 0u ? mine : 1u; nx = cnt > 0u ? cnt : 1u;
}
DI void xcd_barrier(const XcdBarrier& b, int tid) {
  asm volatile("s_waitcnt vmcnt(0)" ::: "memory");
  __syncthreads();
  if (tid == 0) {
    unsigned* bar = b.bar;
    __builtin_amdgcn_s_waitcnt(0);
    unsigned nloc = b.st[0], nx = b.st[1];
    if (nloc == 0u) { xcd_barrier_complete(bar, b.x, nloc, nx); b.st[0] = nloc; b.st[1] = nx; }
    const unsigned old = xb_add(&bar[XB_XSUB(b.x)], 1u);
    const unsigned gen = old / nloc;
    if (old + 1u == (gen + 1u) * nloc) {
      __builtin_amdgcn_fence(__ATOMIC_RELEASE, "agent");
      asm volatile("s_waitcnt vmcnt(0)" ::: "memory");
      const unsigned og = xb_add(&bar[XB_TOP], 1u);
      const unsigned tg = og / nx;
      if (og + 1u == (tg + 1u) * nx) xb_add(&bar[XB_TOPGEN], 1u);
      else XB_SPIN(xb_ld(&bar[XB_TOPGEN]) == tg, bar);
      __builtin_amdgcn_fence(__ATOMIC_ACQUIRE, "agent");
      xb_add(&bar[XB_XGEN(b.x)], 1u);
      asm volatile("s_waitcnt vmcnt(0)" ::: "memory");
    } else {
      XB_SPIN(xb_ld(&bar[XB_XGEN(b.x)]) == gen, bar);
      __builtin_amdgcn_fence(__ATOMIC_ACQUIRE, "agent");
      asm volatile("s_waitcnt vmcnt(0)" ::: "memory");
    }
  }
  __syncthreads();
}

constexpr int NPHASE = 1 + 4 * 9;
#define NREP(t) (((PROBE_MASK >> (t)) & 1) ? 2 : 1)
#define REP(t, nonidem, call) for (int r_ = 0; r_ < NREP(t); ++r_) { p.dry = (nonidem) && (r_ + 1 < NREP(t)); call; }

template <int EN>
__global__ void __launch_bounds__(NTHR) fwd_kernel(Params pk, int ph0, int ph1, int coop) {
  extern __shared__ __attribute__((aligned(16))) char shm[];
  __shared__ const float* in_tab[N_IN];
  if (threadIdx.x < N_IN) in_tab[threadIdx.x] = pk.in[threadIdx.x];
  __shared__ uint4 xb_words;
  if (threadIdx.x == 0) xb_words = make_uint4(0u, 0u, 0u, 0u);
  __syncthreads();
  XcdBarrier xb; xb.bar = (unsigned*)(pk.ws + OFF_BAR); xb.x = xb_xcc_id(); xb.st = (volatile LAS unsigned*)&xb_words;
  if (EN == 0xffff && coop && threadIdx.x == 0) (void)xb_add(&xb.bar[XB_XCNT(xb.x)], 1u);
  bf16_t* shb = (bf16_t*)shm;
  const int wave_s = __builtin_amdgcn_readfirstlane(threadIdx.x >> 6);
  const int phend = (EN == 0xffff) ? ph1 : ph0 + 1;
  for (int ph = ph0; ph < phend; ++ph) {
    int lane_; asm volatile("v_mbcnt_lo_u32_b32 %0, -1, 0\n\tv_mbcnt_hi_u32_b32 %0, -1, %0" : "=v"(lane_));
    int tid_ = wave_s * 64 + lane_, bid_ = blockIdx.x;
    asm volatile("" : "+s"(bid_));
    DevP p; p.in = in_tab; p.dry = false; p.xin = (ph == 1 || ph == 6);
    { unsigned long long w = (unsigned long long)pk.ws, o = (unsigned long long)pk.out;
      unsigned wl = (unsigned)w, wh = (unsigned)(w >> 32), ol = (unsigned)o, oh = (unsigned)(o >> 32);
      asm volatile("" : "+s"(wl), "+s"(wh), "+s"(ol), "+s"(oh));
      p.ws = (char*)(__attribute__((address_space(1))) char*)(((unsigned long long)wh << 32) | wl);
      p.out = (float*)(__attribute__((address_space(1))) float*)(((unsigned long long)oh << 32) | ol); }
    int conv_next = -1, conv_parts = 0;
    GemmCall g{}; int nM = 0, nN = 0; bool do_gemm = false, skip_sync = false;
    if (ph == 0) { if constexpr (EN & 1) REP(0, false, phase_setup(p, shm, tid_, bid_)) }
    else {
      const int layer = (ph - 1) / 9, sub = (ph - 1) % 9, even = (layer & 1) == 0, j = layer >> 1;
      const float* mod = (const float*)(p.ws + OFF_MOD) + (size_t)layer * 9 * 6144;
      const bf16_t* wt = (const bf16_t*)(p.ws + ((layer & 1) ? OFF_WT2 : OFF_WT));
      g.M = MROWS; g.ksk = 1 << 30; g.ksoff = 0;
      if (sub == 0) { if constexpr (EN & 2) REP(1, false, phase_start(p, layer, shm, tid_, bid_)) }
      else if (sub == 1) {
        g.A = (const bf16_t*)(p.ws + OFF_H); g.lda = DM; g.Bt = wt + WT_WIN; g.K = DM; do_gemm = true;
        if (even) { g.e0 = pin(p, I_EMUP) + j * A_IN; g.e1 = pin(p, I_EMUN) + j * A_IN; g.o0 = (bf16_t*)(p.ws + OFF_BIG); g.o1 = (bf16_t*)(p.ws + OFF_L);
          g.mode = M_EVEN; nM = (MROWS + 253) / 254; nN = 11; }
        else { g.bias = pin(p, I_OBIN) + j * HY3; g.e0 = pin(p, I_OCW) + (size_t)j * 3 * HY3; g.e1 = pin(p, I_OCB) + j * HY3; g.o0 = (bf16_t*)(p.ws + OFF_BIG);
          g.mode = M_ODD; nM = (MROWS + 247) / 248; nN = 12; }
      } else if (sub == 2) {
        if (even) {
          g.A = (const bf16_t*)(p.ws + OFF_L); g.lda = LW; g.Bt = wt + WT_LORA; g.K = LW;
          g.e0 = pin(p, I_EW0) + j * 1024; g.e1 = pin(p, I_EA0) + j * 1024; g.o0 = (bf16_t*)(p.ws + OFF_LO);
          g.mode = M_LORA; nM = MROWS / 256; nN = LOW / 256; do_gemm = true;
          if constexpr (EN & 32) phase_qkprep(p, j, tid_, bid_);
        } else { if constexpr (EN & 64) REP(6, true, phase_hyena(p, j, shm, tid_, bid_)) }
      } else if (sub == 3) {
        if (even) { if constexpr (EN & 128) REP(7, false, phase_scan(p, j, shm, tid_, bid_)) if constexpr (EN & 256) REP(8, true, phase_attn(p, j, shm, tid_, bid_))
          if (layer < 3) { __syncthreads();
            if ((int)gridDim.x == 256) { if (bid_ >= 32) convert_layer(p, layer + 1, (bf16_t*)(p.ws + (((layer + 1) & 1) ? OFF_WT2 : OFF_WT)), shm, tid_, bid_ - 32, 224, 4); }
            else convert_layer(p, layer + 1, (bf16_t*)(p.ws + (((layer + 1) & 1) ? OFF_WT2 : OFF_WT)), shm, tid_, bid_, (int)gridDim.x, 4); } }
        else { if constexpr (EN & 512) REP(9, false, phase_transpose(p, shm, tid_, bid_)) }
      } else if (sub == 4) {
        if (even) { if constexpr (EN & 1024) phase_rwkv_out(p, j, tid_, bid_); }
        else skip_sync = true;
      } else if (sub == 5) {
        g.Bt = wt + WT_WOUT; g.K = DM; g.mod = mod; g.msel = 2; g.mode = M_RES; nM = MROWS / 256; nN = DM / 256; do_gemm = true;
        g.skipctx = (layer == 3);
        if (layer < 3) { conv_next = layer + 1; conv_parts = 1; }
        if (even) { g.A = (const bf16_t*)(p.ws + OFF_BIG); g.lda = PW; g.ksk = 8; g.ksoff = A_IN - 512; g.bias = nullptr; }
        else { g.A = (const bf16_t*)(p.ws + OFF_H); g.lda = DM; g.bias = pin(p, I_OBOUT) + j * DM; }
      } else if (sub == 6) { if constexpr (EN & 4096) REP(12, false, norm_phase(p, layer, 1, tid_, bid_)) }
      else if (sub == 7) {
        g.A = (const bf16_t*)(p.ws + OFF_H); g.lda = DM; g.Bt = wt + WT_WUP; g.K = DM;
        g.e0 = pin(p, I_FCW) + (size_t)layer * 3 * FF2; g.e1 = pin(p, I_FCB) + (size_t)layer * FF2; g.o0 = (bf16_t*)(p.ws + OFF_BIG);
        g.mode = M_FFN; nM = (MROWS + 253) / 254; nN = FF / 128; do_gemm = true;
      } else {
        g.A = (const bf16_t*)(p.ws + OFF_BIG); g.lda = FF; g.Bt = wt + WT_WDN; g.K = FF; g.mod = mod; g.msel = 5; g.bias = nullptr;
        g.skipctx = (layer == 3);
        if (layer < 3) { conv_next = layer + 1; conv_parts = ((layer + 1) & 1) ? 2 : 4; }
        g.mode = M_RES; nM = MROWS / 256; nN = DM / 256; do_gemm = true;
      }
    }
    if (do_gemm) {
      if (g.mode == M_RES) { if constexpr (EN & 2048) REP(11, true, gemm_phase<M_RES>(p, shb, g, nM, nN, tid_, bid_)) }
      else if (g.mode == M_LORA) { if constexpr (EN & 16) REP(4, false, gemm_phase<M_LORA>(p, shb, g, nM, nN, tid_, bid_)) }
      else if (g.mode == M_FFN) { if constexpr (EN & 8192) REP(13, true, gemm_phase<M_FFN>(p, shb, g, nM, nN, tid_, bid_)) }
      else if (g.mode == M_EVEN) { if constexpr (EN & 4) REP(2, true, gemm_phase<M_EVEN>(p, shb, g, nM, nN, tid_, bid_)) }
      else { if constexpr (EN & 8) REP(3, true, gemm_phase<M_ODD>(p, shb, g, nM, nN, tid_, bid_)) }
    }
    if (conv_next >= 0 && (int)gridDim.x == 256 && (bid_ >> 3) >= 4)
      convert_layer(p, conv_next, (bf16_t*)(p.ws + ((conv_next & 1) ? OFF_WT2 : OFF_WT)), shm, tid_, (bid_ & 7) * 28 + (bid_ >> 3) - 4, 224, conv_parts);
    else if (conv_next >= 0 && (int)gridDim.x != 256)
      convert_layer(p, conv_next, (bf16_t*)(p.ws + ((conv_next & 1) ? OFF_WT2 : OFF_WT)), shm, tid_, bid_, (int)gridDim.x, conv_parts);
    if (EN == 0xffff && coop && ph + 1 < ph1 && !skip_sync) {
      if (ph1 < 0) { __threadfence(); cg::this_grid().sync(); }
      for (int r_ = 0; r_ < NREP(14); ++r_) xcd_barrier(xb, tid_);
    }
  }
}

#ifndef MK_MULTI
#define MK_MULTI 0
#endif

template <int EN>
static void launch_phase(const Params& p, int ph, hipStream_t stream) {
  static bool attr = false;
  if (!attr) { (void)hipFuncSetAttribute((const void*)fwd_kernel<EN>, hipFuncAttributeMaxDynamicSharedMemorySize, LDS_BYTES); attr = true; }
  fwd_kernel<EN><<<256, NTHR, LDS_BYTES, stream>>>(p, ph, ph + 1, 0);
}

extern "C" void kernel_launch(void* const* d_in, const int* in_sizes, int n_in, void* d_out, int out_size, void* d_ws, size_t ws_size, hipStream_t stream) {
  Params p{};
  for (int i = 0; i < N_IN; ++i) p.in[i] = (const float*)d_in[i];
  p.out = (float*)d_out; p.ws = (char*)d_ws;
  if (ws_size < WS_END2) { fprintf(stderr, "workspace too small: %zu < %zu\n", ws_size, (size_t)WS_END); return; }
#if MK_MULTI
  launch_phase<1>(p, 0, stream);
  for (int layer = 0; layer < 4; ++layer) {
    const int b = 1 + layer * 9; const bool even = (layer & 1) == 0;
    launch_phase<2>(p, b + 0, stream);
    if (even) {
      launch_phase<4>(p, b + 1, stream); launch_phase<16>(p, b + 2, stream); launch_phase<32>(p, b + 2, stream); launch_phase<128 | 256>(p, b + 3, stream); launch_phase<1024>(p, b + 4, stream);
    } else {
      launch_phase<8>(p, b + 1, stream); launch_phase<64>(p, b + 2, stream); launch_phase<512>(p, b + 3, stream);
    }
    launch_phase<2048>(p, b + 5, stream); launch_phase<4096>(p, b + 6, stream); launch_phase<8192>(p, b + 7, stream); launch_phase<2048>(p, b + 8, stream);
  }
#else
  static bool attr = false;
  if (!attr) { (void)hipFuncSetAttribute((const void*)fwd_kernel<0xffff>, hipFuncAttributeMaxDynamicSharedMemorySize, LDS_BYTES); attr = true; }
  (void)hipMemsetAsync((char*)d_ws + OFF_BAR, 0, XCD_BAR_WORDS * 4, stream);
  int ph0 = 0, ph1 = NPHASE, coop = 1;
  void* args[] = {&p, &ph0, &ph1, &coop};
  hipError_t e = hipLaunchCooperativeKernel((const void*)fwd_kernel<0xffff>, dim3(256), dim3(NTHR), args, LDS_BYTES, stream);
  if (e != hipSuccess) fprintf(stderr, "cooperative launch failed: %s\n", hipGetErrorString(e));
#endif
}
```

```cpp
#include <hip/hip_runtime.h>
#include <hip/hip_cooperative_groups.h>
#include <cstdio>
namespace cg = cooperative_groups;

typedef unsigned short bf16_t;
typedef short bf16x8 __attribute__((ext_vector_type(8)));
typedef float f32x4 __attribute__((ext_vector_type(4)));
typedef __bf16 bf16v2 __attribute__((ext_vector_type(2)));
#define DI __device__ __forceinline__
#ifndef PROBE_MASK
#define PROBE_MASK 0
#endif

constexpr int DM = 1024, NB = 8, SEQ = 4096, CTXL = 256, TPB = SEQ + CTXL, MROWS = NB * TPB;
constexpr int A_IN = 1920, EVEN_IN = 2688, PW = 2688, LW = 384, LOW = 2560, FF = 2816, FF2 = 5632, HY3 = 3072;
constexpr int NTHR = 512;
constexpr int TP = 264;
constexpr int LDS_BYTES = 256 * TP * 2;

enum { I_X = 0, I_C, I_CTX, I_CCTX, I_ADAW, I_ADAB, I_N1G, I_N2G, I_FUP, I_FCW, I_FCB, I_FDN,
       I_EWIN, I_EMUP, I_EMUN, I_EW0, I_EW2, I_EA0, I_EA2, I_EG2, I_EKK, I_EKA, I_ERK, I_ELNW, I_ELNB, I_EQN, I_EKN, I_ESINK, I_EWOUT,
       I_OWIN, I_OBIN, I_OCW, I_OCB, I_OFW1, I_OFB1, I_OFW2, I_OFB2, I_OFW3, I_OFB3, I_OFREQ, I_OFOUT, I_OSKIP, I_OWOUT, I_OBOUT, N_IN };

struct Params { const float* in[N_IN]; float* out; char* ws; };
struct DevP { const float* const* in; float* out; char* ws; bool dry; bool xin; };

constexpr size_t OFF_XC = 0;
constexpr size_t OFF_MOD = OFF_XC + (size_t)NB * CTXL * DM * 4;
constexpr size_t OFF_HDNL = OFF_MOD + (size_t)4 * 9 * 6144 * 4;
constexpr size_t OFF_HDNC = OFF_HDNL + (size_t)2 * 4096 * 64 * 4;
constexpr size_t OFF_TW = OFF_HDNC + (size_t)2 * 256 * 64 * 4;
constexpr size_t OFF_ROPE = OFF_TW + (size_t)4096 * 8;
constexpr size_t OFF_KN = OFF_ROPE + (size_t)4096 * 32 * 8;
constexpr size_t OFF_WT = OFF_KN + (size_t)MROWS * 8 * 4;
constexpr size_t WT_WIN = 0, WT_LORA = 3145728, WT_WOUT = WT_LORA + 983040, WT_WUP = WT_WOUT + 1048576, WT_WDN = WT_WUP + 5767168, WT_END = WT_WDN + 2883584;
constexpr size_t OFF_H = OFF_WT + WT_END * 2;
constexpr size_t OFF_BIG = OFF_H + (size_t)MROWS * DM * 2;
constexpr size_t OFF_LO = OFF_BIG + (size_t)NB * HY3 * TPB * 2;
constexpr size_t WS_END = OFF_LO + (size_t)MROWS * LOW * 2;
constexpr size_t OFF_BAR = WS_END;
constexpr size_t OFF_WT2 = OFF_BAR + 16384;
constexpr size_t WS_END2 = OFF_WT2 + WT_END * 2;
constexpr size_t OFF_L = OFF_BIG + (size_t)MROWS * PW * 2;

DI f32x4 ld_nt16(const float* q) { return __builtin_nontemporal_load((const f32x4*)q); }
DI float bf2f(bf16_t h) { return __uint_as_float(((unsigned)h) << 16); }
DI unsigned pack2(float a, float b) { bf16v2 v = {(__bf16)a, (__bf16)b}; return __builtin_bit_cast(unsigned, v); }
DI bf16_t f2bf(float a) { __bf16 v = (__bf16)a; return __builtin_bit_cast(bf16_t, v); }
DI float lo16(unsigned u) { return __uint_as_float(u << 16); }
DI float hi16(unsigned u) { return __uint_as_float(u & 0xffff0000u); }
DI float sigmoidf_(float x) { return 1.f / (1.f + __expf(-x)); }
DI float siluf_(float x) { return x / (1.f + __expf(-x)); }
DI float dpp_sum16(float x) {
  x += __builtin_bit_cast(float, __builtin_amdgcn_update_dpp(0, __builtin_bit_cast(int, x), 0x128, 0xf, 0xf, false));
  x += __builtin_bit_cast(float, __builtin_amdgcn_update_dpp(0, __builtin_bit_cast(int, x), 0x124, 0xf, 0xf, false));
  x += __builtin_bit_cast(float, __builtin_amdgcn_update_dpp(0, __builtin_bit_cast(int, x), 0x122, 0xf, 0xf, false));
  x += __builtin_bit_cast(float, __builtin_amdgcn_update_dpp(0, __builtin_bit_cast(int, x), 0x121, 0xf, 0xf, false));
  return x;
}
DI float bperm_xor(float v, int lane, int mask) {
  return __builtin_bit_cast(float, __builtin_amdgcn_ds_bpermute((lane ^ mask) << 2, __builtin_bit_cast(int, v)));
}
DI float sum16(float v) { return dpp_sum16(v); }
DI float wave_sum(float v, int lane) { v = dpp_sum16(v); v += bperm_xor(v, lane, 16); v += bperm_xor(v, lane, 32); return v; }
DI float* xrow(const DevP& p, int row, int& mi) {
  int b = row / TPB, s = row - b * TPB;
  if (s < CTXL) { mi = 8; return (float*)(p.ws + OFF_XC) + ((size_t)(b * CTXL + s)) * DM; }
  mi = b; return p.out + ((size_t)(b * SEQ + s - CTXL)) * DM;
}
DI bool prev_valid(int row) { int s = row % TPB; return s != 0 && s != CTXL; }
DI bool next_valid(int row) { int s = row % TPB; return s != CTXL - 1 && s != TPB - 1; }

constexpr int HT = 128 * 64;
DI const char* uni_ptr(const char* q) {
  unsigned lo = __builtin_amdgcn_readfirstlane((unsigned)(unsigned long long)q), hi = __builtin_amdgcn_readfirstlane((unsigned)((unsigned long long)q >> 32));
  return (const char*)(const __attribute__((address_space(1))) char*)(((unsigned long long)hi << 32) | lo);
}
DI const float* pin(const DevP& p, int i) { return (const float*)uni_ptr((const char*)p.in[i]); }
DI const float* xrow_src(const DevP& p, int row, int& mi) {
  if (!p.xin) return xrow(p, row, mi);
  const int b = row / TPB, s = row - b * TPB;
  if (s < CTXL) { mi = 8; return pin(p, I_CTX) + ((size_t)(b * CTXL + s)) * DM; }
  mi = b; return pin(p, I_X) + ((size_t)(b * SEQ + s - CTXL)) * DM;
}
DI int lds_byte(int r, int c) { int st = (r >> 4) * 2 + (c >> 5), rr = r & 15, cc = c & 31, ob = rr * 64 + cc * 2; return st * 1024 + (ob ^ (((ob >> 9) & 1) << 5)); }
DI void stage_rc(int b, int& R, int& C) { int st = b / 1024, sb = b % 1024, swz = sb ^ (((sb >> 9) & 1) << 5); R = (st >> 1) * 16 + swz / 64; C = (st & 1) * 32 + (swz % 64) / 2; }

#define WAIT_V(n) asm volatile("s_waitcnt vmcnt(" #n ")" ::: "memory")
#define WAIT_L(n) asm volatile("s_waitcnt lgkmcnt(" #n ")" ::: "memory")
#define BAR __builtin_amdgcn_s_barrier()
#define SCHED __builtin_amdgcn_sched_barrier(0)

enum { M_RES = 0, M_LORA = 1, M_FFN = 2, M_EVEN = 3, M_ODD = 4 };

struct GemmCall {
  const bf16_t* A; int lda; int M; int ksk; int ksoff;
  const bf16_t* Bt; int K;
  const float* bias; const float* mod; int msel;
  const float* e0; const float* e1; const float* e2; const float* e3;
  bf16_t* o0; bf16_t* o1;
  int mode;
  int skipctx;
};

template <int MODE>
DI void gemm_tile(const DevP& p, bf16_t* shm, const GemmCall& g, int pm, int pn, const int tid_, const int bid_) {
  constexpr bool CONV = (MODE >= M_FFN);
  constexpr int S = (MODE == M_ODD) ? 248 : 254, HALO = (MODE == M_ODD) ? 4 : 1;
  const int tid = tid_;
  const int K = g.K;
  int arow0, brow0, brow1;
  if (CONV) arow0 = pm * S - HALO; else arow0 = pm * 256;
  if (MODE == M_FFN) { brow0 = pn * 128; brow1 = FF + pn * 128; } else { brow0 = pn * 256; brow1 = pn * 256 + 128; }
  unsigned aoffv, boffv;
  { int r, c; stage_rc(tid * 16, r, c); aoffv = (unsigned)(r * g.lda + c) * 2u; boffv = (unsigned)(r * K + c) * 2u; }
  const long abase0 = (long)arow0 * g.lda, bbase0 = (long)brow0 * K, bbase1 = (long)brow1 * K;
  const bf16_t* gA = g.A; const bf16_t* gB = g.Bt; const int ksk = g.ksk, ksoff = g.ksoff;
  const int wvu = __builtin_amdgcn_readfirstlane(tid >> 6);
#define SA(b, h) (shm + ((b) * 2 + (h)) * HT)
#define SB(b, h) (shm + (4 + (b) * 2 + (h)) * HT)
#define STAGE_A(P, h, kt) do { const int _k = (kt); \
    const char* _b0 = uni_ptr((const char*)(gA + abase0 + (long)(h) * 128 * g.lda + _k * 64 + (_k >= ksk ? ksoff : 0))); \
    const char* _b1 = uni_ptr(_b0 + (long)128 * g.lda); \
    unsigned _o0 = aoffv; asm volatile("" : "+v"(_o0)); \
    __builtin_amdgcn_global_load_lds((const unsigned*)(_b0 + (size_t)_o0), (unsigned*)((char*)(P) + wvu * 1024), 16, 0, 0); \
    __builtin_amdgcn_global_load_lds((const unsigned*)(_b1 + (size_t)_o0), (unsigned*)((char*)(P) + wvu * 1024 + 8192), 16, 0, 0); } while (0)
#define STAGE_B(P, h, kt) do { \
    const char* _b0 = uni_ptr((const char*)(gB + ((h) ? bbase1 : bbase0) + (kt) * 64)); \
    const char* _b1 = uni_ptr(_b0 + (long)128 * K); \
    unsigned _o0 = boffv; asm volatile("" : "+v"(_o0)); \
    __builtin_amdgcn_global_load_lds((const unsigned*)(_b0 + (size_t)_o0), (unsigned*)((char*)(P) + wvu * 1024), 16, 0, 0); \
    __builtin_amdgcn_global_load_lds((const unsigned*)(_b1 + (size_t)_o0), (unsigned*)((char*)(P) + wvu * 1024 + 8192), 16, 0, 0); } while (0)
#define LDA(dst, b, h) for (int m = 0; m < 4; ++m) for (int k = 0; k < 2; ++k) \
    dst[m][k] = *reinterpret_cast<const bf16x8*>((char*)SA(b, h) + lds_byte(wr * 64 + m * 16 + fr, k * 32 + fq * 8))
#define LDB(dst, b, h) for (int n = 0; n < 2; ++n) for (int k = 0; k < 2; ++k) \
    dst[n][k] = *reinterpret_cast<const bf16x8*>((char*)SB(b, h) + lds_byte(wc * 32 + n * 16 + fr, k * 32 + fq * 8))
#define MMA(ai, bj, At, Bx) do { __builtin_amdgcn_s_setprio(1); \
    for (int m = 0; m < 4; ++m) for (int n = 0; n < 2; ++n) for (int k = 0; k < 2; ++k) \
      acc[ai][bj][m][n] = __builtin_amdgcn_mfma_f32_16x16x32_bf16(Bx[n][k], At[m][k], acc[ai][bj][m][n], 0, 0, 0); \
    __builtin_amdgcn_s_setprio(0); } while (0)

  const int wid = tid >> 6, lane = tid & 63, wr = wid >> 2, wc = wid & 3, fr = lane & 15, fq = lane >> 4;
  f32x4 acc[2][2][4][2] = {};
  bf16x8 At[4][2], B0[2][2], B1[2][2];
  const int nt = K / 64;
  STAGE_B(SB(0, 0), 0, 0); STAGE_A(SA(0, 0), 0, 0);
  STAGE_B(SB(0, 1), 1, 0); STAGE_A(SA(0, 1), 1, 0);
  if (wr == 1) BAR;
  WAIT_V(4); BAR;
  STAGE_B(SB(1, 0), 0, 1); STAGE_A(SA(1, 0), 0, 1); STAGE_B(SB(1, 1), 1, 1);
  WAIT_V(6); BAR;
  for (int t = 0; t < nt; t += 2) {
    const int t1 = t + 1, t2 = (t + 2 < nt) ? t + 2 : nt - 1, t3 = (t + 3 < nt) ? t + 3 : nt - 1;
    LDB(B0, 0, 0); SCHED; LDA(At, 0, 0); STAGE_A(SA(1, 1), 1, t1);
    WAIT_L(8); BAR; WAIT_L(0); MMA(0, 0, At, B0); BAR; SCHED;
    LDB(B1, 0, 1); STAGE_B(SB(0, 0), 0, t2);
    BAR; WAIT_L(0); MMA(0, 1, At, B1); BAR;
    LDA(At, 0, 1); STAGE_A(SA(0, 0), 0, t2);
    BAR; WAIT_L(0); MMA(1, 0, At, B0); BAR; SCHED;
    STAGE_B(SB(0, 1), 1, t2);
    WAIT_V(6); BAR; MMA(1, 1, At, B1); BAR;
    LDB(B0, 1, 0); SCHED; LDA(At, 1, 0); STAGE_A(SA(0, 1), 1, t2);
    WAIT_L(8); BAR; WAIT_L(0); MMA(0, 0, At, B0); BAR; SCHED;
    LDB(B1, 1, 1); STAGE_B(SB(1, 0), 0, t3);
    BAR; WAIT_L(0); MMA(0, 1, At, B1); BAR;
    LDA(At, 1, 1); STAGE_A(SA(1, 0), 0, t3);
    BAR; WAIT_L(0); MMA(1, 0, At, B0); BAR; SCHED;
    STAGE_B(SB(1, 1), 1, t3);
    WAIT_V(6); BAR; MMA(1, 1, At, B1); BAR;
  }
  WAIT_V(0);
  if (wr == 0) BAR;
#undef SA
#undef SB
#undef STAGE_A
#undef STAGE_B
#undef LDA
#undef LDB
#undef MMA
  if (PROBE_MASK != 0 && p.dry && MODE != M_RES) { __syncthreads(); return; }
  int te = tid; asm volatile("" : "+v"(te));
  const int ewr = te >> 8, ewc = (te >> 6) & 3, efr = te & 15, efq = (te & 63) >> 4;
  if (MODE == M_RES) {
    int mi; (void)xrow(p, pm * 256, mi);
    const float* gate = g.mod + mi * 6144 + g.msel * 1024;
    f32x4 gv[4], bb[4];
#pragma unroll
    for (int k = 0; k < 4; ++k) {
      const int col = pn * 256 + (k >> 1) * 128 + ewc * 32 + (k & 1) * 16 + efq * 4;
      gv[k] = *(const f32x4*)(gate + col);
      bb[k] = g.bias ? *(const f32x4*)(g.bias + col) : (f32x4){0.f, 0.f, 0.f, 0.f};
    }
#pragma unroll
    for (int ai = 0; ai < 2; ++ai)
#pragma unroll
      for (int mh = 0; mh < 4; mh += 2) {
        f32x4 xv[2][4]; float* xps[2];
#pragma unroll
        for (int m = 0; m < 2; ++m) {
          int mi2; const int rw = pm * 256 + ai * 128 + ewr * 64 + (mh + m) * 16 + efr;
          xps[m] = xrow(p, rw, mi2);
          const float* xs = p.xin ? xrow_src(p, rw, mi2) : xps[m];
#pragma unroll
          for (int k = 0; k < 4; ++k) xv[m][k] = *(const f32x4*)(xs + pn * 256 + (k >> 1) * 128 + ewc * 32 + (k & 1) * 16 + efq * 4);
        }
#pragma unroll
        for (int m = 0; m < 2; ++m)
#pragma unroll
          for (int k = 0; k < 4; ++k) {
            const f32x4 x = xv[m][k] + gv[k] * (acc[ai][k >> 1][mh + m][k & 1] + bb[k]);
            if (!p.dry) *(f32x4*)(xps[m] + pn * 256 + (k >> 1) * 128 + ewc * 32 + (k & 1) * 16 + efq * 4) = x;
          }
      }
    __syncthreads();
  } else if (MODE == M_LORA) {
    f32x4 cvs[4];
#pragma unroll
    for (int k = 0; k < 4; ++k) { const int col = pn * 256 + (k >> 1) * 128 + ewc * 32 + (k & 1) * 16 + efq * 4;
      cvs[k] = (f32x4){0.f, 0.f, 0.f, 0.f};
      if (col < 1024) cvs[k] = *(const f32x4*)(g.e0 + col); else if (col < 2048) cvs[k] = *(const f32x4*)(g.e1 + col - 1024); }
#pragma unroll
    for (int bj = 0; bj < 2; ++bj)
#pragma unroll
      for (int n = 0; n < 2; ++n) {
        const int col = pn * 256 + bj * 128 + ewc * 32 + n * 16 + efq * 4;
        const f32x4 cv = cvs[bj * 2 + n];
#pragma unroll
        for (int ai = 0; ai < 2; ++ai)
#pragma unroll
          for (int m = 0; m < 4; ++m) {
            const int row = pm * 256 + ai * 128 + ewr * 64 + m * 16 + efr;
            f32x4 a = acc[ai][bj][m][n];
            float o[4];
#pragma unroll
            for (int j = 0; j < 4; ++j) {
              float v = a[j] + cv[j];
              if (col < 1024) o[j] = 0.6065306597126334f * __builtin_amdgcn_rcpf(1.f + __expf(-v));
              else if (col < 2048) o[j] = __builtin_amdgcn_rcpf(1.f + __expf(-v));
              else o[j] = v;
            }
            uint2 pk = {pack2(o[0], o[1]), pack2(o[2], o[3])};
            *(uint2*)(g.o0 + (size_t)row * LOW + col) = pk;
          }
      }
    __syncthreads();
  } else {
    __syncthreads();
    bf16_t* T = shm;
#pragma unroll
    for (int bj = 0; bj < 2; ++bj)
#pragma unroll
      for (int n = 0; n < 2; ++n) {
        const int col = bj * 128 + ewc * 32 + n * 16 + efq * 4;
        f32x4 bv = {0.f, 0.f, 0.f, 0.f};
        if (MODE == M_ODD) bv = *(const f32x4*)(g.bias + pn * 256 + col);
#pragma unroll
        for (int ai = 0; ai < 2; ++ai)
#pragma unroll
          for (int m = 0; m < 4; ++m) {
            const int row = ai * 128 + ewr * 64 + m * 16 + efr;
            f32x4 a = acc[ai][bj][m][n] + bv;
            uint2 pk = {pack2(a[0], a[1]), pack2(a[2], a[3])};
            *(uint2*)(T + row * TP + col) = pk;
          }
      }
    float wg[3][8], bg[8], wv[3][8], bvv[8];
    if (MODE == M_FFN) {
      const int gc_ = pn * 128 + (te & 15) * 8;
#pragma unroll
      for (int e = 0; e < 8; ++e) {
#pragma unroll
        for (int q = 0; q < 3; ++q) { wg[q][e] = g.e0[q * FF2 + gc_ + e]; wv[q][e] = g.e0[q * FF2 + FF + gc_ + e]; }
        bg[e] = g.e1[gc_ + e]; bvv[e] = g.e1[FF + gc_ + e];
      }
    }
    __syncthreads();
    if (MODE == M_FFN) {
      const int cg8 = (te & 15) * 8, rsub = te >> 4;
      const int gc = pn * 128 + cg8;
      for (int i = HALO + rsub; i < HALO + S; i += 32) {
        const int grow = pm * S + (i - HALO);
        if (grow >= g.M) break;
        uint4 gp = *(const uint4*)(T + (i - 1) * TP + cg8), gcn = *(const uint4*)(T + i * TP + cg8), gn = *(const uint4*)(T + (i + 1) * TP + cg8);
        uint4 vp = *(const uint4*)(T + (i - 1) * TP + 128 + cg8), vc = *(const uint4*)(T + i * TP + 128 + cg8), vn = *(const uint4*)(T + (i + 1) * TP + 128 + cg8);
        const uint4 zz = {0u, 0u, 0u, 0u};
        const int sq = grow - (grow / TPB) * TPB;
        if (sq == 0 || sq == CTXL) { gp = zz; vp = zz; }
        if (sq == CTXL - 1 || sq == TPB - 1) { gn = zz; vn = zz; }
        const unsigned* gpa = (const unsigned*)&gp; const unsigned* gca = (const unsigned*)&gcn; const unsigned* gna = (const unsigned*)&gn;
        const unsigned* vpa = (const unsigned*)&vp; const unsigned* vca = (const unsigned*)&vc; const unsigned* vna = (const unsigned*)&vn;
        float o[8];
#pragma unroll
        for (int e = 0; e < 8; ++e) {
          const int w = e >> 1;
          const float a0 = (e & 1) ? hi16(gpa[w]) : lo16(gpa[w]), a1 = (e & 1) ? hi16(gca[w]) : lo16(gca[w]), a2 = (e & 1) ? hi16(gna[w]) : lo16(gna[w]);
          const float b0 = (e & 1) ? hi16(vpa[w]) : lo16(vpa[w]), b1 = (e & 1) ? hi16(vca[w]) : lo16(vca[w]), b2 = (e & 1) ? hi16(vna[w]) : lo16(vna[w]);
          const float gg = wg[0][e] * a0 + (wg[1][e] * a1 + (wg[2][e] * a2 + bg[e]));
          const float vv = wv[0][e] * b0 + (wv[1][e] * b1 + (wv[2][e] * b2 + bvv[e]));
          o[e] = gg * __builtin_amdgcn_rcpf(1.f + __expf(-gg)) * vv;
        }
        uint4 pk = {pack2(o[0], o[1]), pack2(o[2], o[3]), pack2(o[4], o[5]), pack2(o[6], o[7])};
        *(uint4*)(g.o0 + (size_t)grow * FF + gc) = pk;
      }
    } else if (MODE == M_EVEN) {
      const int cg8 = (te & 31) * 8, rsub = te >> 5;
      const int col = pn * 256 + cg8;
      if (col < EVEN_IN) {
        float mp[8], mn[8];
#pragma unroll
        for (int e = 0; e < 8; ++e) { mp[e] = col < A_IN ? g.e0[col + e] : 0.f; mn[e] = col < A_IN ? g.e1[col + e] : 0.f; }
        for (int i = HALO + rsub; i < HALO + S; i += 16) {
          const int grow = pm * S + (i - HALO);
          if (grow >= g.M) break;
          const int sq = grow - (grow / TPB) * TPB;
          const float pv = (sq == 0 || sq == CTXL) ? 0.f : 1.f, nv = (sq == CTXL - 1 || sq == TPB - 1) ? 0.f : 1.f;
          uint4 tp = *(const uint4*)(T + (i - 1) * TP + cg8), tc = *(const uint4*)(T + i * TP + cg8), tn = *(const uint4*)(T + (i + 1) * TP + cg8);
          const unsigned* tpa = (const unsigned*)&tp; const unsigned* tca = (const unsigned*)&tc; const unsigned* tna = (const unsigned*)&tn;
          float o[8];
#pragma unroll
          for (int e = 0; e < 8; ++e) {
            const int w = e >> 1;
            float a0 = ((e & 1) ? hi16(tpa[w]) : lo16(tpa[w])) * pv, a1 = (e & 1) ? hi16(tca[w]) : lo16(tca[w]), a2 = ((e & 1) ? hi16(tna[w]) : lo16(tna[w])) * nv;
            float z = a1 + mp[e] * (a0 - a1) + mn[e] * (a2 - a1);
            if (col >= 1536 && col < 1664) z = 1.f - 2.f / (1.f + __expf(2.f * z));
            else if (col >= 1792 && col < 1920) z = sigmoidf_(z);
            o[e] = z;
          }
          uint4 pk = {pack2(o[0], o[1]), pack2(o[2], o[3]), pack2(o[4], o[5]), pack2(o[6], o[7])};
          if (col >= 1536 && col < 1920) *(uint4*)(g.o1 + (size_t)grow * LW + (col - 1536)) = pk;
          else *(uint4*)(g.o0 + (size_t)grow * PW + col) = pk;
        }
      }
    } else {
      const int rgs = te & 3, csub = te >> 2;
#pragma unroll 1
      for (int cp = 0; cp < 2; ++cp) {
        const int cl = cp * 128 + csub, col = pn * 256 + cl;
        const float w0 = g.e0[col], w1 = g.e0[HY3 + col], w2 = g.e0[2 * HY3 + col], cb = g.e1[col];
#pragma unroll 1
        for (int rg = rgs; rg < 31; rg += 4) {
          const int grow0 = pm * S + rg * 8;
          if (grow0 >= g.M) break;
          const int i0 = HALO + rg * 8;
          float tv[10];
#pragma unroll
          for (int q = 0; q < 10; ++q) tv[q] = bf2f(T[(i0 - 1 + q) * TP + cl]);
          const int b = grow0 / TPB, s0 = grow0 - b * TPB;
          if (s0 == 0 || s0 == CTXL) tv[0] = 0.f;
          if (s0 + 8 == CTXL || s0 + 8 == TPB) tv[9] = 0.f;
          float o[8];
#pragma unroll
          for (int q = 0; q < 8; ++q) o[q] = w0 * tv[q] + (w1 * tv[q + 1] + (w2 * tv[q + 2] + cb));
          uint4 pk = {pack2(o[0], o[1]), pack2(o[2], o[3]), pack2(o[4], o[5]), pack2(o[6], o[7])};
          *(uint4*)(g.o0 + ((size_t)(b * HY3 + col)) * TPB + s0) = pk;
        }
      }
    }
    __syncthreads();
  }
}

template <int MODE>
DI void gemm_phase(const DevP& p, bf16_t* shm, const GemmCall& g, int nM, int nN, const int tid_, const int bid_) {
  if (g.skipctx) nM = 128;
  const int total = nM * nN, share = (total + 7) >> 3, xcd = bid_ & 7, lb = bid_ >> 3, nlb = (int)gridDim.x >> 3;
  const int lend = min((xcd + 1) * share, total), nig = 8 * nN;
  for (int L = xcd * share + lb; L < lend; L += nlb) {
    const int gid = L / nig, fm = gid * 8, gsz = min(nM - fm, 8), wi = L - gid * nig;
    const int pmr = fm + wi % gsz;
    gemm_tile<MODE>(p, shm, g, g.skipctx ? (pmr >> 4) * 17 + 1 + (pmr & 15) : pmr, wi / gsz, tid_, bid_);
  }
}

DI void wconv(const float* src, int K, int N, bf16_t* dst, float* sh, const int tid_, const int bid_, const int nwk_) {
  const int tid = tid_, tk = K / 64, tn = N / 64, ntile = tk * tn;
  const int kk0 = tid >> 4, nn4 = (tid & 15) * 4;
  int it = bid_;
  f32x4 v0 = {0.f, 0.f, 0.f, 0.f}, v1 = v0;
  if (it < ntile) { const int k0 = (it / tn) * 64, n0 = (it % tn) * 64;
    v0 = ld_nt16(src + (size_t)(k0 + kk0) * N + n0 + nn4); v1 = ld_nt16(src + (size_t)(k0 + kk0 + 32) * N + n0 + nn4); }
  while (it < ntile) {
    const int k0 = (it / tn) * 64, n0 = (it % tn) * 64;
    sh[kk0 * 65 + nn4] = v0[0]; sh[kk0 * 65 + nn4 + 1] = v0[1]; sh[kk0 * 65 + nn4 + 2] = v0[2]; sh[kk0 * 65 + nn4 + 3] = v0[3];
    sh[(kk0 + 32) * 65 + nn4] = v1[0]; sh[(kk0 + 32) * 65 + nn4 + 1] = v1[1]; sh[(kk0 + 32) * 65 + nn4 + 2] = v1[2]; sh[(kk0 + 32) * 65 + nn4 + 3] = v1[3];
    __syncthreads();
    const int itn = it + nwk_;
    if (itn < ntile) { const int k1 = (itn / tn) * 64, n1 = (itn % tn) * 64;
      v0 = ld_nt16(src + (size_t)(k1 + kk0) * N + n1 + nn4); v1 = ld_nt16(src + (size_t)(k1 + kk0 + 32) * N + n1 + nn4); }
    { const int nn = tid >> 3, kp = (tid & 7) * 8;
      uint4 pk = {pack2(sh[kp * 65 + nn], sh[(kp + 1) * 65 + nn]), pack2(sh[(kp + 2) * 65 + nn], sh[(kp + 3) * 65 + nn]),
                  pack2(sh[(kp + 4) * 65 + nn], sh[(kp + 5) * 65 + nn]), pack2(sh[(kp + 6) * 65 + nn], sh[(kp + 7) * 65 + nn])};
      *(uint4*)(dst + (size_t)(n0 + nn) * K + k0 + kp) = pk; }
    __syncthreads();
    it = itn;
  }
}

DI void norm_phase(const DevP& p, int layer, int which, const int tid_, const int bid_) {
  const float* gw = pin(p, which ? I_N2G : I_N1G) + layer * DM;
  const float* mod = (const float*)(p.ws + OFF_MOD) + (size_t)layer * 9 * 6144;
  bf16_t* H = (bf16_t*)(p.ws + OFF_H);
  const int lane = tid_ & 63, gw_id = bid_ * 8 + (tid_ >> 6), nw = gridDim.x * 8;
  for (int row0 = gw_id; row0 < MROWS; row0 += 2 * nw) {
    const int row1 = row0 + nw; const bool has1 = row1 < MROWS;
    int mi0, mi1; const float* xp0 = xrow_src(p, row0, mi0); const float* xp1 = xrow_src(p, has1 ? row1 : row0, mi1);
    f32x4 v0[4], v1[4]; float ss0 = 0.f, ss1 = 0.f;
#pragma unroll
    for (int q = 0; q < 4; ++q) { v0[q] = *(const f32x4*)(xp0 + q * 256 + lane * 4); v1[q] = *(const f32x4*)(xp1 + q * 256 + lane * 4); }
#pragma unroll
    for (int q = 0; q < 4; ++q) { ss0 += v0[q][0] * v0[q][0] + v0[q][1] * v0[q][1] + v0[q][2] * v0[q][2] + v0[q][3] * v0[q][3];
                                  ss1 += v1[q][0] * v1[q][0] + v1[q][1] * v1[q][1] + v1[q][2] * v1[q][2] + v1[q][3] * v1[q][3]; }
    ss0 = wave_sum(ss0, lane); ss1 = wave_sum(ss1, lane);
    const float rstd0 = rsqrtf(ss0 * (1.f / DM) + 1e-6f), rstd1 = rsqrtf(ss1 * (1.f / DM) + 1e-6f);
    const float* sh0 = mod + mi0 * 6144 + (which ? 3 : 0) * 1024; const float* sh1 = mod + mi1 * 6144 + (which ? 3 : 0) * 1024;
#pragma unroll
    for (int q = 0; q < 4; ++q) {
      const int c = q * 256 + lane * 4;
      const f32x4 gg = *(const f32x4*)(gw + c);
      { const f32x4 s1 = *(const f32x4*)(sh0 + 1024 + c), s0 = *(const f32x4*)(sh0 + c); float o[4];
#pragma unroll
        for (int j = 0; j < 4; ++j) o[j] = v0[q][j] * rstd0 * gg[j] * (1.f + s1[j]) + s0[j];
        uint2 pk = {pack2(o[0], o[1]), pack2(o[2], o[3])};
        *(uint2*)(H + (size_t)row0 * DM + c) = pk; }
      if (has1) { const f32x4 s1 = *(const f32x4*)(sh1 + 1024 + c), s0 = *(const f32x4*)(sh1 + c); float o[4];
#pragma unroll
        for (int j = 0; j < 4; ++j) o[j] = v1[q][j] * rstd1 * gg[j] * (1.f + s1[j]) + s0[j];
        uint2 pk = {pack2(o[0], o[1]), pack2(o[2], o[3])};
        *(uint2*)(H + (size_t)row1 * DM + c) = pk; }
    }
  }
}

DI void phase_setup(const DevP& p, char* shmc, const int tid_, const int bid_) {
  const int tid = tid_;
  const size_t gtid = (size_t)bid_ * NTHR + tid, gn = (size_t)gridDim.x * NTHR;
  { float2* tw = (float2*)(p.ws + OFF_TW);
    for (size_t i = gtid; i < 4096; i += gn) { float sn, cs; sincospif((float)i / 4096.f, &sn, &cs); tw[i] = make_float2(cs, -sn); }
    float2* rp = (float2*)(p.ws + OFF_ROPE);
    for (size_t i = gtid; i < 4096 * 32; i += gn) { int t = (int)(i >> 5), f = (int)(i & 31); float pos = (f < 16) ? (float)(t / 64) : (float)(t % 64);
      float inv = powf(10000.f, -(float)(f & 15) / 16.f); float a = pos * inv; rp[i] = make_float2(cosf(a), sinf(a)); } }
  { float* sc = (float*)shmc;
    float* red = sc + 9 * 1024;
    for (int i = tid; i < 9 * 1024; i += NTHR) { int mi = i >> 10, k = i & 1023; float v = (mi < 8) ? pin(p, I_C)[mi * 1024 + k] : pin(p, I_CCTX)[k]; sc[i] = siluf_(v); }
    __syncthreads();
    float* mod = (float*)(p.ws + OFF_MOD);
    float* red2 = sc + 9 * 1024;
    for (int it = bid_; it < 4 * 48; it += gridDim.x) {
      const int l = it / 48, c0 = (it % 48) * 128, n4 = (tid & 31) * 4, ks = tid >> 5;
      const float* w = pin(p, I_ADAW) + (size_t)l * 1024 * 6144 + c0 + n4;
      f32x4 a[9];
#pragma unroll
      for (int q = 0; q < 9; ++q) a[q] = (f32x4){0.f, 0.f, 0.f, 0.f};
#pragma unroll 8
      for (int k = ks * 64; k < ks * 64 + 64; ++k) { const f32x4 wv = *(const f32x4*)(w + (size_t)k * 6144);
#pragma unroll
        for (int q = 0; q < 9; ++q) a[q] += sc[q * 1024 + k] * wv; }
#pragma unroll
      for (int q = 0; q < 9; ++q) *(f32x4*)(red2 + (ks * 9 + q) * 128 + n4) = a[q];
      __syncthreads();
      for (int o = tid; o < 9 * 128; o += NTHR) { const int q = o >> 7, c = o & 127; float sum = 0.f;
#pragma unroll
        for (int k2 = 0; k2 < 16; ++k2) sum += red2[(k2 * 9 + q) * 128 + c];
        mod[((size_t)l * 9 + q) * 6144 + c0 + c] = sum + pin(p, I_ADAB)[l * 6144 + c0 + c]; }
      __syncthreads();
    }
  }
  { float* scr = (float*)shmc + (tid >> 6) * 128;
    const int lane = tid & 63, gw_id = bid_ * 8 + (tid >> 6), nw = gridDim.x * 8;
    for (int r = gw_id; r < 2 * (4096 + 256); r += nw) {
      const int j = r / 4352, rr = r % 4352, type = rr >= 4096, i = type ? rr - 4096 : rr, n = type ? 256 : 4096;
      const float tpos = (float)i / (float)(n - 1), ang = 6.283185307179586f * (float)i / (float)n;
      float z = 0.f;
      if (lane == 0) z = tpos;
      else if (lane <= 32) { int e = (lane - 1) & 15; float f = 1e-4f + (float)e * ((15.f - 1e-4f) / 15.f); z = (lane <= 16) ? cosf(f * ang) : -sinf(f * ang); }
      scr[lane] = z;
      __builtin_amdgcn_wave_barrier();
      const float fr = pin(p, I_OFREQ)[j * 64 + lane];
      float a = pin(p, I_OFB1)[j * 64 + lane];
      { const float* W = pin(p, I_OFW1) + (size_t)j * 33 * 64 + lane; float wr_[33];
#pragma unroll
        for (int e = 0; e < 33; ++e) wr_[e] = W[e * 64];
        __builtin_amdgcn_sched_barrier(0);
#pragma unroll
        for (int e = 0; e < 33; ++e) a += scr[e] * wr_[e]; }
      float h = sinf(fr * a);
      scr[64 + lane] = h;
      __builtin_amdgcn_wave_barrier();
      a = pin(p, I_OFB2)[j * 64 + lane];
      { const float* W = pin(p, I_OFW2) + (size_t)j * 64 * 64 + lane;
#pragma unroll
        for (int e0 = 0; e0 < 64; e0 += 32) { float wr_[32];
#pragma unroll
          for (int e = 0; e < 32; ++e) wr_[e] = W[(e0 + e) * 64];
          __builtin_amdgcn_sched_barrier(0);
#pragma unroll
          for (int e = 0; e < 32; ++e) a += scr[64 + e0 + e] * wr_[e]; } }
      h = sinf(fr * a);
      __builtin_amdgcn_wave_barrier();
      scr[lane] = h;
      __builtin_amdgcn_wave_barrier();
      a = pin(p, I_OFB3)[j * 64 + lane];
      { const float* W = pin(p, I_OFW3) + (size_t)j * 64 * 64 + lane;
#pragma unroll
        for (int e0 = 0; e0 < 64; e0 += 32) { float wr_[32];
#pragma unroll
          for (int e = 0; e < 32; ++e) wr_[e] = W[(e0 + e) * 64];
          __builtin_amdgcn_sched_barrier(0);
#pragma unroll
          for (int e = 0; e < 32; ++e) a += scr[e0 + e] * wr_[e]; } }
      h = sinf(fr * a);
      float* dst = type ? (float*)(p.ws + OFF_HDNC) + ((size_t)j * 256 + i) * 64 : (float*)(p.ws + OFF_HDNL) + ((size_t)j * 4096 + i) * 64;
      dst[lane] = h;
      __builtin_amdgcn_wave_barrier();
    }
  }
}

DI void phase_taps(const DevP& p, int j, char* shmc, const int tid_, const int bid_, const int nwk_);
DI void convert_layer(const DevP& p, int layer, bf16_t* wt, char* shmc, const int tid_, const int bid_, const int nwk_, const int parts) {
  float* sh = (float*)shmc;
  const int j = layer >> 1;
  if ((layer & 1) == 0) { if (parts & 1) {
    wconv(pin(p, I_EWIN) + (size_t)j * DM * EVEN_IN, DM, EVEN_IN, wt + WT_WIN, sh, tid_, bid_, nwk_);
    {
      unsigned* z = (unsigned*)(wt + WT_WIN + (size_t)EVEN_IN * DM);
      for (size_t i = (size_t)bid_ * NTHR + tid_; i < (size_t)128 * DM / 2; i += (size_t)nwk_ * NTHR) z[i] = 0u; }
    wconv(pin(p, I_EWOUT) + (size_t)j * DM * DM, DM, DM, wt + WT_WOUT, sh, tid_, bid_, nwk_);
    {
      bf16_t* lb = wt + WT_LORA;
      for (size_t i = (size_t)bid_ * NTHR + tid_; i < (size_t)LOW * LW; i += (size_t)nwk_ * NTHR) {
        const int n = (int)(i / LW), k = (int)(i % LW); float v = 0.f;
        if (n < 512) { if (k < 64) v = pin(p, I_EW2)[(((size_t)j * 2 + 0) * 64 + k) * 512 + n]; }
        else if (n < 1024) { if (k >= 64 && k < 128) v = pin(p, I_EW2)[(((size_t)j * 2 + 1) * 64 + (k - 64)) * 512 + (n - 512)]; }
        else if (n < 1536) { if (k >= 128 && k < 192) v = pin(p, I_EA2)[(((size_t)j * 2 + 0) * 64 + (k - 128)) * 512 + (n - 1024)]; }
        else if (n < 2048) { if (k >= 192 && k < 256) v = pin(p, I_EA2)[(((size_t)j * 2 + 1) * 64 + (k - 192)) * 512 + (n - 1536)]; }
        else { if (k >= 256) v = pin(p, I_EG2)[((size_t)j * 128 + (k - 256)) * 512 + (n - 2048)]; }
        lb[i] = f2bf(v);
      } }
  } } else {
    if (parts & 1) {
    wconv(pin(p, I_OWIN) + (size_t)j * DM * HY3, DM, HY3, wt + WT_WIN, sh, tid_, bid_, nwk_);
    wconv(pin(p, I_OWOUT) + (size_t)j * DM * DM, DM, DM, wt + WT_WOUT, sh, tid_, bid_, nwk_); }
    if (parts & 2) phase_taps(p, j, shmc, tid_, bid_, nwk_);
  }
  if (parts & 4) {
  wconv(pin(p, I_FUP) + (size_t)layer * DM * FF2, DM, FF2, wt + WT_WUP, sh, tid_, bid_, nwk_);
  wconv(pin(p, I_FDN) + (size_t)layer * FF * DM, FF, DM, wt + WT_WDN, sh, tid_, bid_, nwk_); }
}
DI void phase_start(const DevP& p, int layer, char* shmc, const int tid_, const int bid_) {
  norm_phase(p, layer, 0, tid_, bid_);
  if (layer == 0) convert_layer(p, 0, (bf16_t*)(p.ws + OFF_WT), shmc, tid_, bid_, (int)gridDim.x, 7);
}

DI void phase_qkprep(const DevP& p, int j, const int tid_, const int bid_) {
  bf16_t* P = (bf16_t*)(p.ws + OFF_BIG);
  float* KN = (float*)(p.ws + OFF_KN);
  const float2* rope = (const float2*)(p.ws + OFF_ROPE);
  const int l16 = tid_ & 15;
  const int g0 = (bid_ * NTHR + tid_) >> 4, gs = ((int)gridDim.x * NTHR) >> 4;
  const float* gq = pin(p, I_EQN) + j * 64; const float* gk = pin(p, I_EKN) + j * 64;
  const float gq0 = gq[2 * l16], gq1 = gq[2 * l16 + 1], gq2 = gq[32 + 2 * l16], gq3 = gq[33 + 2 * l16];
  const float gk0 = gk[2 * l16], gk1 = gk[2 * l16 + 1], gk2 = gk[32 + 2 * l16], gk3 = gk[33 + 2 * l16];
  for (int row = g0; row < MROWS; row += gs) {
    const int s = row % TPB, t = s >= CTXL ? s - CTXL : 0;
    bf16_t* base = P + (size_t)row * PW;
    unsigned u0[10], u1[10]; uint2 uk[8]; f32x4 kkw[8];
#pragma unroll
    for (int q = 0; q < 10; ++q) { u0[q] = *(const unsigned*)(base + A_IN + q * 64 + 2 * l16); u1[q] = *(const unsigned*)(base + A_IN + q * 64 + 32 + 2 * l16); }
#pragma unroll
    for (int h = 0; h < 8; ++h) { uk[h] = *(const uint2*)(base + 512 + h * 64 + 4 * l16); kkw[h] = *(const f32x4*)(pin(p, I_EKK) + j * 512 + h * 64 + 4 * l16); }
    const float2 c0 = rope[t * 32 + 2 * l16], c1 = rope[t * 32 + 2 * l16 + 1];
#pragma unroll
    for (int q = 0; q < 10; ++q) {
      float a0 = lo16(u0[q]), a1 = hi16(u0[q]), b0 = lo16(u1[q]), b1 = hi16(u1[q]);
      const float ss = sum16(a0 * a0 + a1 * a1 + b0 * b0 + b1 * b1);
      const float rstd = rsqrtf(ss * (1.f / 64.f) + 1e-6f);
      a0 = a0 * rstd * (q < 8 ? gq0 : gk0); a1 = a1 * rstd * (q < 8 ? gq1 : gk1); b0 = b0 * rstd * (q < 8 ? gq2 : gk2); b1 = b1 * rstd * (q < 8 ? gq3 : gk3);
      if (s >= CTXL) {
        const float na0 = a0 * c0.x - b0 * c0.y, nb0 = a0 * c0.y + b0 * c0.x, na1 = a1 * c1.x - b1 * c1.y, nb1 = a1 * c1.y + b1 * c1.x;
        a0 = na0; b0 = nb0; a1 = na1; b1 = nb1;
      }
      *(unsigned*)(base + A_IN + q * 64 + 2 * l16) = pack2(a0, a1); *(unsigned*)(base + A_IN + q * 64 + 32 + 2 * l16) = pack2(b0, b1);
    }
#pragma unroll
    for (int h = 0; h < 8; ++h) {
      const float a0 = lo16(uk[h].x) * kkw[h][0], a1 = hi16(uk[h].x) * kkw[h][1], a2 = lo16(uk[h].y) * kkw[h][2], a3 = hi16(uk[h].y) * kkw[h][3];
      const float ss = sum16(a0 * a0 + a1 * a1 + a2 * a2 + a3 * a3);
      if (l16 == 0) KN[(size_t)row * 8 + h] = 1.f / fmaxf(sqrtf(ss), 1e-12f);
    }
  }
}

template <int CTRL> DI float dppf(float x) { return __builtin_bit_cast(float, __builtin_amdgcn_update_dpp(0, __builtin_bit_cast(int, x), CTRL, 0xf, 0xf, false)); }
DI void phase_scan(const DevP& p, int j, char* shmc, const int tid_, const int bid_) {
  const bf16_t* P = (const bf16_t*)(p.ws + OFF_BIG);
  const bf16_t* LO = (const bf16_t*)(p.ws + OFF_LO);
  const float* KN = (const float*)(p.ws + OFF_KN);
  bf16_t* Y = (bf16_t*)(p.ws + OFF_H);
  const int tid = tid_, l16 = tid & 15, rloc = tid >> 4;
  constexpr int TT = 32, STEPF = 5 * 64 + 32 + 4;
  constexpr int NSTEP = CTXL + SEQ, NCH = NSTEP / TT;
  float* buf = (float*)shmc;
  float* ybuf = buf + 2 * TT * STEPF;
  for (int u = bid_; u < 256; u += gridDim.x) {
    const int chain = u >> 1, half = u & 1, d = chain >> 6, b = (chain >> 3) & 7, h = chain & 7;
    f32x4 kkw = *(const f32x4*)(pin(p, I_EKK) + j * 512 + h * 64 + 4 * l16), kaw = *(const f32x4*)(pin(p, I_EKA) + j * 512 + h * 64 + 4 * l16);
    f32x4 S = {0.f, 0.f, 0.f, 0.f};
    float sa = 0.f;
    uint2 gr, gk, ge, ga, gv, gk2; float gkn, gkn2;
    auto rowof = [&](int g) -> int {
      g = g > NSTEP - 1 ? NSTEP - 1 : g;
      const int seg = g >= CTXL, st = seg ? g - CTXL : g, n = seg ? SEQ : CTXL, t = d ? (n - 1 - st) : st;
      return b * TPB + (seg ? CTXL + t : t);
    };
    auto gload = [&](int c) {
      const int row = rowof(c * TT + rloc), row2 = rowof(c * TT + rloc + 1);
      const bf16_t* pr = P + (size_t)row * PW + h * 64 + 4 * l16;
      gr = *(const uint2*)pr; gk = *(const uint2*)(pr + 512);
      gk2 = *(const uint2*)(P + (size_t)row2 * PW + 512 + h * 64 + 4 * l16);
      const bf16_t* lo = LO + (size_t)row * LOW + d * 512 + h * 64 + 4 * l16;
      ge = *(const uint2*)lo; ga = *(const uint2*)(lo + 1024);
      gkn = KN[(size_t)row * 8 + h]; gkn2 = KN[(size_t)row2 * 8 + h];
      if (l16 < 8) gv = *(const uint2*)(P + (size_t)row * PW + 1024 + h * 64 + half * 32 + 4 * l16);
    };
    auto lstore = [&](int bi) {
      float* dst = buf + ((size_t)bi * TT + rloc) * STEPF;
      float k4[4] = {lo16(gk.x), hi16(gk.x), lo16(gk.y), hi16(gk.y)}, e4[4] = {lo16(ge.x), hi16(ge.x), lo16(ge.y), hi16(ge.y)};
      float a4[4] = {lo16(ga.x), hi16(ga.x), lo16(ga.y), hi16(ga.y)}, n4[4] = {lo16(gk2.x), hi16(gk2.x), lo16(gk2.y), hi16(gk2.y)};
      f32x4 w, q, kka, kd, r = {lo16(gr.x), hi16(gr.x), lo16(gr.y), hi16(gr.y)};
      float c1 = 0.f, c2 = 0.f;
#pragma unroll
      for (int e = 0; e < 4; ++e) {
        w[e] = __expf(-e4[e]); const float kk = k4[e] * kkw[e] * gkn, kkn = n4[e] * kkw[e] * gkn2;
        kka[e] = kk * a4[e]; kd[e] = k4[e] * (1.f + (a4[e] - 1.f) * kaw[e]); q[e] = w[e] * kkn;
        c1 += kka[e] * kkn; c2 += kd[e] * kkn;
      }
      c1 = dpp_sum16(c1); c2 = dpp_sum16(c2);
      *(f32x4*)(dst + 0 + 4 * l16) = q; *(f32x4*)(dst + 64 + 4 * l16) = kka; *(f32x4*)(dst + 128 + 4 * l16) = kd; *(f32x4*)(dst + 192 + 4 * l16) = w; *(f32x4*)(dst + 256 + 4 * l16) = r;
      if (l16 < 8) { f32x4 v = {lo16(gv.x), hi16(gv.x), lo16(gv.y), hi16(gv.y)}; *(f32x4*)(dst + 320 + 4 * l16) = v; }
      if (l16 == 0) { dst[352] = c1; dst[353] = c2; }
    };
    __syncthreads();
    gload(0); lstore(0);
    __syncthreads();
    for (int c = 0; c < NCH; ++c) {
      if (c + 1 < NCH) gload(c + 1);
      const float* sb = buf + (size_t)(c & 1) * TT * STEPF;
      float* yb = ybuf + (c & 1) * TT * 32;
      f32x4 Lq[3], Lka[3], Lkd[3], Lw[3], Lr[3]; float Lv[3]; float2 Lc[3];
#define SCAN_LD(slot, st) do { const float* q_ = sb + (st) * STEPF; \
        Lq[slot] = *(const f32x4*)(q_ + 4 * l16); Lka[slot] = *(const f32x4*)(q_ + 64 + 4 * l16); Lkd[slot] = *(const f32x4*)(q_ + 128 + 4 * l16); \
        Lw[slot] = *(const f32x4*)(q_ + 192 + 4 * l16); Lr[slot] = *(const f32x4*)(q_ + 256 + 4 * l16); Lv[slot] = q_[320 + rloc]; Lc[slot] = *(const float2*)(q_ + 352); } while (0)
      SCAN_LD(0, 0); SCAN_LD(1, 1);
      float yp[16];
#pragma unroll
      for (int st = 0; st < TT; ++st) {
        if (st + 2 < TT) SCAN_LD((st + 2) % 3, st + 2);
        __builtin_amdgcn_sched_barrier(0);
        { const int sl_ = st % 3;
          const f32x4 qq = Lq[sl_], kka = Lka[sl_], kd = Lkd[sl_], w = Lw[sl_], r = Lr[sl_]; const float v = Lv[sl_]; const float2 cc = Lc[sl_];
          float pd = S[0] * qq[0] + S[1] * qq[1] + S[2] * qq[2] + S[3] * qq[3];
          pd = dpp_sum16(pd);
#pragma unroll
          for (int e = 0; e < 4; ++e) S[e] = S[e] * w[e] + sa * kka[e] + v * kd[e];
          sa = -pd - sa * cc.x - v * cc.y;
          yp[st & 15] = S[0] * r[0] + S[1] * r[1] + S[2] * r[2] + S[3] * r[3];
        }
        if ((st & 15) == 15) {
          const bool h8 = l16 & 8, h4 = l16 & 4, h2 = l16 & 2, h1 = l16 & 1;
#pragma unroll
          for (int k = 0; k < 8; ++k) { const float a = yp[k], bq = yp[k + 8]; yp[k] = (h8 ? bq : a) + dppf<0x128>(h8 ? a : bq); }
#pragma unroll
          for (int k = 0; k < 4; ++k) { const float a = yp[k], bq = yp[k + 4]; yp[k] = (h4 ? bq : a) + dppf<0x141>(h4 ? a : bq); }
#pragma unroll
          for (int k = 0; k < 2; ++k) { const float a = yp[k], bq = yp[k + 2]; yp[k] = (h2 ? bq : a) + dppf<0x4E>(h2 ? a : bq); }
          { const float a = yp[0], bq = yp[1]; yp[0] = (h1 ? bq : a) + dppf<0xB1>(h1 ? a : bq); }
          yb[((st - 15) + l16) * 32 + rloc] = yp[0];
        }
      }
#undef SCAN_LD
      if (c + 1 < NCH) lstore((c + 1) & 1);
      __syncthreads();
      {
        const int sl = tid >> 4, i2 = (tid & 15) * 2;
        const int row = rowof(c * TT + sl);
        *(unsigned*)(Y + ((size_t)d * MROWS + row) * 512 + h * 64 + half * 32 + i2) = pack2(yb[sl * 32 + i2], yb[sl * 32 + i2 + 1]);
      }
    }
    __syncthreads();
  }
}

DI void phase_attn(const DevP& p, int j, char* shmc, const int tid_, const int bid_) {
  bf16_t* P = (bf16_t*)(p.ws + OFF_BIG);
  constexpr int KP = 72;
  bf16_t* Ks = (bf16_t*)shmc;
  bf16_t* Vs = Ks + 2 * 64 * KP;
  const int tid = tid_, wid = tid >> 6, lane = tid & 63, fr = lane & 15, fq = lane >> 4;
  const int gh = wid & 3, th = wid >> 2;
  const float C2 = 0.125f * 1.4426950408889634f;
  for (int it0 = bid_; it0 < 544; it0 += gridDim.x) {
    const int it = ((int)gridDim.x == 256 && it0 < 512) ? ((it0 & ~255) | ((it0 & 7) << 5) | ((it0 >> 3) & 31)) : it0;
    int b, kvh, qb0, isctx;
    if (it < 512) { b = it >> 6; kvh = (it >> 5) & 1; qb0 = it & 31; isctx = 0; }
    else { int i2 = it - 512; b = i2 >> 2; kvh = (i2 >> 1) & 1; qb0 = i2 & 1; isctx = 1; }
    const int head = kvh * 4 + gh;
    const int tq0 = qb0 * 128 + th * 64;
    const int rowbase = b * TPB + (isctx ? 0 : CTXL);
    bf16x8 bq[4][2];
#pragma unroll
    for (int qb = 0; qb < 4; ++qb)
#pragma unroll
      for (int ds = 0; ds < 2; ++ds)
        bq[qb][ds] = *(const bf16x8*)(P + (size_t)(rowbase + tq0 + qb * 16 + fr) * PW + A_IN + head * 64 + ds * 32 + fq * 8);
    f32x4 O[4][4];
#pragma unroll
    for (int a = 0; a < 4; ++a)
#pragma unroll
      for (int c = 0; c < 4; ++c) O[a][c] = (f32x4){0.f, 0.f, 0.f, 0.f};
    const float sinkl = pin(p, I_ESINK)[j * 8 + head] * 1.4426950408889634f;
    float mrun[4], lrun[4];
#pragma unroll
    for (int qb = 0; qb < 4; ++qb) { mrun[qb] = sinkl; lrun[qb] = (fq == 0) ? 1.f : 0.f; }
    const int ntile = isctx ? 4 : 10;
    auto tile_row0 = [&](int ti, bool& valid, bool& lat) -> int {
      if (!isctx && ti < 6) { int kb = qb0 * 128 + (ti - 2) * 64; lat = true; valid = (kb >= 0 && kb < SEQ); return b * TPB + CTXL + kb; }
      int ci = isctx ? ti : ti - 6; lat = false; valid = true; return b * TPB + ci * 64;
    };
    uint4 kreg, vreg;
    const int lkey = tid >> 3, ldg = tid & 7;
    auto gl = [&](int ti) { bool v, l; int r0 = tile_row0(ti, v, l); if (v) {
        const bf16_t* src = P + (size_t)(r0 + lkey) * PW + A_IN + 512 + kvh * 64 + ldg * 8;
        kreg = *(const uint4*)src; vreg = *(const uint4*)(src + 128); } };
    auto ls = [&](int ti, int bi) { bool v, l; tile_row0(ti, v, l); if (v) {
        *(uint4*)(Ks + bi * 64 * KP + lkey * KP + ldg * 8) = kreg;
        bf16_t* vt = Vs + bi * 64 * KP; const unsigned* vr = (const unsigned*)&vreg;
#pragma unroll
        for (int e = 0; e < 8; ++e) vt[(ldg * 8 + e) * KP + lkey] = (bf16_t)((e & 1) ? (vr[e >> 1] >> 16) : (vr[e >> 1] & 0xffffu)); } };
    __syncthreads();
    gl(0); ls(0, 0);
    __syncthreads();
    for (int ti = 0; ti < ntile; ++ti) {
      if (ti + 1 < ntile) gl(ti + 1);
      bool valid, lat; const int r0 = tile_row0(ti, valid, lat);
      bool work = valid;
      const int kt0 = lat ? (r0 - (b * TPB + CTXL)) : 0;
      if (lat && (kt0 + 63 < tq0 - 128 || kt0 > tq0 + 63 + 128)) work = false;
      if (work) {
        const bf16_t* kt = Ks + (ti & 1) * 64 * KP; const bf16_t* vt = Vs + (ti & 1) * 64 * KP;
        f32x4 Sx[4][4];
#pragma unroll
        for (int kb = 0; kb < 4; ++kb) {
          bf16x8 ak0 = *(const bf16x8*)(kt + (kb * 16 + fr) * KP + fq * 8), ak1 = *(const bf16x8*)(kt + (kb * 16 + fr) * KP + 32 + fq * 8);
#pragma unroll
          for (int qb = 0; qb < 4; ++qb) {
            f32x4 s = {0.f, 0.f, 0.f, 0.f};
            s = __builtin_amdgcn_mfma_f32_16x16x32_bf16(ak0, bq[qb][0], s, 0, 0, 0);
            s = __builtin_amdgcn_mfma_f32_16x16x32_bf16(ak1, bq[qb][1], s, 0, 0, 0);
            Sx[kb][qb] = s;
          }
        }
        bf16x8 pb[4][2];
#pragma unroll
        for (int qb = 0; qb < 4; ++qb) {
          const int qtok = tq0 + qb * 16 + fr;
          float mx = -3.0e38f;
#pragma unroll
          for (int kb = 0; kb < 4; ++kb)
#pragma unroll
            for (int jj = 0; jj < 4; ++jj) {
              float s = Sx[kb][qb][jj] * C2;
              if (lat) { int dk = kt0 + kb * 16 + fq * 4 + jj - qtok; if (dk > 128 || dk < -128) s = -3.0e38f; }
              Sx[kb][qb][jj] = s; mx = fmaxf(mx, s);
            }
          mx = fmaxf(mx, bperm_xor(mx, lane, 16)); mx = fmaxf(mx, bperm_xor(mx, lane, 32));
          constexpr float THR = 11.0f;
          float alpha = 1.f;
          if (__builtin_amdgcn_ballot_w64(mx > mrun[qb] + THR) != 0ull) {
            const float mnew = fmaxf(mrun[qb], mx);
            alpha = exp2f(mrun[qb] - mnew);
            mrun[qb] = mnew;
#pragma unroll
            for (int db = 0; db < 4; ++db) O[db][qb] *= alpha;
          }
          const float mcur = mrun[qb];
          float ps = 0.f; float pv[4][4];
#pragma unroll
          for (int kb = 0; kb < 4; ++kb)
#pragma unroll
            for (int jj = 0; jj < 4; ++jj) { float e = exp2f(Sx[kb][qb][jj] - mcur); pv[kb][jj] = e; ps += e; }
          lrun[qb] = lrun[qb] * alpha + ps;
#pragma unroll
          for (int ks = 0; ks < 2; ++ks) {
            unsigned w0 = pack2(pv[2 * ks][0], pv[2 * ks][1]), w1 = pack2(pv[2 * ks][2], pv[2 * ks][3]);
            unsigned w2 = pack2(pv[2 * ks + 1][0], pv[2 * ks + 1][1]), w3 = pack2(pv[2 * ks + 1][2], pv[2 * ks + 1][3]);
            uint4 t4 = {w0, w1, w2, w3}; pb[qb][ks] = __builtin_bit_cast(bf16x8, t4);
          }
        }
#pragma unroll
        for (int db = 0; db < 4; ++db)
#pragma unroll
          for (int ks = 0; ks < 2; ++ks) {
            uint2 v0 = *(const uint2*)(vt + (db * 16 + fr) * KP + (2 * ks) * 16 + fq * 4), v1 = *(const uint2*)(vt + (db * 16 + fr) * KP + (2 * ks + 1) * 16 + fq * 4);
            uint4 t4 = {v0.x, v0.y, v1.x, v1.y}; bf16x8 av = __builtin_bit_cast(bf16x8, t4);
#pragma unroll
            for (int qb = 0; qb < 4; ++qb) O[db][qb] = __builtin_amdgcn_mfma_f32_16x16x32_bf16(av, pb[qb][ks], O[db][qb], 0, 0, 0);
          }
      }
      if (ti + 1 < ntile) ls(ti + 1, (ti + 1) & 1);
      __syncthreads();
    }
#pragma unroll
    for (int qb = 0; qb < 4; ++qb) {
      float l = lrun[qb]; l += bperm_xor(l, lane, 16); l += bperm_xor(l, lane, 32);
      const float inv = 1.f / l;
      bf16_t* dst = P + (size_t)(rowbase + tq0 + qb * 16 + fr) * PW + A_IN + head * 64 + fq * 4;
#pragma unroll
      for (int db = 0; db < 4; ++db) {
        uint2 pk = {pack2(O[db][qb][0] * inv, O[db][qb][1] * inv), pack2(O[db][qb][2] * inv, O[db][qb][3] * inv)};
        if (!p.dry) *(uint2*)(dst + db * 16) = pk;
      }
    }
  }
}

DI void phase_rwkv_out(const DevP& p, int j, const int tid_, const int bid_) {
  bf16_t* P = (bf16_t*)(p.ws + OFF_BIG);
  const bf16_t* LO = (const bf16_t*)(p.ws + OFF_LO);
  const bf16_t* Y = (const bf16_t*)(p.ws + OFF_H);
  const int l16 = tid_ & 15;
  const int g0 = (bid_ * NTHR + tid_) >> 4, gs = ((int)gridDim.x * NTHR) >> 4, NIT = MROWS * 8;
  for (int it0 = g0; it0 < NIT; it0 += 2 * gs) {
    uint2 y0[2], y1[2], ur[2], uk[2], uv[2], ua0[2], ua1[2], ug[2]; f32x4 ka[2], rk[2], lw[2], lb[2]; bf16_t* prs[2]; bool ok[2];
#pragma unroll
    for (int k = 0; k < 2; ++k) {
      const int itk = it0 + k * gs; ok[k] = itk < NIT; const int it = ok[k] ? itk : it0;
      const int row = it >> 3, h = it & 7, c = h * 64 + 4 * l16;
      y0[k] = *(const uint2*)(Y + (size_t)row * 512 + c); y1[k] = *(const uint2*)(Y + ((size_t)MROWS + row) * 512 + c);
      bf16_t* pr = P + (size_t)row * PW + c; prs[k] = pr;
      ur[k] = *(const uint2*)pr; uk[k] = *(const uint2*)(pr + 512); uv[k] = *(const uint2*)(pr + 1024);
      const bf16_t* lo = LO + (size_t)row * LOW + c;
      ua0[k] = *(const uint2*)(lo + 1024); ua1[k] = *(const uint2*)(lo + 1536); ug[k] = *(const uint2*)(lo + 2048);
      ka[k] = *(const f32x4*)(pin(p, I_EKA) + j * 512 + c); rk[k] = *(const f32x4*)(pin(p, I_ERK) + j * 512 + c);
      lw[k] = *(const f32x4*)(pin(p, I_ELNW) + j * 512 + c); lb[k] = *(const f32x4*)(pin(p, I_ELNB) + j * 512 + c);
    }
#pragma unroll
    for (int k = 0; k < 2; ++k) {
      const float y[4] = {lo16(y0[k].x) + lo16(y1[k].x), hi16(y0[k].x) + hi16(y1[k].x), lo16(y0[k].y) + lo16(y1[k].y), hi16(y0[k].y) + hi16(y1[k].y)};
      const float r[4] = {lo16(ur[k].x), hi16(ur[k].x), lo16(ur[k].y), hi16(ur[k].y)}, kq[4] = {lo16(uk[k].x), hi16(uk[k].x), lo16(uk[k].y), hi16(uk[k].y)};
      const float v[4] = {lo16(uv[k].x), hi16(uv[k].x), lo16(uv[k].y), hi16(uv[k].y)}, a0[4] = {lo16(ua0[k].x), hi16(ua0[k].x), lo16(ua0[k].y), hi16(ua0[k].y)};
      const float a1[4] = {lo16(ua1[k].x), hi16(ua1[k].x), lo16(ua1[k].y), hi16(ua1[k].y)}, gg[4] = {lo16(ug[k].x), hi16(ug[k].x), lo16(ug[k].y), hi16(ug[k].y)};
      float sy = 0.f, bo = 0.f;
#pragma unroll
      for (int q = 0; q < 4; ++q) { sy += y[q]; const float kd = kq[q] * (2.f + (a0[q] + a1[q] - 2.f) * ka[k][q]); bo += r[q] * kd * rk[k][q]; }
      sy = sum16(sy); bo = sum16(bo);
      const float mu = sy * (1.f / 64.f);
      float sv = 0.f;
#pragma unroll
      for (int q = 0; q < 4; ++q) { const float dd = y[q] - mu; sv += dd * dd; }
      sv = sum16(sv);
      const float rs = rsqrtf(sv * (1.f / 64.f) + 64e-5f);
      float o[4];
#pragma unroll
      for (int q = 0; q < 4; ++q) o[q] = ((y[q] - mu) * rs * lw[k][q] + lb[k][q] + bo * v[q]) * gg[q];
      uint2 pk = {pack2(o[0], o[1]), pack2(o[2], o[3])};
      if (ok[k] && !p.dry) *(uint2*)prs[k] = pk;
    }
  }
}

DI int PI(int n) { return n + (n >> 5); }
DI float2 cmul(float2 a, float2 b) { return make_float2(a.x * b.x - a.y * b.y, a.x * b.y + a.y * b.x); }
DI float2 cmulc(float2 a, float2 b) { return make_float2(a.x * b.x + a.y * b.y, a.y * b.x - a.x * b.y); }
template <int M> DI float2 c16() {
  constexpr float cs[8] = {1.f, 0.9238795325112867f, 0.7071067811865476f, 0.3826834323650898f, 0.f, -0.3826834323650898f, -0.7071067811865476f, -0.9238795325112867f};
  constexpr float sn[8] = {0.f, -0.3826834323650898f, -0.7071067811865476f, -0.9238795325112867f, -1.f, -0.9238795325112867f, -0.7071067811865476f, -0.3826834323650898f};
  return make_float2(cs[M], sn[M]);
}
template <int S, int I, bool TWD> DI void bfly_f(float2 (&x)[16], float2 w) {
  constexpr int hs = 8 >> S, m = I & (hs - 1);
  float2 a = x[I], b = x[I + hs];
  x[I] = make_float2(a.x + b.x, a.y + b.y);
  float2 d = make_float2(a.x - b.x, a.y - b.y);
  float2 W = c16<m * (8 / hs)>();
  if (TWD) W = cmul(W, w);
  x[I + hs] = (m == 0 && !TWD) ? d : cmul(d, W);
}
template <int S, int I, bool TWD> DI void bfly_i(float2 (&x)[16], float2 w) {
  constexpr int hs = 8 >> S, m = I & (hs - 1);
  float2 W = c16<m * (8 / hs)>();
  if (TWD) W = cmul(W, w);
  float2 a = x[I], t = (m == 0 && !TWD) ? x[I + hs] : cmulc(x[I + hs], W);
  x[I] = make_float2(a.x + t.x, a.y + t.y);
  x[I + hs] = make_float2(a.x - t.x, a.y - t.y);
}
template <int S, bool TWD> DI void stage_f(float2 (&x)[16], float2 w) {
  constexpr int hs = 8 >> S;
  if (!(0 & hs)) bfly_f<S, 0, TWD>(x, w);
  if (!(1 & hs)) bfly_f<S, 1 & ~hs, TWD>(x, w);
  if (!(2 & hs)) bfly_f<S, 2 & ~hs, TWD>(x, w);
  if (!(3 & hs)) bfly_f<S, 3 & ~hs, TWD>(x, w);
  if (!(4 & hs)) bfly_f<S, 4 & ~hs, TWD>(x, w);
  if (!(5 & hs)) bfly_f<S, 5 & ~hs, TWD>(x, w);
  if (!(6 & hs)) bfly_f<S, 6 & ~hs, TWD>(x, w);
  if (!(7 & hs)) bfly_f<S, 7 & ~hs, TWD>(x, w);
  if (!(8 & hs)) bfly_f<S, 8 & ~hs, TWD>(x, w);
  if (!(9 & hs)) bfly_f<S, 9 & ~hs, TWD>(x, w);
  if (!(10 & hs)) bfly_f<S, 10 & ~hs, TWD>(x, w);
  if (!(11 & hs)) bfly_f<S, 11 & ~hs, TWD>(x, w);
  if (!(12 & hs)) bfly_f<S, 12 & ~hs, TWD>(x, w);
  if (!(13 & hs)) bfly_f<S, 13 & ~hs, TWD>(x, w);
  if (!(14 & hs)) bfly_f<S, 14 & ~hs, TWD>(x, w);
  if (!(15 & hs)) bfly_f<S, 15 & ~hs, TWD>(x, w);
}
template <int S, bool TWD> DI void stage_i(float2 (&x)[16], float2 w) {
  constexpr int hs = 8 >> S;
  if (!(0 & hs)) bfly_i<S, 0, TWD>(x, w);
  if (!(1 & hs)) bfly_i<S, 1 & ~hs, TWD>(x, w);
  if (!(2 & hs)) bfly_i<S, 2 & ~hs, TWD>(x, w);
  if (!(3 & hs)) bfly_i<S, 3 & ~hs, TWD>(x, w);
  if (!(4 & hs)) bfly_i<S, 4 & ~hs, TWD>(x, w);
  if (!(5 & hs)) bfly_i<S, 5 & ~hs, TWD>(x, w);
  if (!(6 & hs)) bfly_i<S, 6 & ~hs, TWD>(x, w);
  if (!(7 & hs)) bfly_i<S, 7 & ~hs, TWD>(x, w);
  if (!(8 & hs)) bfly_i<S, 8 & ~hs, TWD>(x, w);
  if (!(9 & hs)) bfly_i<S, 9 & ~hs, TWD>(x, w);
  if (!(10 & hs)) bfly_i<S, 10 & ~hs, TWD>(x, w);
  if (!(11 & hs)) bfly_i<S, 11 & ~hs, TWD>(x, w);
  if (!(12 & hs)) bfly_i<S, 12 & ~hs, TWD>(x, w);
  if (!(13 & hs)) bfly_i<S, 13 & ~hs, TWD>(x, w);
  if (!(14 & hs)) bfly_i<S, 14 & ~hs, TWD>(x, w);
  if (!(15 & hs)) bfly_i<S, 15 & ~hs, TWD>(x, w);
}
template <bool TWD> DI void r16_fwd(float2 (&x)[16], float2 w0) {
  float2 w1 = cmul(w0, w0), w2 = cmul(w1, w1), w3 = cmul(w2, w2);
  stage_f<0, TWD>(x, w0); stage_f<1, TWD>(x, w1); stage_f<2, TWD>(x, w2); stage_f<3, TWD>(x, w3);
}
template <bool TWD> DI void r16_inv(float2 (&x)[16], float2 w0) {
  float2 w1 = cmul(w0, w0), w2 = cmul(w1, w1), w3 = cmul(w2, w2);
  stage_i<3, TWD>(x, w3); stage_i<2, TWD>(x, w2); stage_i<1, TWD>(x, w1); stage_i<0, TWD>(x, w0);
}
DI void passA(float2* D, const float2 w0, int tid, bool inv) {
  const int base = (tid >> 8) * 4096 + (tid & 255);
  float2 x[16];
#pragma unroll
  for (int i = 0; i < 16; ++i) x[i] = D[PI(base + i * 256)];
  if (inv) r16_inv<true>(x, w0); else r16_fwd<true>(x, w0);
#pragma unroll
  for (int i = 0; i < 16; ++i) D[PI(base + i * 256)] = x[i];
}
DI void passB(float2* D, const float2 w0, int tid, bool inv) {
  const int base = (tid >> 4) * 256 + (tid & 15);
  float2 x[16];
#pragma unroll
  for (int i = 0; i < 16; ++i) x[i] = D[PI(base + i * 16)];
  if (inv) r16_inv<true>(x, w0); else r16_fwd<true>(x, w0);
#pragma unroll
  for (int i = 0; i < 16; ++i) D[PI(base + i * 16)] = x[i];
}

DI void phase_taps(const DevP& p, int j, char* shmc, const int tid_, const int bid_, const int nwk_) {
  float* hs = (float*)shmc;
  float* fs = hs + 64 * 65;
  const float* fout = pin(p, I_OFOUT) + (size_t)j * 64 * 4096;
  const float da = -3.0701134573253945f, db = -15.350567286626973f;
  const int tid = tid_;
  for (int it = bid_; it < 64 * 68; it += nwk_) {
    const int ct = it / 68, tt = it % 68, isc = tt >= 64, t0 = (isc ? tt - 64 : tt) * 64, c0 = ct * 64, n = isc ? 256 : 4096;
    const float* hdn = isc ? (const float*)(p.ws + OFF_HDNC) + (size_t)j * 256 * 64 : (const float*)(p.ws + OFF_HDNL) + (size_t)j * 4096 * 64;
    __syncthreads();
    { float hv_[8], fv_[8];
#pragma unroll
      for (int q = 0; q < 8; ++q) { const int e = tid + q * NTHR, r = e >> 6, cc = e & 63; hv_[q] = hdn[(size_t)(t0 + r) * 64 + cc]; fv_[q] = fout[(size_t)r * 4096 + c0 + cc]; }
      __builtin_amdgcn_sched_barrier(0);
#pragma unroll
      for (int q = 0; q < 8; ++q) { const int e = tid + q * NTHR, r = e >> 6, cc = e & 63; hs[r * 65 + cc] = hv_[q]; fs[r * 64 + cc] = fv_[q]; } }
    __syncthreads();
    const int tl = tid & 63, cg8 = (tid >> 6) * 8;
    float acc[8];
#pragma unroll
    for (int e = 0; e < 8; ++e) acc[e] = 0.f;
    for (int k = 0; k < 64; ++k) { const float hv = hs[tl * 65 + k];
#pragma unroll
      for (int e = 0; e < 8; ++e) acc[e] += hv * fs[k * 64 + cg8 + e]; }
    const float tpos = (float)(t0 + tl) / (float)(n - 1);
#pragma unroll
    for (int e = 0; e < 8; ++e) {
      const int c = c0 + cg8 + e, d = c & 1023;
      const float delta = fabsf(da + (db - da) * (float)d / (float)(DM - 1));
      const float v = acc[e] * (__expf(-tpos * delta) + 0.05f);
      if (isc) ((float*)(p.ws + OFF_LO) + (size_t)4096 * 4096)[(size_t)c * 256 + t0 + tl] = v;
      else ((float*)(p.ws + OFF_LO))[(size_t)c * 4096 + t0 + tl] = v;
    }
  }
}

DI void phase_hyena(const DevP& p, int j, char* shmc, const int tid_, const int bid_, const bool skipctx) {
  bf16_t* ZT = (bf16_t*)(p.ws + OFF_BIG);
  const float2* TW = (const float2*)(p.ws + OFF_TW);
  const float* HFL = (const float*)(p.ws + OFF_LO);
  const float* HFC = HFL + (size_t)4096 * 4096;
  float2* D = (float2*)shmc;
  float2* KF = D + 8448;
  const int tid = tid_;
  for (int d = bid_; d < DM; d += gridDim.x) {
#pragma unroll 1
    for (int o = 0; o < 2; ++o) {
      const float skip = pin(p, I_OSKIP)[(j * 2 + o) * DM + d];
      const float* cf = HFL + ((size_t)((o * 2 + 0) * DM + d)) * 4096;
      const float* cb = HFL + ((size_t)((o * 2 + 1) * DM + d)) * 4096;
      __syncthreads();
      for (int t = tid; t < 4096; t += NTHR) {
        const float lo = (t == 0) ? cf[0] + cb[0] : cf[t];
        const float hi = (t == 0) ? 0.f : cb[4096 - t];
        const float2 w = TW[t];
        D[PI(t)] = make_float2(lo + hi, 0.f);
        const float dd = lo - hi;
        D[PI(4096 + t)] = make_float2(dd * w.x, dd * w.y);
      }
      { const float2 w_ = TW[2 * (tid & 255)]; __syncthreads(); passA(D, w_, tid, false); }
      { const float2 w_ = TW[32 * (tid & 15)]; __syncthreads(); passB(D, w_, tid, false); }
      __syncthreads();
      { float2 x[16];
#pragma unroll
        for (int i = 0; i < 16; ++i) x[i] = D[PI(tid * 16 + i)];
        r16_fwd<false>(x, make_float2(1.f, 0.f));
#pragma unroll
        for (int i = 0; i < 16; ++i) KF[PI(tid * 16 + i)] = x[i]; }
      __syncthreads();
#pragma unroll 1
      for (int pr = 0; pr < 4; ++pr) {
        const bf16_t* u1 = ZT + ((size_t)((2 * pr) * HY3 + d)) * TPB + CTXL;
        const bf16_t* u2 = ZT + ((size_t)((2 * pr + 1) * HY3 + d)) * TPB + CTXL;
        for (int t = tid; t < 4096; t += NTHR) {
          const float2 u = make_float2(bf2f(u1[t]), bf2f(u2[t]));
          D[PI(t)] = u; D[PI(4096 + t)] = cmul(u, TW[t]);
        }
        { const float2 w_ = TW[2 * (tid & 255)]; __syncthreads(); passA(D, w_, tid, false); }
        { const float2 w_ = TW[32 * (tid & 15)]; __syncthreads(); passB(D, w_, tid, false); }
        __syncthreads();
        { float2 x[16];
#pragma unroll
          for (int i = 0; i < 16; ++i) x[i] = D[PI(tid * 16 + i)];
          r16_fwd<false>(x, make_float2(1.f, 0.f));
#pragma unroll
          for (int i = 0; i < 16; ++i) x[i] = cmul(x[i], KF[PI(tid * 16 + i)]);
          r16_inv<false>(x, make_float2(1.f, 0.f));
#pragma unroll
          for (int i = 0; i < 16; ++i) D[PI(tid * 16 + i)] = x[i]; }
        { const float2 w_ = TW[32 * (tid & 15)]; __syncthreads(); passB(D, w_, tid, true); }
        { const float2 w_ = TW[2 * (tid & 255)]; __syncthreads(); passA(D, w_, tid, true); }
        __syncthreads();
        const bf16_t* x1 = ZT + ((size_t)((2 * pr) * HY3 + (1 + o) * DM + d)) * TPB + CTXL;
        const bf16_t* x2 = ZT + ((size_t)((2 * pr + 1) * HY3 + (1 + o) * DM + d)) * TPB + CTXL;
        bf16_t* o1 = ZT + ((size_t)((2 * pr) * HY3 + d)) * TPB + CTXL;
        bf16_t* o2 = ZT + ((size_t)((2 * pr + 1) * HY3 + d)) * TPB + CTXL;
        {
          float2 twv[8]; bf16_t ua_[8], ub_[8], xa_[8], xb_[8];
#pragma unroll
          for (int k = 0; k < 8; ++k) { const int t = tid + k * NTHR; twv[k] = TW[t]; ua_[k] = u1[t]; ub_[k] = u2[t]; xa_[k] = x1[t]; xb_[k] = x2[t]; }
          __builtin_amdgcn_sched_barrier(0);
#pragma unroll
          for (int k = 0; k < 8; ++k) { const int t = tid + k * NTHR;
            const float2 a = D[PI(t)], b = cmulc(D[PI(4096 + t)], twv[k]);
            const float yx = (a.x + b.x) * (1.f / 8192.f), yy = (a.y + b.y) * (1.f / 8192.f);
            if (!p.dry) { o1[t] = f2bf(bf2f(xa_[k]) * (yx + bf2f(ua_[k]) * skip)); o2[t] = f2bf(bf2f(xb_[k]) * (yy + bf2f(ub_[k]) * skip)); } }
        }
        __syncthreads();
      }
      if (!skipctx)
      {
        const float* hfc = HFC + ((size_t)((o * 2 + 0) * DM + d)) * 256;
        const float* hbc = HFC + ((size_t)((o * 2 + 1) * DM + d)) * 256;
        for (int q = tid; q < 5 * 256; q += NTHR) {
          const int blk = q >> 8, t = q & 255; const float2 w = TW[16 * t];
          if (blk < 4) {
            const float2 u = make_float2(bf2f(ZT[((size_t)((2 * blk) * HY3 + d)) * TPB + t]), bf2f(ZT[((size_t)((2 * blk + 1) * HY3 + d)) * TPB + t]));
            D[PI(blk * 512 + t)] = u; D[PI(blk * 512 + 256 + t)] = cmul(u, w);
          } else {
            const float lo = (t == 0) ? hfc[0] + hbc[0] : hfc[t], hi = (t == 0) ? 0.f : hbc[256 - t];
            D[PI(2048 + t)] = make_float2(lo + hi, 0.f); const float dd = lo - hi; D[PI(2304 + t)] = make_float2(dd * w.x, dd * w.y);
          }
        }
        { const float2 w_ = TW[32 * (tid & 15)]; __syncthreads(); if (tid < 160) passB(D, w_, tid, false); }
        __syncthreads();
        if (tid >= 128 && tid < 160) { float2 x[16];
#pragma unroll
          for (int i = 0; i < 16; ++i) x[i] = D[PI(tid * 16 + i)];
          r16_fwd<false>(x, make_float2(1.f, 0.f));
#pragma unroll
          for (int i = 0; i < 16; ++i) D[PI(tid * 16 + i)] = x[i]; }
        __syncthreads();
        if (tid < 128) { float2 x[16];
          const int kb = 2048 + ((tid >> 4) & 1) * 256 + (tid & 15) * 16;
#pragma unroll
          for (int i = 0; i < 16; ++i) x[i] = D[PI(tid * 16 + i)];
          r16_fwd<false>(x, make_float2(1.f, 0.f));
#pragma unroll
          for (int i = 0; i < 16; ++i) x[i] = cmul(x[i], D[PI(kb + i)]);
          r16_inv<false>(x, make_float2(1.f, 0.f));
#pragma unroll
          for (int i = 0; i < 16; ++i) D[PI(tid * 16 + i)] = x[i]; }
        { const float2 w_ = TW[32 * (tid & 15)]; __syncthreads(); if (tid < 128) passB(D, w_, tid, true); }
        __syncthreads();
        { float2 twv[2]; bf16_t ua_[2], ub_[2], xa_[2], xb_[2];
#pragma unroll
          for (int k = 0; k < 2; ++k) { const int q = tid + k * NTHR, blk = q >> 8, t = q & 255;
            const bf16_t* p1 = ZT + ((size_t)((2 * blk) * HY3 + d)) * TPB + t; const bf16_t* p2 = ZT + ((size_t)((2 * blk + 1) * HY3 + d)) * TPB + t;
            twv[k] = TW[16 * t]; ua_[k] = *p1; ub_[k] = *p2; xa_[k] = p1[(size_t)(1 + o) * DM * TPB]; xb_[k] = p2[(size_t)(1 + o) * DM * TPB]; }
#pragma unroll
          for (int k = 0; k < 2; ++k) { const int q = tid + k * NTHR, blk = q >> 8, t = q & 255;
            const float2 a = D[PI(blk * 512 + t)], b = cmulc(D[PI(blk * 512 + 256 + t)], twv[k]);
            const float yx = (a.x + b.x) * (1.f / 512.f), yy = (a.y + b.y) * (1.f / 512.f);
            bf16_t* p1 = ZT + ((size_t)((2 * blk) * HY3 + d)) * TPB + t; bf16_t* p2 = ZT + ((size_t)((2 * blk + 1) * HY3 + d)) * TPB + t;
            if (!p.dry) { *p1 = f2bf(bf2f(xa_[k]) * (yx + bf2f(ua_[k]) * skip)); *p2 = f2bf(bf2f(xb_[k]) * (yy + bf2f(ub_[k]) * skip)); } }
        }
        __syncthreads();
      }
    }
  }
}

DI void phase_transpose(const DevP& p, char* shmc, const int tid_, const int bid_) {
  const bf16_t* ZT = (const bf16_t*)(p.ws + OFF_BIG);
  bf16_t* H = (bf16_t*)(p.ws + OFF_H);
  bf16_t* T = (bf16_t*)shmc;
  const int tid = tid_;
  for (int it = bid_; it < NB * 68 * 16; it += gridDim.x) {
    const int b = it / (68 * 16), rem = it % (68 * 16), s0 = (rem >> 4) * 64, d0 = (rem & 15) * 64;
    { const int dr = tid >> 3, sc = (tid & 7) * 8;
      *(uint4*)(T + dr * 72 + sc) = *(const uint4*)(ZT + ((size_t)(b * HY3 + d0 + dr)) * TPB + s0 + sc); }
    __syncthreads();
    { const int sr = tid >> 3, dc = (tid & 7) * 8; unsigned w[4];
#pragma unroll
      for (int e = 0; e < 4; ++e) w[e] = (unsigned)T[(dc + 2 * e) * 72 + sr] | ((unsigned)T[(dc + 2 * e + 1) * 72 + sr] << 16);
      uint4 pk = {w[0], w[1], w[2], w[3]};
      *(uint4*)(H + ((size_t)(b * TPB + s0 + sr)) * DM + d0 + dc) = pk; }
    __syncthreads();
  }
}


#define XB_TMO      128
#define XB_XCNT(j)  (256  + 64 * (j))
#define XB_XSUB(j)  (1280 + 64 * (j))
#define XB_XGEN(j)  (2304 + 64 * (j))
#define XB_TOP      3328
#define XB_TOPGEN   3392
#define XCD_BAR_WORDS 3456
#define XB_SPIN_CAP (1u << 22)
#define LAS __attribute__((address_space(3)))
DI unsigned xb_ld(unsigned* q)              { return __hip_atomic_load(q, __ATOMIC_RELAXED, __HIP_MEMORY_SCOPE_AGENT); }
DI unsigned xb_add(unsigned* q, unsigned v) { return __hip_atomic_fetch_add(q, v, __ATOMIC_RELAXED, __HIP_MEMORY_SCOPE_AGENT); }
DI unsigned xb_xcc_id() { return (unsigned)__builtin_amdgcn_s_getreg((3 << 11) | 20) & 0xFu; }
#define XB_SPIN(cond, bar) do { unsigned _sp = 0; while (cond) { __builtin_amdgcn_s_sleep(1); \
    if ((++_sp & 255u) == 0u) { if (xb_ld(&(bar)[XB_TMO])) break; if (_sp > XB_SPIN_CAP) { atomicAdd(&(bar)[XB_TMO], 1u); break; } } } } while (0)
struct XcdBarrier { unsigned* bar; unsigned x; volatile LAS unsigned* st; };
DI void xcd_barrier_complete(unsigned* bar, unsigned x, unsigned& nloc, unsigned& nx) {
  const unsigned G = gridDim.x;
  unsigned sum, cnt, mine, sp = 0u;
  for (;;) {
    sum = 0u; cnt = 0u; mine = 0u;
#pragma unroll
    for (unsigned j = 0; j < 16; ++j) { const unsigned c = xb_ld(&bar[XB_XCNT(j)]); sum += c; cnt += (c > 0u) ? 1u : 0u; mine = (j == x) ? c : mine; }
    if (sum == G) break;
    __builtin_amdgcn_s_sleep(1);
    if ((++sp & 255u) == 0u) { if (xb_ld(&bar[XB_TMO])) break; if (sp > XB_SPIN_CAP) { atomicAdd(&bar[XB_TMO], 1u); break; } }
  }
  nloc = mine > 0u ? mine : 1u; nx = cnt > 0u ? cnt : 1u;
}
DI void xcd_barrier(const XcdBarrier& b, int tid) {
  asm volatile("s_waitcnt vmcnt(0)" ::: "memory");
  __syncthreads();
  if (tid == 0) {
    unsigned* bar = b.bar;
    __builtin_amdgcn_s_waitcnt(0);
    unsigned nloc = b.st[0], nx = b.st[1];
    if (nloc == 0u) { xcd_barrier_complete(bar, b.x, nloc, nx); b.st[0] = nloc; b.st[1] = nx; }
    const unsigned old = xb_add(&bar[XB_XSUB(b.x)], 1u);
    const unsigned gen = old / nloc;
    if (old + 1u == (gen + 1u) * nloc) {
      __builtin_amdgcn_fence(__ATOMIC_RELEASE, "agent");
      asm volatile("s_waitcnt vmcnt(0)" ::: "memory");
      const unsigned og = xb_add(&bar[XB_TOP], 1u);
      const unsigned tg = og / nx;
      if (og + 1u == (tg + 1u) * nx) xb_add(&bar[XB_TOPGEN], 1u);
      else XB_SPIN(xb_ld(&bar[XB_TOPGEN]) == tg, bar);
      __builtin_amdgcn_fence(__ATOMIC_ACQUIRE, "agent");
      xb_add(&bar[XB_XGEN(b.x)], 1u);
      asm volatile("s_waitcnt vmcnt(0)" ::: "memory");
    } else {
      XB_SPIN(xb_ld(&bar[XB_XGEN(b.x)]) == gen, bar);
      __builtin_amdgcn_fence(__ATOMIC_ACQUIRE, "agent");
      asm volatile("s_waitcnt vmcnt(0)" ::: "memory");
    }
  }
  __syncthreads();
}

constexpr int NPHASE = 1 + 4 * 9;
#define NREP(t) (((PROBE_MASK >> (t)) & 1) ? 2 : 1)
#define REP(t, nonidem, call) for (int r_ = 0; r_ < NREP(t); ++r_) { p.dry = (nonidem) && (r_ + 1 < NREP(t)); call; }

template <int EN>
__global__ void __launch_bounds__(NTHR) fwd_kernel(Params pk, int ph0, int ph1, int coop) {
  extern __shared__ __attribute__((aligned(16))) char shm[];
  __shared__ const float* in_tab[N_IN];
  if (threadIdx.x < N_IN) in_tab[threadIdx.x] = pk.in[threadIdx.x];
  __shared__ uint4 xb_words;
  if (threadIdx.x == 0) xb_words = make_uint4(0u, 0u, 0u, 0u);
  __syncthreads();
  XcdBarrier xb; xb.bar = (unsigned*)(pk.ws + OFF_BAR); xb.x = xb_xcc_id(); xb.st = (volatile LAS unsigned*)&xb_words;
  if (EN == 0xffff && coop && threadIdx.x == 0) (void)xb_add(&xb.bar[XB_XCNT(xb.x)], 1u);
  bf16_t* shb = (bf16_t*)shm;
  const int wave_s = __builtin_amdgcn_readfirstlane(threadIdx.x >> 6);
  const int phend = (EN == 0xffff) ? ph1 : ph0 + 1;
  for (int ph = ph0; ph < phend; ++ph) {
    int lane_; asm volatile("v_mbcnt_lo_u32_b32 %0, -1, 0\n\tv_mbcnt_hi_u32_b32 %0, -1, %0" : "=v"(lane_));
    int tid_ = wave_s * 64 + lane_, bid_ = blockIdx.x;
    asm volatile("" : "+s"(bid_));
    DevP p; p.in = in_tab; p.dry = false; p.xin = (ph == 1 || ph == 6);
    { unsigned long long w = (unsigned long long)pk.ws, o = (unsigned long long)pk.out;
      unsigned wl = (unsigned)w, wh = (unsigned)(w >> 32), ol = (unsigned)o, oh = (unsigned)(o >> 32);
      asm volatile("" : "+s"(wl), "+s"(wh), "+s"(ol), "+s"(oh));
      p.ws = (char*)(__attribute__((address_space(1))) char*)(((unsigned long long)wh << 32) | wl);
      p.out = (float*)(__attribute__((address_space(1))) float*)(((unsigned long long)oh << 32) | ol); }
    int conv_next = -1, conv_parts = 0;
    GemmCall g{}; int nM = 0, nN = 0; bool do_gemm = false, skip_sync = false;
    if (ph == 0) { if constexpr (EN & 1) REP(0, false, phase_setup(p, shm, tid_, bid_)) }
    else {
      const int layer = (ph - 1) / 9, sub = (ph - 1) % 9, even = (layer & 1) == 0, j = layer >> 1;
      const float* mod = (const float*)(p.ws + OFF_MOD) + (size_t)layer * 9 * 6144;
      const bf16_t* wt = (const bf16_t*)(p.ws + ((layer & 1) ? OFF_WT2 : OFF_WT));
      g.M = MROWS; g.ksk = 1 << 30; g.ksoff = 0;
      if (sub == 0) { if constexpr (EN & 2) REP(1, false, phase_start(p, layer, shm, tid_, bid_)) }
      else if (sub == 1) {
        g.A = (const bf16_t*)(p.ws + OFF_H); g.lda = DM; g.Bt = wt + WT_WIN; g.K = DM; do_gemm = true;
        if (even) { g.e0 = pin(p, I_EMUP) + j * A_IN; g.e1 = pin(p, I_EMUN) + j * A_IN; g.o0 = (bf16_t*)(p.ws + OFF_BIG); g.o1 = (bf16_t*)(p.ws + OFF_L);
          g.mode = M_EVEN; nM = (MROWS + 253) / 254; nN = 11; }
        else { g.bias = pin(p, I_OBIN) + j * HY3; g.e0 = pin(p, I_OCW) + (size_t)j * 3 * HY3; g.e1 = pin(p, I_OCB) + j * HY3; g.o0 = (bf16_t*)(p.ws + OFF_BIG);
          g.mode = M_ODD; nM = (MROWS + 247) / 248; nN = 12; }
      } else if (sub == 2) {
        if (even) {
          g.A = (const bf16_t*)(p.ws + OFF_L); g.lda = LW; g.Bt = wt + WT_LORA; g.K = LW;
          g.e0 = pin(p, I_EW0) + j * 1024; g.e1 = pin(p, I_EA0) + j * 1024; g.o0 = (bf16_t*)(p.ws + OFF_LO);
          g.mode = M_LORA; nM = MROWS / 256; nN = LOW / 256; do_gemm = true;
          if constexpr (EN & 32) phase_qkprep(p, j, tid_, bid_);
        } else { if constexpr (EN & 64) REP(6, true, phase_hyena(p, j, shm, tid_, bid_, layer == 3)) }
      } else if (sub == 3) {
        if (even) { if constexpr (EN & 128) REP(7, false, phase_scan(p, j, shm, tid_, bid_)) if constexpr (EN & 256) REP(8, true, phase_attn(p, j, shm, tid_, bid_))
          if (layer < 3) { __syncthreads();
            if ((int)gridDim.x == 256) { if (bid_ >= 32) convert_layer(p, layer + 1, (bf16_t*)(p.ws + (((layer + 1) & 1) ? OFF_WT2 : OFF_WT)), shm, tid_, bid_ - 32, 224, 4); }
            else convert_layer(p, layer + 1, (bf16_t*)(p.ws + (((layer + 1) & 1) ? OFF_WT2 : OFF_WT)), shm, tid_, bid_, (int)gridDim.x, 4); } }
        else { if constexpr (EN & 512) REP(9, false, phase_transpose(p, shm, tid_, bid_)) }
      } else if (sub == 4) {
        if (even) { if constexpr (EN & 1024) phase_rwkv_out(p, j, tid_, bid_); }
        else skip_sync = true;
      } else if (sub == 5) {
        g.Bt = wt + WT_WOUT; g.K = DM; g.mod = mod; g.msel = 2; g.mode = M_RES; nM = MROWS / 256; nN = DM / 256; do_gemm = true;
        g.skipctx = (layer == 3);
        if (layer < 3) { conv_next = layer + 1; conv_parts = 1; }
        if (even) { g.A = (const bf16_t*)(p.ws + OFF_BIG); g.lda = PW; g.ksk = 8; g.ksoff = A_IN - 512; g.bias = nullptr; }
        else { g.A = (const bf16_t*)(p.ws + OFF_H); g.lda = DM; g.bias = pin(p, I_OBOUT) + j * DM; }
      } else if (sub == 6) { if constexpr (EN & 4096) REP(12, false, norm_phase(p, layer, 1, tid_, bid_)) }
      else if (sub == 7) {
        g.A = (const bf16_t*)(p.ws + OFF_H); g.lda = DM; g.Bt = wt + WT_WUP; g.K = DM;
        g.e0 = pin(p, I_FCW) + (size_t)layer * 3 * FF2; g.e1 = pin(p, I_FCB) + (size_t)layer * FF2; g.o0 = (bf16_t*)(p.ws + OFF_BIG);
        g.mode = M_FFN; nM = (MROWS + 253) / 254; nN = FF / 128; do_gemm = true;
      } else {
        g.A = (const bf16_t*)(p.ws + OFF_BIG); g.lda = FF; g.Bt = wt + WT_WDN; g.K = FF; g.mod = mod; g.msel = 5; g.bias = nullptr;
        g.skipctx = (layer == 3);
        if (layer < 3) { conv_next = layer + 1; conv_parts = ((layer + 1) & 1) ? 2 : 4; }
        g.mode = M_RES; nM = MROWS / 256; nN = DM / 256; do_gemm = true;
      }
    }
    if (do_gemm) {
      if (g.mode == M_RES) { if constexpr (EN & 2048) REP(11, true, gemm_phase<M_RES>(p, shb, g, nM, nN, tid_, bid_)) }
      else if (g.mode == M_LORA) { if constexpr (EN & 16) REP(4, false, gemm_phase<M_LORA>(p, shb, g, nM, nN, tid_, bid_)) }
      else if (g.mode == M_FFN) { if constexpr (EN & 8192) REP(13, true, gemm_phase<M_FFN>(p, shb, g, nM, nN, tid_, bid_)) }
      else if (g.mode == M_EVEN) { if constexpr (EN & 4) REP(2, true, gemm_phase<M_EVEN>(p, shb, g, nM, nN, tid_, bid_)) }
      else { if constexpr (EN & 8) REP(3, true, gemm_phase<M_ODD>(p, shb, g, nM, nN, tid_, bid_)) }
    }
    if (conv_next >= 0 && (int)gridDim.x == 256 && (bid_ >> 3) >= 4)
      convert_layer(p, conv_next, (bf16_t*)(p.ws + ((conv_next & 1) ? OFF_WT2 : OFF_WT)), shm, tid_, (bid_ & 7) * 28 + (bid_ >> 3) - 4, 224, conv_parts);
    else if (conv_next >= 0 && (int)gridDim.x != 256)
      convert_layer(p, conv_next, (bf16_t*)(p.ws + ((conv_next & 1) ? OFF_WT2 : OFF_WT)), shm, tid_, bid_, (int)gridDim.x, conv_parts);
    if (EN == 0xffff && coop && ph + 1 < ph1 && !skip_sync) {
      if (ph1 < 0) { __threadfence(); cg::this_grid().sync(); }
      for (int r_ = 0; r_ < NREP(14); ++r_) xcd_barrier(xb, tid_);
    }
  }
}

#ifndef MK_MULTI
#define MK_MULTI 0
#endif

template <int EN>
static void launch_phase(const Params& p, int ph, hipStream_t stream) {
  static bool attr = false;
  if (!attr) { (void)hipFuncSetAttribute((const void*)fwd_kernel<EN>, hipFuncAttributeMaxDynamicSharedMemorySize, LDS_BYTES); attr = true; }
  fwd_kernel<EN><<<256, NTHR, LDS_BYTES, stream>>>(p, ph, ph + 1, 0);
}

extern "C" void kernel_launch(void* const* d_in, const int* in_sizes, int n_in, void* d_out, int out_size, void* d_ws, size_t ws_size, hipStream_t stream) {
  Params p{};
  for (int i = 0; i < N_IN; ++i) p.in[i] = (const float*)d_in[i];
  p.out = (float*)d_out; p.ws = (char*)d_ws;
  if (ws_size < WS_END2) { fprintf(stderr, "workspace too small: %zu < %zu\n", ws_size, (size_t)WS_END); return; }
#if MK_MULTI
  launch_phase<1>(p, 0, stream);
  for (int layer = 0; layer < 4; ++layer) {
    const int b = 1 + layer * 9; const bool even = (layer & 1) == 0;
    launch_phase<2>(p, b + 0, stream);
    if (even) {
      launch_phase<4>(p, b + 1, stream); launch_phase<16>(p, b + 2, stream); launch_phase<32>(p, b + 2, stream); launch_phase<128 | 256>(p, b + 3, stream); launch_phase<1024>(p, b + 4, stream);
    } else {
      launch_phase<8>(p, b + 1, stream); launch_phase<64>(p, b + 2, stream); launch_phase<512>(p, b + 3, stream);
    }
    launch_phase<2048>(p, b + 5, stream); launch_phase<4096>(p, b + 6, stream); launch_phase<8192>(p, b + 7, stream); launch_phase<2048>(p, b + 8, stream);
  }
#else
  static bool attr = false;
  if (!attr) { (void)hipFuncSetAttribute((const void*)fwd_kernel<0xffff>, hipFuncAttributeMaxDynamicSharedMemorySize, LDS_BYTES); attr = true; }
  (void)hipMemsetAsync((char*)d_ws + OFF_BAR, 0, XCD_BAR_WORDS * 4, stream);
  int ph0 = 0, ph1 = NPHASE, coop = 1;
  void* args[] = {&p, &ph0, &ph1, &coop};
  hipError_t e = hipLaunchCooperativeKernel((const void*)fwd_kernel<0xffff>, dim3(256), dim3(NTHR), args, LDS_BYTES, stream);
  if (e != hipSuccess) fprintf(stderr, "cooperative launch failed: %s\n", hipGetErrorString(e));
#endif
}
```
